# Optimizing an MI355X kernel written in HIP

```python
import math
import jax, jax.numpy as jnp
from jax import lax
import numpy as np

D_MODEL = 1024
BATCH = 16
SEQ = 2048
DEPTH = 4

CHUNK = 64
N_MIXERS = 2
N_GDN = (DEPTH + 1) // 2
N_HGRN = DEPTH // 2
EPS = 1e-6

GDN_HEADS = 8
GDN_HEAD_DIM = D_MODEL // GDN_HEADS
GDN_KEY_WIDTH = GDN_HEADS * GDN_HEAD_DIM
GDN_VAL_WIDTH = GDN_HEADS * GDN_HEAD_DIM
GDN_CONV_WIDTH = 2 * GDN_KEY_WIDTH + GDN_VAL_WIDTH
GDN_IN_WIDTH = GDN_CONV_WIDTH + GDN_VAL_WIDTH + 2 * GDN_HEADS
CONV_K = 4

HGRN_FORGET_DIM = 128
HGRN_HEADS = D_MODEL // HGRN_FORGET_DIM
HGRN_VALUE_DIM = D_MODEL // HGRN_HEADS
HGRN_WIDTH = HGRN_HEADS * HGRN_FORGET_DIM
HGRN_IN_WIDTH = 4 * HGRN_WIDTH
SUB = 16
N_SUB = CHUNK // SUB

MLP_HIDDEN = 4 * D_MODEL

kernel_name = "hybrid_gdn_hgrn2_stream_encoder"


def _rmsnorm(x, w):
    xf = x.astype(jnp.float32)
    y = xf * lax.rsqrt(jnp.mean(xf * xf, axis=-1, keepdims=True) + EPS)
    return (y * w.astype(jnp.float32)).astype(x.dtype)


def _l2norm(x):
    return x * lax.rsqrt(jnp.sum(x * x, axis=-1, keepdims=True) + EPS)


def _causal_conv(x, w):
    K = w.shape[0]
    T = x.shape[1]
    xp = jnp.pad(x, ((0, 0), (K - 1, 0), (0, 0)))
    y = xp[:, 0:T] * w[0]
    for kk in range(1, K):
        y = y + xp[:, kk:kk + T] * w[kk]
    return y


def _to_chunks(a, nc):
    B = a.shape[0]
    H = a.shape[2]
    a = a.reshape((B, nc, CHUNK, H) + a.shape[3:])
    return jnp.moveaxis(a, (1, 3), (0, 2))


def _from_chunks(o):
    nc, B, H, C, Dv = o.shape
    return jnp.moveaxis(o, (0, 2), (1, 3)).reshape(B, nc * C, H, Dv)


def _gdn_chunked(q, k, v, beta, g):
    B, T, H, DK = q.shape
    DV = v.shape[-1]
    nc = T // CHUNK
    q = _to_chunks(q * (DK ** -0.5), nc)
    k = _to_chunks(k, nc)
    v = _to_chunks(v, nc)
    beta = _to_chunks(beta, nc)
    gc = jnp.cumsum(_to_chunks(g, nc), axis=-1)
    causal = jnp.tril(jnp.ones((CHUNK, CHUNK), dtype=bool))
    strict = jnp.tril(jnp.ones((CHUNK, CHUNK), dtype=bool), k=-1)
    decay = jnp.exp(jnp.where(causal, gc[..., :, None] - gc[..., None, :], -jnp.inf))
    kb = k * beta[..., None]
    L = jnp.where(strict, jnp.einsum('nbhik,nbhjk->nbhij', kb, k) * decay, 0.0)
    rhs = jnp.concatenate([v * beta[..., None], kb * jnp.exp(gc)[..., None]], axis=-1)
    sol = lax.linalg.triangular_solve(L, rhs, left_side=True, lower=True, unit_diagonal=True)
    u = sol[..., :DV]
    w = sol[..., DV:]
    a_qk = jnp.where(causal, jnp.einsum('nbhik,nbhjk->nbhij', q, k) * decay, 0.0)
    q_dec = q * jnp.exp(gc)[..., None]
    k_dec = k * jnp.exp(gc[..., -1:] - gc)[..., None]
    chunk_decay = jnp.exp(gc[..., -1])

    def step(S, xs):
        qd, a_c, u_c, w_c, kd, dl = xs
        v_new = u_c - jnp.einsum('bhck,bhkv->bhcv', w_c, S)
        o = jnp.einsum('bhck,bhkv->bhcv', qd, S) + jnp.einsum('bhij,bhjv->bhiv', a_c, v_new)
        S = S * dl[..., None, None] + jnp.einsum('bhck,bhcv->bhkv', kd, v_new)
        return S, o

    S0 = jnp.zeros((B, H, DK, DV), jnp.float32)
    _, o = lax.scan(step, S0, (q_dec, a_qk, u, w, k_dec, chunk_decay))
    return _from_chunks(o)


def _hgrn2_chunked(q, k, v, g):
    B, T, H, DK = q.shape
    DV = v.shape[-1]
    nc = T // CHUNK
    q = _to_chunks(q * (DK ** -0.5), nc)
    k = _to_chunks(k, nc)
    v = _to_chunks(v, nc)
    g = _to_chunks(g, nc)
    gc = jnp.cumsum(g, axis=-2)
    gb = (gc - g)[:, :, :, ::SUB]
    pos = jnp.arange(CHUNK)
    off_mask = (pos[None, :] // SUB) < jnp.arange(N_SUB)[:, None]
    diag_mask = jnp.tril(jnp.ones((SUB, SUB), dtype=bool))

    def step(S, xs):
        q_c, k_c, v_c, gc_c, gb_c = xs
        qs = q_c.reshape(B, H, N_SUB, SUB, DK)
        ks = k_c.reshape(B, H, N_SUB, SUB, DK)
        vs = v_c.reshape(B, H, N_SUB, SUB, DV)
        gs = gc_c.reshape(B, H, N_SUB, SUB, DK)
        q_off = qs * jnp.exp(gs - gb_c[:, :, :, None])
        k_off = k_c[:, :, None] * jnp.exp(
            jnp.where(off_mask[:, :, None], gb_c[:, :, :, None] - gc_c[:, :, None], -jnp.inf))
        a_off = jnp.einsum('bhsik,bhsjk->bhsij', q_off, k_off)
        dec = jnp.exp(jnp.where(diag_mask[:, :, None],
                                gs[..., :, None, :] - gs[..., None, :, :], -jnp.inf))
        a_diag = jnp.einsum('bhsik,bhsjk,bhsijk->bhsij', qs, ks, dec)
        o = (jnp.einsum('bhsij,bhjv->bhsiv', a_off, v_c)
             + jnp.einsum('bhsij,bhsjv->bhsiv', a_diag, vs)).reshape(B, H, CHUNK, DV)
        o = o + jnp.einsum('bhck,bhkv->bhcv', q_c * jnp.exp(gc_c), S)
        g_last = gc_c[:, :, -1]
        S = S * jnp.exp(g_last)[..., None] + jnp.einsum(
            'bhck,bhcv->bhkv', k_c * jnp.exp(g_last[:, :, None] - gc_c), v_c)
        return S, o

    S0 = jnp.zeros((B, H, DK, DV), jnp.float32)
    _, o = lax.scan(step, S0, (q, k, v, gc, gb))
    return _from_chunks(o)


def _gated_deltanet(y, w_in, conv_w, a_log, dt_bias, onorm_w, w_out):
    B, T, _ = y.shape
    f32 = jnp.float32
    proj = y @ w_in
    qkv = proj[..., :GDN_CONV_WIDTH]
    gate = proj[..., GDN_CONV_WIDTH:GDN_CONV_WIDTH + GDN_VAL_WIDTH]
    a = proj[..., GDN_CONV_WIDTH + GDN_VAL_WIDTH:GDN_CONV_WIDTH + GDN_VAL_WIDTH + GDN_HEADS]
    b = proj[..., GDN_CONV_WIDTH + GDN_VAL_WIDTH + GDN_HEADS:]
    qkv = jax.nn.silu(_causal_conv(qkv, conv_w)).astype(f32)
    q = _l2norm(qkv[..., :GDN_KEY_WIDTH].reshape(B, T, GDN_HEADS, GDN_HEAD_DIM))
    k = _l2norm(qkv[..., GDN_KEY_WIDTH:2 * GDN_KEY_WIDTH].reshape(B, T, GDN_HEADS, GDN_HEAD_DIM))
    v = qkv[..., 2 * GDN_KEY_WIDTH:].reshape(B, T, GDN_HEADS, GDN_HEAD_DIM)
    beta = jax.nn.sigmoid(b.astype(f32))
    g = -jnp.exp(a_log.astype(f32)) * jax.nn.softplus(a.astype(f32) + dt_bias.astype(f32))
    o = _gdn_chunked(q, k, v, beta, g)
    o = _rmsnorm(o, onorm_w) * jax.nn.silu(gate.astype(f32)).reshape(B, T, GDN_HEADS, GDN_HEAD_DIM)
    return o.reshape(B, T, GDN_VAL_WIDTH).astype(y.dtype) @ w_out


def _hgrn2(y, w_in, lb, gnorm_w, w_out):
    B, T, _ = y.shape
    f32 = jnp.float32
    proj = y @ w_in
    q, f, i, gate = jnp.split(proj, 4, axis=-1)
    f = f.astype(f32)
    log_forget = jnp.logaddexp(jnp.log(lb), jnp.log1p(-lb) + jax.nn.log_sigmoid(f))
    k = (1.0 - lb) * jax.nn.sigmoid(-f)
    q = jax.nn.silu(q.astype(f32))
    heads = lambda t: t.reshape(B, T, HGRN_HEADS, -1)
    o = _hgrn2_chunked(heads(q), heads(k), heads(i.astype(f32)), heads(log_forget))
    o = _rmsnorm(o.reshape(B, T, HGRN_WIDTH), gnorm_w) * jax.nn.silu(gate.astype(f32))
    return o.astype(y.dtype) @ w_out


def _sq_relu_mlp(h, w_up, w_down):
    return jnp.square(jax.nn.relu(h @ w_up)) @ w_down


def setup_inputs(seed: int = 0) -> dict:
    key = jax.random.key(seed)
    ks = jax.random.split(key, 17)
    f32 = jnp.float32
    nrm = lambda kk, shape: jax.random.normal(kk, shape, f32)
    x = nrm(ks[0], (BATCH, SEQ, D_MODEL))
    gdn_w_in = nrm(ks[1], (N_GDN, D_MODEL, GDN_IN_WIDTH)) * D_MODEL ** -0.5
    gdn_conv = nrm(ks[2], (N_GDN, CONV_K, GDN_CONV_WIDTH)) * CONV_K ** -0.5
    gdn_a_log = jnp.log(jax.random.uniform(ks[3], (N_GDN, GDN_HEADS), f32, 1.0, 16.0))
    dt = jnp.exp(jax.random.uniform(ks[4], (N_GDN, GDN_HEADS), f32, math.log(1e-3), math.log(1e-1)))
    gdn_dt_bias = dt + jnp.log(-jnp.expm1(-dt))
    gdn_onorm = 1.0 + 0.02 * nrm(ks[5], (N_GDN, GDN_HEAD_DIM))
    gdn_w_out = nrm(ks[6], (N_GDN, GDN_VAL_WIDTH, D_MODEL)) * GDN_VAL_WIDTH ** -0.5
    hgrn_w_in = nrm(ks[7], (N_HGRN, D_MODEL, HGRN_IN_WIDTH)) * D_MODEL ** -0.5
    hgrn_lb_logits = 0.1 * nrm(ks[8], (DEPTH, HGRN_WIDTH))
    hgrn_gnorm = 1.0 + 0.02 * nrm(ks[9], (N_HGRN, HGRN_WIDTH))
    hgrn_w_out = nrm(ks[10], (N_HGRN, HGRN_WIDTH, D_MODEL)) * HGRN_WIDTH ** -0.5
    norm_mix = 1.0 + 0.02 * nrm(ks[11], (DEPTH, D_MODEL))
    norm_mlp = 1.0 + 0.02 * nrm(ks[12], (DEPTH, D_MODEL))
    mlp_w_up = nrm(ks[13], (DEPTH, D_MODEL, MLP_HIDDEN)) * D_MODEL ** -0.5
    mlp_w_down = nrm(ks[14], (DEPTH, MLP_HIDDEN, D_MODEL)) * MLP_HIDDEN ** -0.5
    norm_final = 1.0 + 0.02 * nrm(ks[15], (D_MODEL,))
    return {"x": x, "gdn_w_in": gdn_w_in, "gdn_conv": gdn_conv, "gdn_a_log": gdn_a_log,
            "gdn_dt_bias": gdn_dt_bias, "gdn_onorm": gdn_onorm, "gdn_w_out": gdn_w_out,
            "hgrn_w_in": hgrn_w_in, "hgrn_lb_logits": hgrn_lb_logits, "hgrn_gnorm": hgrn_gnorm,
            "hgrn_w_out": hgrn_w_out, "norm_mix": norm_mix, "norm_mlp": norm_mlp,
            "mlp_w_up": mlp_w_up, "mlp_w_down": mlp_w_down, "norm_final": norm_final}


def reference(x, gdn_w_in, gdn_conv, gdn_a_log, gdn_dt_bias, gdn_onorm, gdn_w_out,
              hgrn_w_in, hgrn_lb_logits, hgrn_gnorm, hgrn_w_out, norm_mix, norm_mlp,
              mlp_w_up, mlp_w_down, norm_final):
    sm = jax.nn.softmax(hgrn_lb_logits.astype(jnp.float32), axis=0)
    lower_bounds = jnp.cumsum(sm, axis=0) - sm[0]
    h = x
    for i in range(DEPTH):
        j = i // N_MIXERS
        y = _rmsnorm(h, norm_mix[i])
        if i % N_MIXERS == 0:
            y = _gated_deltanet(y, gdn_w_in[j], gdn_conv[j], gdn_a_log[j], gdn_dt_bias[j],
                                gdn_onorm[j], gdn_w_out[j])
        else:
            y = _hgrn2(y, hgrn_w_in[j], lower_bounds[i], hgrn_gnorm[j], hgrn_w_out[j])
        h = h + y.astype(h.dtype)
        h = h + _sq_relu_mlp(_rmsnorm(h, norm_mlp[i]), mlp_w_up[i], mlp_w_down[i]).astype(h.dtype)
    return _rmsnorm(h, norm_final)
```

```cpp
#include <hip/hip_runtime.h>
#include <hip/hip_cooperative_groups.h>
#include <cstdio>
#include <cstdint>
namespace cg = cooperative_groups;
namespace pg8 {
#define PG8_LAS __attribute__((address_space(3)))
typedef unsigned short bf16_t;
typedef short bf16x8 __attribute__((ext_vector_type(8)));
typedef float f32x4 __attribute__((ext_vector_type(4)));
typedef unsigned u32x4 __attribute__((ext_vector_type(4)));
constexpr int BM = 256, BK = 64, HALF = 128, HTB = HALF * BK * 2  , STAGE_BYTES = 8 * HTB, NXCD = 8, WGM = 8;

__host__ __device__ __forceinline__ int lds_byte(int r, int c) { const int st = (r >> 4) * 2 + (c >> 5), rr = r & 15, cc = c & 31, ob = rr * 64 + cc * 2; return st * 1024 + (ob ^ (((ob >> 9) & 1) << 5)); }
__host__ __device__ __forceinline__ void stage_rc(int b, int& R, int& C) { const int st = b / 1024, sb = b % 1024, swz = sb ^ (((sb >> 9) & 1) << 5); R = (st >> 1) * 16 + swz / 64; C = (st & 1) * 32 + (swz % 64) / 2; }
__host__ __device__ __forceinline__ int perm32(int rho) { const int n = rho >> 4, i = rho & 15; return 8 * (i >> 2) + 4 * n + (i & 3); }

struct Unit { int pm, pn; };
struct Gemm { const bf16_t* A; const bf16_t* Bt; int M, N, K; };

struct StaticOrder {
    int nM, nN, nwg, G, c;
    __host__ __device__ void init(int M, int N, int G_, int c_) { nM = M / BM; nN = N / BM; nwg = nM * nN; G = G_; c = c_; }
    __host__ __device__ bool next(int i, Unit& u) const {
        const long L = (long)i * G + c; if (L >= nwg) return false;
        int wgid = (int)L; { const int q = nwg / NXCD, r = nwg % NXCD, xcd = wgid % NXCD, off = wgid / NXCD; wgid = (xcd < r ? xcd * (q + 1) : r * (q + 1) + (xcd - r) * q) + off; }
        const int nig = WGM * nN, gid = wgid / nig, fm = gid * WGM, gsz = (nM - fm) < WGM ? (nM - fm) : WGM;
        u.pm = fm + ((wgid % nig) % gsz); u.pn = (wgid % nig) / gsz; return true;
    }
    __device__ __forceinline__ void a_ready(const Unit&) const {}
    __device__ __forceinline__ void done(const Unit&) const {}
};


__device__ __forceinline__ unsigned cvt_pk_bf16(float lo, float hi) { unsigned r; asm volatile("v_cvt_pk_bf16_f32 %0, %1, %2" : "=v"(r) : "v"(lo), "v"(hi)); return r; }
constexpr float RMS_EPS = 1e-6f;
__device__ __forceinline__ float row_rstd16(const float* ssp, int row) {
    const f32x4* p = (const f32x4*)(ssp + (size_t)row * 16); const f32x4 a = p[0], b = p[1], c = p[2], d = p[3];
    const float s = (((a[0] + a[1]) + (a[2] + a[3])) + ((b[0] + b[1]) + (b[2] + b[3]))) + (((c[0] + c[1]) + (c[2] + c[3])) + ((d[0] + d[1]) + (d[2] + d[3])));
    return rsqrtf(s * (1.0f / 1024.0f) + RMS_EPS);
}
__device__ __forceinline__ float row_rstd8(const float* ssp, int row) {
    const f32x4* p = (const f32x4*)(ssp + (size_t)row * 8); const f32x4 a = p[0], b = p[1];
    const float s = ((a[0] + a[1]) + (a[2] + a[3])) + ((b[0] + b[1]) + (b[2] + b[3]));
    return rsqrtf(s * (1.0f / 1024.0f) + RMS_EPS);
}

struct EpiProj {
    static constexpr bool PERM = true, AFTER_DRAIN = false;
    bf16_t* O; size_t plane_stride; const float* ss; float* AB; bf16_t* halo;
    __device__ __forceinline__ void operator()(const f32x4 (&acc)[2][2][4][2], const Unit& u, int wr, int wc, int fr, int fq) const {
        const int row0 = u.pm * BM + wr * 64 + fr; const int colt = u.pn * BM;
        if (colt >= 4096) {
            if (wc == 0 && fq < 2) {
#pragma unroll
                for (int ai = 0; ai < 2; ++ai)
#pragma unroll
                    for (int m = 0; m < 4; ++m) { const int row = row0 + ai * HALF + m * 16; const float rs = row_rstd16(ss, row);
#pragma unroll
                        for (int n = 0; n < 2; ++n) { const f32x4 v = acc[ai][0][m][n] * rs; *(f32x4*)(AB + (size_t)row * 16 + 8 * fq + 4 * n) = v; } }
            }
            return;
        }
        const int plane = colt >> 10; bf16_t* base = O + (size_t)plane * plane_stride; const int col0 = (colt & 1023) + wc * 32 + 8 * fq;
#pragma unroll
        for (int ai = 0; ai < 2; ++ai)
#pragma unroll
            for (int m = 0; m < 4; ++m) { const int row = row0 + ai * HALF + m * 16; const float rs = row_rstd16(ss, row);
                bf16_t* rowp = base + (size_t)row * 1024 + col0;
#pragma unroll
                for (int bj = 0; bj < 2; ++bj) { const f32x4 v0 = acc[ai][bj][m][0] * rs, v1 = acc[ai][bj][m][1] * rs;
                    u32x4 w; w.x = cvt_pk_bf16(v0[0], v0[1]); w.y = cvt_pk_bf16(v0[2], v0[3]); w.z = cvt_pk_bf16(v1[0], v1[1]); w.w = cvt_pk_bf16(v1[2], v1[3]);
                    *(u32x4*)(rowp + bj * HALF) = w;
                    if (halo != nullptr && plane < 3 && m == 3 && fr >= 13) *(u32x4*)(halo + ((size_t)(row >> 6) * 3 + (fr - 13)) * 3072 + plane * 1024 + col0 + bj * HALF) = w; } }
    }
};
struct EpiUp {
    static constexpr bool PERM = true, AFTER_DRAIN = false;
    bf16_t* O; const float* ss;
    __device__ __forceinline__ void operator()(const f32x4 (&acc)[2][2][4][2], const Unit& u, int wr, int wc, int fr, int fq) const {
        const int row0 = u.pm * BM + wr * 64 + fr; const int col0 = u.pn * BM + wc * 32 + 8 * fq;
#pragma unroll
        for (int ai = 0; ai < 2; ++ai)
#pragma unroll
            for (int m = 0; m < 4; ++m) { const int row = row0 + ai * HALF + m * 16; const float rs = row_rstd16(ss, row);
                bf16_t* rowp = O + (size_t)row * 4096 + col0;
#pragma unroll
                for (int bj = 0; bj < 2; ++bj) { f32x4 v0 = acc[ai][bj][m][0] * rs, v1 = acc[ai][bj][m][1] * rs;
#pragma unroll
                    for (int e = 0; e < 4; ++e) { const float a0 = fmaxf(v0[e], 0.f), a1 = fmaxf(v1[e], 0.f); v0[e] = a0 * a0; v1[e] = a1 * a1; }
                    u32x4 w; w.x = cvt_pk_bf16(v0[0], v0[1]); w.y = cvt_pk_bf16(v0[2], v0[3]); w.z = cvt_pk_bf16(v1[0], v1[1]); w.w = cvt_pk_bf16(v1[2], v1[3]);
                    *(u32x4*)(rowp + bj * HALF) = w; } }
    }
};
struct EpiRes {
    static constexpr bool PERM = true, AFTER_DRAIN = false;
    const float* hin; float* hout; bf16_t* hb; float* ss_next; const float* rowss;
    __device__ __forceinline__ void operator()(const f32x4 (&acc)[2][2][4][2], const Unit& u, int wr, int wc, int fr_, int fq_) const {
        int fr = fr_, fq = fq_; asm volatile("" : "+v"(fr), "+v"(fq));
        const int row0 = u.pm * BM + wr * 64 + fr; const int col0 = u.pn * BM + wc * 32 + 8 * fq;
#pragma unroll
        for (int ai = 0; ai < 2; ++ai)
#pragma unroll
            for (int m = 0; m < 4; ++m) { const int row = row0 + ai * HALF + m * 16; const float sc = rowss ? row_rstd8(rowss, row) : 1.0f;
                const size_t off = (size_t)row * 1024 + col0; float q = 0.f;
#pragma unroll
                for (int bj = 0; bj < 2; ++bj) { const f32x4 h0 = *(const f32x4*)(hin + off + bj * HALF), h1 = *(const f32x4*)(hin + off + bj * HALF + 4);
                    const f32x4 v0 = h0 + acc[ai][bj][m][0] * sc, v1 = h1 + acc[ai][bj][m][1] * sc;
                    *(f32x4*)(hout + off + bj * HALF) = v0; *(f32x4*)(hout + off + bj * HALF + 4) = v1;
                    u32x4 w; w.x = cvt_pk_bf16(v0[0], v0[1]); w.y = cvt_pk_bf16(v0[2], v0[3]); w.z = cvt_pk_bf16(v1[0], v1[1]); w.w = cvt_pk_bf16(v1[2], v1[3]);
                    *(u32x4*)(hb + off + bj * HALF) = w;
                    q += (v0[0] * v0[0] + v0[1] * v0[1]) + (v0[2] * v0[2] + v0[3] * v0[3]) + (v1[0] * v1[0] + v1[1] * v1[1]) + (v1[2] * v1[2] + v1[3] * v1[3]); }
                q += __shfl_xor(q, 16); q += __shfl_xor(q, 32);
                if (fq == 0) ss_next[(size_t)row * 16 + u.pn * 4 + wc] = q;
                asm volatile("" ::: "memory"); }
    }
};

template <class Epi, class Sched, bool ALIGN_EPI = false, bool SP2 = false>
__device__ __forceinline__ void gemm_phase(PG8_LAS unsigned char* lds, const Gemm g, const Sched& S, const Epi& E) {
    int tid = threadIdx.x; asm volatile("" : "+v"(tid));
    const int wid = __builtin_amdgcn_readfirstlane(tid >> 6), lane = tid & 63, wr = wid >> 2, wc = wid & 3, fr = lane & 15, fq = lane >> 4;
    const int K = g.K, nt = K / BK;
    unsigned voffA[2], voffB[2];
#pragma unroll
    for (int i = 0; i < 2; ++i) { int R, C; stage_rc(tid * 16 + i * 8192, R, C); const int Rb = Epi::PERM ? ((R & ~31) + perm32(R & 31)) : R;
        voffA[i] = (unsigned)(R * K + C) * 2u; voffB[i] = (unsigned)(Rb * K + C) * 2u; }
    const size_t kstep = (size_t)(BK * 2);
    const size_t hstep = (size_t)HALF * K * 2;
    const size_t tstep = 2 * hstep;
    const unsigned ldsw = (unsigned)wid * 1024u;
    const int aoff = lds_byte(wr * 64 + fr, fq * 8), boff = lds_byte(wc * 32 + fr, fq * 8);
#define PG8_SA(b, h) (((b) * 2 + (h)) * HTB)
#define PG8_SB(b, h) ((4 + (b) * 2 + (h)) * HTB)
#define PG8_STAGE(bufoff, gbase, voff) do { _Pragma("unroll") for (int _i = 0; _i < 2; ++_i) \
        __builtin_amdgcn_global_load_lds((const unsigned*)((const char*)(gbase) + (voff)[_i]), (PG8_LAS unsigned*)(lds + (bufoff) + ldsw + _i * 8192), 16, 0, 0); } while (0)
#define PG8_LDA(dst, b, h) do { _Pragma("unroll") for (int m = 0; m < 4; ++m) _Pragma("unroll") for (int k = 0; k < 2; ++k) dst[m][k] = *(const PG8_LAS bf16x8*)(lds + PG8_SA(b, h) + aoff + m * 2048 + k * 1024); } while (0)
#define PG8_LDB(dst, b, h) do { _Pragma("unroll") for (int n = 0; n < 2; ++n) _Pragma("unroll") for (int k = 0; k < 2; ++k) dst[n][k] = *(const PG8_LAS bf16x8*)(lds + PG8_SB(b, h) + boff + n * 2048 + k * 1024); } while (0)
#define PG8_MMA(ai, bj, At, Bt) do { __builtin_amdgcn_s_setprio(1); _Pragma("unroll") for (int m = 0; m < 4; ++m) _Pragma("unroll") for (int n = 0; n < 2; ++n) _Pragma("unroll") for (int k = 0; k < 2; ++k) \
        acc[ai][bj][m][n] = __builtin_amdgcn_mfma_f32_16x16x32_bf16(Bt[n][k], At[m][k], acc[ai][bj][m][n], 0, 0, 0); __builtin_amdgcn_s_setprio(0); } while (0)
#define PG8_WAIT_V(n) asm volatile("s_waitcnt vmcnt(" #n ")" ::: "memory")
#define PG8_WAIT_L(n) asm volatile("s_waitcnt lgkmcnt(" #n ")" ::: "memory")
#define PG8_BAR __builtin_amdgcn_s_barrier()
#define PG8_SCHED __builtin_amdgcn_sched_barrier(0)
    Unit cur, nxt; int ui = 0;
    if (!S.next(0, cur)) return;
    f32x4 acc[2][2][4][2];
#pragma unroll
    for (int a = 0; a < 2; ++a)
#pragma unroll
        for (int b = 0; b < 2; ++b)
#pragma unroll
            for (int m = 0; m < 4; ++m)
#pragma unroll
                for (int n = 0; n < 2; ++n) acc[a][b][m][n] = (f32x4){0.f, 0.f, 0.f, 0.f};
    bf16x8 At[4][2], B0[2][2], B1[2][2];
    const char* cA = (const char*)g.A + (size_t)cur.pm * tstep; const char* cB = (const char*)g.Bt + (size_t)cur.pn * tstep;
    S.a_ready(cur);
    if constexpr (SP2) {
        PG8_STAGE(PG8_SB(0, 0), cB, voffB); PG8_STAGE(PG8_SB(0, 1), cB + hstep, voffB); PG8_STAGE(PG8_SA(0, 0), cA, voffA); PG8_STAGE(PG8_SA(0, 1), cA + hstep, voffA);
        if (wr == 1) PG8_BAR;
        PG8_WAIT_V(2); PG8_BAR;
        PG8_STAGE(PG8_SB(1, 0), cB + kstep, voffB); PG8_STAGE(PG8_SA(1, 0), cA + kstep, voffA); PG8_STAGE(PG8_SB(1, 1), cB + hstep + kstep, voffB);
        PG8_WAIT_V(6); PG8_BAR;
    } else {
        PG8_STAGE(PG8_SB(0, 0), cB, voffB); PG8_STAGE(PG8_SA(0, 0), cA, voffA); PG8_STAGE(PG8_SB(0, 1), cB + hstep, voffB); PG8_STAGE(PG8_SA(0, 1), cA + hstep, voffA);
        if (wr == 1) PG8_BAR;
        PG8_WAIT_V(4); PG8_BAR;
        PG8_STAGE(PG8_SB(1, 0), cB + kstep, voffB); PG8_STAGE(PG8_SA(1, 0), cA + kstep, voffA); PG8_STAGE(PG8_SB(1, 1), cB + hstep + kstep, voffB);
        PG8_WAIT_V(6); PG8_BAR;
    }
    for (;;) {
        const bool has_next = S.next(ui + 1, nxt);
        const char* nA = has_next ? (const char*)g.A + (size_t)nxt.pm * tstep : cA; const char* nB = has_next ? (const char*)g.Bt + (size_t)nxt.pn * tstep : cB;
        for (int t = 0; t < nt; t += 2) {
            const bool last = (t == nt - 2);
            const char* a1 = cA + (size_t)(t + 1) * kstep;
            const char* a2 = last ? nA : cA + (size_t)(t + 2) * kstep; const char* b2 = last ? nB : cB + (size_t)(t + 2) * kstep;
            const char* a3 = a2 + kstep; const char* b3 = b2 + kstep;
            if (last && has_next) S.a_ready(nxt);
            if constexpr (SP2) {
            PG8_LDB(B0, 0, 0); PG8_LDB(B1, 0, 1); PG8_SCHED; PG8_LDA(At, 0, 0); PG8_STAGE(PG8_SA(1, 1), a1 + hstep, voffA);
            PG8_WAIT_V(8); PG8_WAIT_L(0); PG8_BAR; PG8_MMA(0, 0, At, B0); PG8_MMA(0, 1, At, B1); PG8_BAR; PG8_SCHED;
            PG8_LDA(At, 0, 1); PG8_STAGE(PG8_SB(0, 0), b2, voffB); PG8_STAGE(PG8_SB(0, 1), b2 + hstep, voffB); PG8_STAGE(PG8_SA(0, 0), a2, voffA);
            PG8_WAIT_V(8); PG8_WAIT_L(0); PG8_BAR; PG8_MMA(1, 0, At, B0); PG8_MMA(1, 1, At, B1); PG8_BAR; PG8_SCHED;
            PG8_LDB(B0, 1, 0); PG8_LDB(B1, 1, 1); PG8_SCHED; PG8_LDA(At, 1, 0); PG8_STAGE(PG8_SA(0, 1), a2 + hstep, voffA);
            PG8_WAIT_V(8); PG8_WAIT_L(0); PG8_BAR; PG8_MMA(0, 0, At, B0); PG8_MMA(0, 1, At, B1); PG8_BAR; PG8_SCHED;
            PG8_LDA(At, 1, 1); PG8_STAGE(PG8_SB(1, 0), b3, voffB); PG8_STAGE(PG8_SB(1, 1), b3 + hstep, voffB); PG8_STAGE(PG8_SA(1, 0), a3, voffA);
            PG8_WAIT_V(8); PG8_WAIT_L(0); PG8_BAR; PG8_MMA(1, 0, At, B0); PG8_MMA(1, 1, At, B1); PG8_BAR; PG8_SCHED;
            } else {
            PG8_LDB(B0, 0, 0); PG8_SCHED; PG8_LDA(At, 0, 0); PG8_STAGE(PG8_SA(1, 1), a1 + hstep, voffA);
            PG8_WAIT_L(8); PG8_BAR; PG8_WAIT_L(0); PG8_MMA(0, 0, At, B0); PG8_BAR; PG8_SCHED;
            PG8_LDB(B1, 0, 1); PG8_STAGE(PG8_SB(0, 0), b2, voffB);
            PG8_BAR; PG8_WAIT_L(0); PG8_MMA(0, 1, At, B1); PG8_BAR;
            PG8_LDA(At, 0, 1); PG8_STAGE(PG8_SA(0, 0), a2, voffA);
            PG8_BAR; PG8_WAIT_L(0); PG8_MMA(1, 0, At, B0); PG8_BAR; PG8_SCHED;
            PG8_STAGE(PG8_SB(0, 1), b2 + hstep, voffB);
            PG8_WAIT_V(6); PG8_BAR; PG8_MMA(1, 1, At, B1); PG8_BAR;
            PG8_LDB(B0, 1, 0); PG8_SCHED; PG8_LDA(At, 1, 0); PG8_STAGE(PG8_SA(0, 1), a2 + hstep, voffA);
            PG8_WAIT_L(8); PG8_BAR; PG8_WAIT_L(0); PG8_MMA(0, 0, At, B0); PG8_BAR; PG8_SCHED;
            PG8_LDB(B1, 1, 1); PG8_STAGE(PG8_SB(1, 0), b3, voffB);
            PG8_BAR; PG8_WAIT_L(0); PG8_MMA(0, 1, At, B1); PG8_BAR;
            PG8_LDA(At, 1, 1); PG8_STAGE(PG8_SA(1, 0), a3, voffA);
            PG8_BAR; PG8_WAIT_L(0); PG8_MMA(1, 0, At, B0); PG8_BAR; PG8_SCHED;
            PG8_STAGE(PG8_SB(1, 1), b3 + hstep, voffB);
            PG8_WAIT_V(6); PG8_BAR; PG8_MMA(1, 1, At, B1); PG8_BAR;
            }
        }
        if constexpr (ALIGN_EPI) { if (wr == 0) PG8_BAR; }
        if constexpr (!Epi::AFTER_DRAIN) { E(acc, cur, wr, wc, fr, fq); S.done(cur); }
        if (!has_next) break;
#pragma unroll
        for (int a = 0; a < 2; ++a)
#pragma unroll
            for (int b = 0; b < 2; ++b)
#pragma unroll
                for (int m = 0; m < 4; ++m)
#pragma unroll
                    for (int n = 0; n < 2; ++n) acc[a][b][m][n] = (f32x4){0.f, 0.f, 0.f, 0.f};
        cur = nxt; cA = nA; cB = nB; ++ui;
        if constexpr (ALIGN_EPI) { if (wr == 1) PG8_BAR; }
    }
    PG8_WAIT_V(0);
    if constexpr (!ALIGN_EPI) { if (wr == 0) PG8_BAR; }
    PG8_BAR;
    if constexpr (Epi::AFTER_DRAIN) { E.fused(acc, cur, wr, wc, fr, fq, lds, wid, lane); S.done(cur); }
#undef PG8_SA
#undef PG8_SB
#undef PG8_STAGE
#undef PG8_LDA
#undef PG8_LDB
#undef PG8_MMA
#undef PG8_WAIT_V
#undef PG8_WAIT_L
#undef PG8_BAR
#undef PG8_SCHED
}
}

#define LAS __attribute__((address_space(3)))
typedef unsigned short bf16_t;
typedef short bf16x8 __attribute__((ext_vector_type(8)));
typedef float f32x4 __attribute__((ext_vector_type(4)));
typedef unsigned u32x4 __attribute__((ext_vector_type(4)));
typedef unsigned u32x2 __attribute__((ext_vector_type(2)));
constexpr int NWAVES = 8, NTHREADS = 512;
constexpr int M_TOK = 32768, DMODEL = 1024, NCH = 512  , NITEM = 4096  ;
constexpr float EPS = 1e-6f;
constexpr size_t MiB = 1u << 20;
constexpr size_t PLANE = (size_t)M_TOK * 1024;
constexpr size_t WS_SS = 0;
constexpr size_t WS_LB = 1536 * 1024;
constexpr size_t WS_WGI = 2 * MiB, WS_WGO = 19 * MiB, WS_WHI = 23 * MiB, WS_WHO = 39 * MiB, WS_WUP = 43 * MiB, WS_WDN = 75 * MiB;
constexpr size_t WS_PROJ = 108 * MiB;
constexpr size_t WS_HB = 364 * MiB;
constexpr size_t WS_AQK = 428 * MiB;
constexpr size_t WS_HALO = 460 * MiB;
constexpr size_t WS_AB = 470 * MiB;
constexpr size_t WS_DEC = 472 * MiB;
constexpr size_t WS_SSA = 474 * MiB, WS_SSB = 476 * MiB;
constexpr size_t WS_SSO = 478 * MiB;
constexpr size_t WS_END = 480 * MiB;
constexpr int GDN_NPAD = 4352;
constexpr int LDS_BYTES = 147456;

__device__ __forceinline__ float bf2f(unsigned v) { return __uint_as_float(v << 16); }
__device__ __forceinline__ float bflo(unsigned w) { return __uint_as_float(w << 16); }
__device__ __forceinline__ float bfhi(unsigned w) { return __uint_as_float(w & 0xffff0000u); }
__device__ __forceinline__ unsigned f2bf(float f) { unsigned u = __float_as_uint(f); return (u + 0x7fffu + ((u >> 16) & 1u)) >> 16; }
__device__ __forceinline__ unsigned pk2(float lo, float hi) { return pg8::cvt_pk_bf16(lo, hi); }
__device__ __forceinline__ float sigmoidf_(float x) { return 1.0f / (1.0f + __expf(-x)); }
__device__ __forceinline__ float siluf_(float x) { return x / (1.0f + __expf(-x)); }
__device__ __forceinline__ float wave_sum(float v) {
#pragma unroll
    for (int o = 1; o < 64; o <<= 1) v += __shfl_xor(v, o);
    return v;
}
#define LDS_WAIT() asm volatile("s_waitcnt lgkmcnt(0)" ::: "memory")

template <int K> __device__ __forceinline__ f32x4 mm_tile(const LAS bf16_t* A1, int s1, const LAS bf16_t* A2, int s2, f32x4 acc, int lane) {
    const LAS bf16_t* p1 = A1 + (lane & 15) * s1 + (lane >> 4) * 8;
    const LAS bf16_t* p2 = A2 + (lane & 15) * s2 + (lane >> 4) * 8;
#pragma unroll
    for (int k0 = 0; k0 < K; k0 += 32) {
        const bf16x8 a = *(const LAS bf16x8*)(p1 + k0); const bf16x8 b = *(const LAS bf16x8*)(p2 + k0);
        acc = __builtin_amdgcn_mfma_f32_16x16x32_bf16(a, b, acc, 0, 0, 0);
    }
    return acc;
}

__device__ __forceinline__ void transpose_item(const float* W, int K, int Nsrc, int Npad, const float* nw, bf16_t* WT, LAS float* scr, int item, int lane) {
    const int nblk = Npad / 32, kb = item / nblk, nb = item % nblk, k0 = 64 * kb, n0 = 32 * nb;
#pragma unroll 8
    for (int i = 0; i < 32; ++i) { const int kk = 2 * i + (lane >> 5); const int n = n0 + (lane & 31);
        float v = (n < Nsrc) ? W[(size_t)(k0 + kk) * Nsrc + n] : 0.f; if (nw) v *= nw[k0 + kk]; scr[kk * 33 + (lane & 31)] = v; }
    LDS_WAIT(); asm volatile("" ::: "memory");
    const int c = lane & 7;
#pragma unroll
    for (int j = 0; j < 4; ++j) { const int n = (lane >> 3) + 8 * j; const LAS float* s = scr + (8 * c) * 33 + n;
        u32x4 o; o.x = pk2(s[0 * 33], s[1 * 33]); o.y = pk2(s[2 * 33], s[3 * 33]); o.z = pk2(s[4 * 33], s[5 * 33]); o.w = pk2(s[6 * 33], s[7 * 33]);
        *(u32x4*)(WT + (size_t)(n0 + n) * K + k0 + 8 * c) = o; }
    LDS_WAIT(); asm volatile("" ::: "memory");
}

struct Args { const float* in[16]; float* out; unsigned char* ws; };

__device__ __forceinline__ void prologue(const Args& a, LAS unsigned char* lds, int tid) {
    const int lane = tid & 63, wave = __builtin_amdgcn_readfirstlane(tid >> 6);
    unsigned char* ws = a.ws;
    LAS float* scr = (LAS float*)(lds + wave * 16384);
    const int gw = blockIdx.x * NWAVES + wave, NGW = gridDim.x * NWAVES;
    const float* gdn_w_in = a.in[1]; const float* gdn_w_out = a.in[6]; const float* hgrn_w_in = a.in[7]; const float* hgrn_w_out = a.in[10];
    const float* norm_mix = a.in[11]; const float* norm_mlp = a.in[12]; const float* w_up = a.in[13]; const float* w_down = a.in[14];
    constexpr int I_GI = 16 * (GDN_NPAD / 32), I_SQ = 16 * 32, I_HI = 16 * 128, I_UP = 16 * 128, I_DN = 64 * 32;
    constexpr int NITEMS = 2 * I_GI + 2 * I_SQ + 2 * I_HI + 2 * I_SQ + 4 * I_UP + 4 * I_DN;
    for (int it = gw; it < NITEMS; it += NGW) {
        int r = it;
        if (r < 2 * I_GI) { const int j = r / I_GI; r -= j * I_GI; transpose_item(gdn_w_in + (size_t)j * 1024 * 4112, 1024, 4112, GDN_NPAD, norm_mix + (2 * j) * 1024, (bf16_t*)(ws + WS_WGI) + (size_t)j * GDN_NPAD * 1024, scr, r, lane); continue; } r -= 2 * I_GI;
        if (r < 2 * I_SQ) { const int j = r / I_SQ; r -= j * I_SQ; transpose_item(gdn_w_out + (size_t)j * 1024 * 1024, 1024, 1024, 1024, nullptr, (bf16_t*)(ws + WS_WGO) + (size_t)j * 1024 * 1024, scr, r, lane); continue; } r -= 2 * I_SQ;
        if (r < 2 * I_HI) { const int j = r / I_HI; r -= j * I_HI; transpose_item(hgrn_w_in + (size_t)j * 1024 * 4096, 1024, 4096, 4096, norm_mix + (2 * j + 1) * 1024, (bf16_t*)(ws + WS_WHI) + (size_t)j * 4096 * 1024, scr, r, lane); continue; } r -= 2 * I_HI;
        if (r < 2 * I_SQ) { const int j = r / I_SQ; r -= j * I_SQ; transpose_item(hgrn_w_out + (size_t)j * 1024 * 1024, 1024, 1024, 1024, nullptr, (bf16_t*)(ws + WS_WHO) + (size_t)j * 1024 * 1024, scr, r, lane); continue; } r -= 2 * I_SQ;
        if (r < 4 * I_UP) { const int j = r / I_UP; r -= j * I_UP; transpose_item(w_up + (size_t)j * 1024 * 4096, 1024, 4096, 4096, norm_mlp + j * 1024, (bf16_t*)(ws + WS_WUP) + (size_t)j * 4096 * 1024, scr, r, lane); continue; } r -= 4 * I_UP;
        { const int j = r / I_DN; r -= j * I_DN; transpose_item(w_down + (size_t)j * 4096 * 1024, 4096, 1024, 1024, nullptr, (bf16_t*)(ws + WS_WDN) + (size_t)j * 1024 * 4096, scr, r, lane); }
    }
    float* SSB = (float*)(ws + WS_SSB); bf16_t* HB = (bf16_t*)(ws + WS_HB); const float* x = a.in[0];
    for (int m = gw; m < M_TOK; m += NGW) {
        const f32x4* xr = (const f32x4*)(x + (size_t)m * DMODEL) + lane; float s = 0.f; f32x4 v[4];
#pragma unroll
        for (int j = 0; j < 4; ++j) { v[j] = xr[64 * j]; s += (v[j][0] * v[j][0] + v[j][1] * v[j][1]) + (v[j][2] * v[j][2] + v[j][3] * v[j][3]); }
        s = wave_sum(s);
        u32x2* o8 = (u32x2*)(HB + (size_t)m * DMODEL) + lane;
#pragma unroll
        for (int j = 0; j < 4; ++j) { u32x2 w; w.x = pk2(v[j][0], v[j][1]); w.y = pk2(v[j][2], v[j][3]); o8[64 * j] = w; }
        if (lane < 16) SSB[(size_t)m * 16 + lane] = (lane == 0) ? s : 0.f;
    }
    if (blockIdx.x == 0) {
        const float* lg = a.in[8]; float* LB = (float*)(ws + WS_LB);
        for (int c = tid; c < 1024; c += NTHREADS) {
            const float l0 = lg[c], l1 = lg[1024 + c], l2 = lg[2048 + c], l3 = lg[3072 + c];
            const float mx = fmaxf(fmaxf(l0, l1), fmaxf(l2, l3));
            const float e0 = expf(l0 - mx), e1 = expf(l1 - mx), e2 = expf(l2 - mx), e3 = expf(l3 - mx); const float inv = 1.0f / (e0 + e1 + e2 + e3);
            LB[c] = e1 * inv; LB[1024 + c] = (e1 + e2 + e3) * inv;
        }
    }
}

__device__ __forceinline__ void gdn_prep(LAS unsigned char* lds, int tid, bf16_t* P, bf16_t* Wpl, bf16_t* AQK, const bf16_t* HALO, const float* AB, float* DEC,
                                         const float* conv_w, const float* a_log, const float* dt_bias) {
    asm volatile("" : "+v"(tid));
    const int lane = tid & 63, wave = __builtin_amdgcn_readfirstlane(tid >> 6);
    LAS bf16_t* QB = (LAS bf16_t*)lds; LAS bf16_t* KB = QB + 64 * 136; LAS bf16_t* VB = KB + 64 * 136;
    LAS float* LM = (LAS float*)(lds + 52224); LAS float* GC = LM + 4096; LAS float* BETA = GC + 64; LAS float* EG = BETA + 64; LAS float* BEG = EG + 64;
    for (int it = blockIdx.x; it < NITEM; it += gridDim.x) {
        const int h = it & 7, cidx = it >> 3, n = cidx & 31; const size_t row0 = (size_t)cidx * 64;
        if (tid < 384) {
            const int p = tid >> 7, seg = (tid >> 4) & 7, cg8 = tid & 15; const int ch = h * 128 + cg8 * 8;
            float cw[4][8];
#pragma unroll
            for (int kk = 0; kk < 4; ++kk) { const f32x4 c0 = *(const f32x4*)(conv_w + kk * 3072 + p * 1024 + ch), c1 = *(const f32x4*)(conv_w + kk * 3072 + p * 1024 + ch + 4);
#pragma unroll
                for (int e = 0; e < 4; ++e) { cw[kk][e] = c0[e]; cw[kk][4 + e] = c1[e]; } }
            const bf16_t* src = P + (size_t)p * PLANE + ch;
            u32x4 xr[11];
#pragma unroll
            for (int r = 0; r < 11; ++r) { const int t = seg * 8 - 3 + r;
                if (t >= 0) xr[r] = *(const u32x4*)(src + (row0 + t) * 1024);
                else if (n > 0) xr[r] = *(const u32x4*)(HALO + ((size_t)(cidx - 1) * 3 + (t + 3)) * 3072 + p * 1024 + ch);
                else xr[r] = (u32x4){0u, 0u, 0u, 0u}; }
            LAS bf16_t* dstb = QB + p * 64 * 136 + cg8 * 8;
#pragma unroll
            for (int tt = 0; tt < 8; ++tt) {
                float y[8];
#pragma unroll
                for (int e = 0; e < 8; ++e) y[e] = 0.f;
#pragma unroll
                for (int kk = 0; kk < 4; ++kk) { const u32x4 w = xr[tt + kk];
                    y[0] += cw[kk][0] * bflo(w.x); y[1] += cw[kk][1] * bfhi(w.x); y[2] += cw[kk][2] * bflo(w.y); y[3] += cw[kk][3] * bfhi(w.y);
                    y[4] += cw[kk][4] * bflo(w.z); y[5] += cw[kk][5] * bfhi(w.z); y[6] += cw[kk][6] * bflo(w.w); y[7] += cw[kk][7] * bfhi(w.w); }
                float ssq = 0.f;
#pragma unroll
                for (int e = 0; e < 8; ++e) { y[e] = siluf_(y[e]); ssq += y[e] * y[e]; }
                if (p < 2) {
                    ssq += __shfl_xor(ssq, 1); ssq += __shfl_xor(ssq, 2); ssq += __shfl_xor(ssq, 4); ssq += __shfl_xor(ssq, 8);
                    const float rn = rsqrtf(ssq + EPS) * (p == 0 ? 0.08838834764831845f : 1.0f);
#pragma unroll
                    for (int e = 0; e < 8; ++e) y[e] *= rn;
                }
                u32x4 o; o.x = pk2(y[0], y[1]); o.y = pk2(y[2], y[3]); o.z = pk2(y[4], y[5]); o.w = pk2(y[6], y[7]);
                *(LAS u32x4*)(dstb + (seg * 8 + tt) * 136) = o;
            }
        } else if (tid >= 448) {
            const float av = AB[(row0 + lane) * 16 + h], bv = AB[(row0 + lane) * 16 + 8 + h];
            const float beta = sigmoidf_(bv); const float xx = av + dt_bias[h];
            const float sp = fmaxf(xx, 0.f) + log1pf(expf(-fabsf(xx)));
            float g = -expf(a_log[h]) * sp;
#pragma unroll
            for (int o = 1; o < 64; o <<= 1) { const float v = __shfl_up(g, o); if (lane >= o) g += v; }
            GC[lane] = g; BETA[lane] = beta; { const float eg = expf(g); EG[lane] = eg; BEG[lane] = beta * eg; }
        }
        __syncthreads();
#pragma unroll
        for (int q4 = 0; q4 < 4; ++q4) {
            const int tt = wave * 4 + q4, sel = tt >> 4, mi = (tt & 15) >> 2, nj = tt & 3;
            f32x4 acc = (f32x4){0.f, 0.f, 0.f, 0.f};
            if (nj <= mi) acc = mm_tile<128>((sel ? QB : KB) + mi * 16 * 136, 136, KB + nj * 16 * 136, 136, acc, lane);
            const int jc = nj * 16 + (lane & 15); const float gj = GC[jc];
#pragma unroll
            for (int jj = 0; jj < 4; ++jj) { const int i = mi * 16 + (lane >> 4) * 4 + jj;
                if (sel == 0) { float val = 0.f; if (jc < i) val = BETA[i] * acc[jj] * __expf(GC[i] - gj); LM[i * 64 + jc] = val; }
                else { float val = 0.f; if (jc <= i) val = acc[jj] * __expf(GC[i] - gj); AQK[(size_t)it * 4096 + i * 64 + jc] = (bf16_t)f2bf(val); } }
        }
        __syncthreads();
        if (tid < 256) {
            const int c = tid; const bool isu = c < 128;
            unsigned a_src = (unsigned)(size_t)(isu ? (VB + c) : (KB + (c - 128))), a_fac = (unsigned)(size_t)(isu ? BETA : BEG), a_lm = (unsigned)(size_t)LM;
            asm volatile("" : "+v"(a_src), "+v"(a_fac), "+v"(a_lm));
            float sol[64];
#pragma unroll
            for (int i = 0; i < 64; ++i) {
                float r = bf2f(*(const LAS bf16_t*)(size_t)(a_src + i * 272)) * *(const LAS float*)(size_t)(a_fac + i * 4);
#pragma unroll
                for (int j4 = 0; j4 * 4 < i; ++j4) { const f32x4 l = *(const LAS f32x4*)(size_t)(a_lm + i * 256 + j4 * 16);
                    r -= l[0] * sol[j4 * 4];
                    if (j4 * 4 + 1 < i) r -= l[1] * sol[j4 * 4 + 1];
                    if (j4 * 4 + 2 < i) r -= l[2] * sol[j4 * 4 + 2];
                    if (j4 * 4 + 3 < i) r -= l[3] * sol[j4 * 4 + 3]; }
                sol[i] = r;
                asm volatile("" ::: "memory");
            }
            bf16_t* dst = (isu ? (P + 2 * PLANE) : Wpl) + row0 * 1024 + h * 128 + (c & 127);
#pragma unroll
            for (int i = 0; i < 64; ++i) dst[(size_t)i * 1024] = (bf16_t)f2bf(sol[i]);
        } else {
            const int t2 = tid - 256;
            { const int i = t2 >> 2, c0 = (t2 & 3) * 32; const float e = EG[i];
#pragma unroll
              for (int v = 0; v < 4; ++v) { const u32x4 w = *(const LAS u32x4*)(QB + i * 136 + c0 + v * 8); u32x4 o;
                  o.x = pk2(bflo(w.x) * e, bfhi(w.x) * e); o.y = pk2(bflo(w.y) * e, bfhi(w.y) * e); o.z = pk2(bflo(w.z) * e, bfhi(w.z) * e); o.w = pk2(bflo(w.w) * e, bfhi(w.w) * e);
                  *(u32x4*)(P + (row0 + i) * 1024 + h * 128 + c0 + v * 8) = o; } }
            { const int dk = t2 >> 1, cb = (t2 & 1) * 32; const float gl = GC[63];
#pragma unroll
              for (int v = 0; v < 4; ++v) { float t[8];
#pragma unroll
                  for (int e = 0; e < 8; ++e) { const int c = cb + v * 8 + e; t[e] = bf2f(KB[c * 136 + dk]) * __expf(gl - GC[c]); }
                  u32x4 o; o.x = pk2(t[0], t[1]); o.y = pk2(t[2], t[3]); o.z = pk2(t[4], t[5]); o.w = pk2(t[6], t[7]);
                  *(u32x4*)(P + PLANE + (row0 + (dk >> 1)) * 1024 + h * 128 + ((dk & 1) << 6) + cb + v * 8) = o; } }
            if (t2 < 128) DEC[(size_t)it * 128 + t2] = EG[63];
        }
        __syncthreads();
    }
}

__device__ __forceinline__ void hgrn_prep(LAS unsigned char* lds, int tid, bf16_t* P, bf16_t* AQK, float* DEC, const float* LBv) {
    asm volatile("" : "+v"(tid));
    const int lane = tid & 63, wave = __builtin_amdgcn_readfirstlane(tid >> 6);
    LAS bf16_t* QH = (LAS bf16_t*)lds; LAS bf16_t* KH = QH + 4 * 16 * 136; LAS float* TOT = (LAS float*)(lds + 14 * 16 * 136 * 2);
    const int d = tid & 127, s = tid >> 7;
    for (int it = blockIdx.x; it < NITEM; it += gridDim.x) {
        const int h = it & 7, cidx = it >> 3; const size_t row0 = (size_t)cidx * 64;
        const float lb = LBv[h * 128 + d];
        float qv[16], kv[16], gl[16]; float run = 0.f;
        bf16_t* q0 = P + (row0 + s * 16) * 1024 + h * 128 + d; const bf16_t* f0 = q0 + PLANE;
#pragma unroll
        for (int r = 0; r < 16; ++r) { const float qraw = bf2f(q0[(size_t)r * 1024]), fraw = bf2f(f0[(size_t)r * 1024]);
            const float sg = 1.0f / (1.0f + expf(-fraw)); const float ft = lb + (1.0f - lb) * sg; run += logf(ft); gl[r] = run;
            kv[r] = (1.0f - lb) / (1.0f + expf(fraw)); qv[r] = siluf_(qraw) * 0.08838834764831845f; }
        TOT[s * 128 + d] = run;
        __syncthreads();
        const float t0 = TOT[d], t1 = TOT[128 + d], t2 = TOT[256 + d], t3 = TOT[384 + d];
        const float gb = (s > 0 ? t0 : 0.f) + (s > 1 ? t1 : 0.f) + (s > 2 ? t2 : 0.f); const float glast = (t0 + t1) + (t2 + t3);
#pragma unroll
        for (int r = 0; r < 16; ++r) q0[(size_t)r * 1024] = (bf16_t)f2bf(qv[r] * __expf(gb + gl[r]));
        { float t[16];
#pragma unroll
          for (int r = 0; r < 16; ++r) t[r] = kv[r] * __expf(glast - gb - gl[r]);
          u32x4 o0, o1; o0.x = pk2(t[0], t[1]); o0.y = pk2(t[2], t[3]); o0.z = pk2(t[4], t[5]); o0.w = pk2(t[6], t[7]); o1.x = pk2(t[8], t[9]); o1.y = pk2(t[10], t[11]); o1.z = pk2(t[12], t[13]); o1.w = pk2(t[14], t[15]);
          bf16_t* kd = P + PLANE + (row0 + (d >> 1)) * 1024 + h * 128 + ((d & 1) << 6) + s * 16;
          *(u32x4*)kd = o0; *(u32x4*)(kd + 8) = o1; }
        if (s == 0) DEC[(size_t)it * 128 + d] = __expf(glast);
#pragma unroll
        for (int r = 0; r < 16; ++r) QH[(s * 16 + r) * 136 + d] = (bf16_t)f2bf(qv[r] * __expf(gl[r]));
#pragma unroll
        for (int st = 0; st < 4; ++st) {
            if (st >= s) {
                float off = 0.f;
                if (st > s) { if (s <= 0 && 0 < st) off += t0; if (s <= 1 && 1 < st) off += t1; if (s <= 2 && 2 < st) off += t2; }
                const int pidx = st * (st + 1) / 2 + s;
#pragma unroll
                for (int r = 0; r < 16; ++r) KH[(pidx * 16 + r) * 136 + d] = (bf16_t)f2bf(kv[r] * __expf(off - gl[r]));
            }
        }
        __syncthreads();
        for (int tile = wave; tile < 16; tile += 8) {
            const int st = tile >> 2, sj = tile & 3; f32x4 acc = (f32x4){0.f, 0.f, 0.f, 0.f};
            if (sj <= st) acc = mm_tile<128>(QH + st * 16 * 136, 136, KH + (st * (st + 1) / 2 + sj) * 16 * 136, 136, acc, lane);
            const int jc = sj * 16 + (lane & 15);
#pragma unroll
            for (int jj = 0; jj < 4; ++jj) { const int i = st * 16 + (lane >> 4) * 4 + jj; const float val = (sj <= st && jc <= i) ? acc[jj] : 0.f;
                AQK[(size_t)it * 4096 + i * 64 + jc] = (bf16_t)f2bf(val); }
        }
        __syncthreads();
    }
}

__device__ __forceinline__ void scan_phase(LAS unsigned char* lds, int tid, bool gdn, bf16_t* P, const bf16_t* Wpl, const bf16_t* AQK, const float* DEC, const float* nw, float* ss_o) {
    if (blockIdx.x >= 128) return;
    asm volatile("" : "+v"(tid));
    const int lane = tid & 63, wave = __builtin_amdgcn_readfirstlane(tid >> 6);
    const int b = blockIdx.x >> 3, h = blockIdx.x & 7;
    LAS bf16_t* ST = (LAS bf16_t*)lds; LAS bf16_t* VNT = (LAS bf16_t*)(lds + 34816); LAS bf16_t* WB = (LAS bf16_t*)(lds + 53248); LAS bf16_t* QD = (LAS bf16_t*)(lds + 70656);
    LAS bf16_t* AQ = (LAS bf16_t*)(lds + 88064); LAS bf16_t* KDT = (LAS bf16_t*)(lds + 97280); LAS float* DECV = (LAS float*)(lds + 115712); LAS float* OB = (LAS float*)(lds + 53248);
    f32x4 Sacc[8];
#pragma unroll
    for (int nt = 0; nt < 8; ++nt) Sacc[nt] = (f32x4){0.f, 0.f, 0.f, 0.f};
    for (int i = tid; i < 128 * 136 / 2; i += NTHREADS) ((LAS unsigned*)ST)[i] = 0u;
    const int mrow = wave * 16 + (lane >> 4) * 4;
    const LAS bf16_t* STw = ST + wave * 16 * 136; const LAS bf16_t* VNTw = VNT + wave * 16 * 72;
    __syncthreads();
    for (int n = 0; n < 32; ++n) {
        const int cidx = b * 32 + n, it = cidx * 8 + h; const size_t row0 = (size_t)cidx * 64;
#pragma unroll
        for (int i = 0; i < 2; ++i) { const int idx = tid + NTHREADS * i, r = idx >> 4, c8 = idx & 15; const size_t g = (row0 + r) * 1024 + h * 128 + c8 * 8;
            if (gdn) *(LAS u32x4*)(WB + r * 136 + c8 * 8) = *(const u32x4*)(Wpl + g);
            *(LAS u32x4*)(QD + r * 136 + c8 * 8) = *(const u32x4*)(P + g);
            *(LAS u32x4*)(KDT + (r * 2 + (c8 >> 3)) * 72 + (c8 & 7) * 8) = *(const u32x4*)(P + PLANE + g); }
        { const int r = tid >> 3, c8 = tid & 7; *(LAS u32x4*)(AQ + r * 72 + c8 * 8) = *(const u32x4*)(AQK + (size_t)it * 4096 + r * 64 + c8 * 8); }
        if (tid < 128) DECV[tid] = DEC[(size_t)it * 128 + tid];
        __syncthreads();
        f32x4 vn[4];
#pragma unroll
        for (int nt = 0; nt < 4; ++nt) { const u32x2 uu = *(const u32x2*)(P + 2 * PLANE + (row0 + nt * 16 + (lane & 15)) * 1024 + h * 128 + mrow);
            vn[nt] = (f32x4){bflo(uu.x), bfhi(uu.x), bflo(uu.y), bfhi(uu.y)}; }
        if (gdn) {
#pragma unroll
            for (int nt = 0; nt < 4; ++nt) { const f32x4 acc = mm_tile<128>(STw, 136, WB + nt * 16 * 136, 136, (f32x4){0.f, 0.f, 0.f, 0.f}, lane); vn[nt] = vn[nt] - acc; }
        }
#pragma unroll
        for (int nt = 0; nt < 4; ++nt)
#pragma unroll
            for (int jj = 0; jj < 4; ++jj) VNT[(mrow + jj) * 72 + nt * 16 + (lane & 15)] = (bf16_t)f2bf(vn[nt][jj]);
        LDS_WAIT();
        f32x4 o[4];
#pragma unroll
        for (int nt = 0; nt < 4; ++nt) { o[nt] = mm_tile<128>(STw, 136, QD + nt * 16 * 136, 136, (f32x4){0.f, 0.f, 0.f, 0.f}, lane);
            o[nt] = mm_tile<64>(VNTw, 72, AQ + nt * 16 * 72, 72, o[nt], lane); }
#pragma unroll
        for (int nt = 0; nt < 8; ++nt) { const float dcy = DECV[nt * 16 + (lane & 15)]; Sacc[nt] = Sacc[nt] * dcy;
            Sacc[nt] = mm_tile<64>(VNTw, 72, KDT + nt * 16 * 72, 72, Sacc[nt], lane); }
        __syncthreads();
#pragma unroll
        for (int nt = 0; nt < 8; ++nt)
#pragma unroll
            for (int jj = 0; jj < 4; ++jj) ST[(mrow + jj) * 136 + nt * 16 + (lane & 15)] = (bf16_t)f2bf(Sacc[nt][jj]);
#pragma unroll
        for (int nt = 0; nt < 4; ++nt) *(LAS f32x4*)(OB + (nt * 16 + (lane & 15)) * 132 + mrow) = o[nt];
        __syncthreads();
        { const int c = tid >> 3, seg = tid & 7; const size_t row = row0 + c; f32x4 ov[4]; float ssq = 0.f;
#pragma unroll
          for (int v = 0; v < 4; ++v) { ov[v] = *(const LAS f32x4*)(OB + c * 132 + seg * 16 + v * 4); ssq += (ov[v][0] * ov[v][0] + ov[v][1] * ov[v][1]) + (ov[v][2] * ov[v][2] + ov[v][3] * ov[v][3]); }
          ssq += __shfl_xor(ssq, 1); ssq += __shfl_xor(ssq, 2); ssq += __shfl_xor(ssq, 4);
          bf16_t* gp = P + 3 * PLANE + row * 1024 + h * 128 + seg * 16;
          const u32x4 g0 = *(const u32x4*)gp, g1 = *(const u32x4*)(gp + 8);
          const float rs = gdn ? rsqrtf(ssq * (1.0f / 128.0f) + EPS) : 1.0f;
          const float* nwp = nw + (gdn ? 0 : h * 128) + seg * 16;
          float gt[16]; gt[0] = bflo(g0.x); gt[1] = bfhi(g0.x); gt[2] = bflo(g0.y); gt[3] = bfhi(g0.y); gt[4] = bflo(g0.z); gt[5] = bfhi(g0.z); gt[6] = bflo(g0.w); gt[7] = bfhi(g0.w);
          gt[8] = bflo(g1.x); gt[9] = bfhi(g1.x); gt[10] = bflo(g1.y); gt[11] = bfhi(g1.y); gt[12] = bflo(g1.z); gt[13] = bfhi(g1.z); gt[14] = bflo(g1.w); gt[15] = bfhi(g1.w);
          float val[16];
#pragma unroll
          for (int e = 0; e < 16; ++e) val[e] = ov[e >> 2][e & 3] * rs * nwp[e] * siluf_(gt[e]);
          u32x4 o0, o1; o0.x = pk2(val[0], val[1]); o0.y = pk2(val[2], val[3]); o0.z = pk2(val[4], val[5]); o0.w = pk2(val[6], val[7]);
          o1.x = pk2(val[8], val[9]); o1.y = pk2(val[10], val[11]); o1.z = pk2(val[12], val[13]); o1.w = pk2(val[14], val[15]);
          *(u32x4*)gp = o0; *(u32x4*)(gp + 8) = o1;
          if (!gdn && seg == 0) ss_o[row * 8 + h] = ssq; }
        __syncthreads();
    }
}

__global__ void __launch_bounds__(NTHREADS, 2) mega_fwd(Args a) {
    extern __shared__ __attribute__((aligned(16))) unsigned char lds_raw[];
    LAS unsigned char* lds = (LAS unsigned char*)lds_raw;
    cg::grid_group grid = cg::this_grid();
    const int tid = threadIdx.x;
    unsigned char* ws = a.ws;
    float* SSA = (float*)(ws + WS_SSA); float* SSB = (float*)(ws + WS_SSB); float* SSO = (float*)(ws + WS_SSO); bf16_t* P = (bf16_t*)(ws + WS_PROJ); bf16_t* HB = (bf16_t*)(ws + WS_HB); bf16_t* AQK = (bf16_t*)(ws + WS_AQK);
    bf16_t* HALO = (bf16_t*)(ws + WS_HALO); float* AB = (float*)(ws + WS_AB); float* DEC = (float*)(ws + WS_DEC);
    const float* x = a.in[0]; float* out = a.out;
    const int G = gridDim.x;

    prologue(a, lds, tid);
    grid.sync();

    for (int i = 0; i < 4; ++i) {
        const int j = i >> 1; const bool gdn = (i & 1) == 0;
        {
            const bf16_t* Bt = gdn ? (const bf16_t*)(ws + WS_WGI) + (size_t)j * GDN_NPAD * 1024 : (const bf16_t*)(ws + WS_WHI) + (size_t)j * 4096 * 1024;
            pg8::Gemm g{HB, Bt, M_TOK, gdn ? GDN_NPAD : 4096, 1024}; pg8::StaticOrder S; S.init(M_TOK, g.N, G, (int)blockIdx.x);
            pg8::EpiProj E{P, PLANE, SSB, gdn ? AB : nullptr, gdn ? HALO : nullptr};
            pg8::gemm_phase<pg8::EpiProj, pg8::StaticOrder, true, true>(lds, g, S, E);
        }
        grid.sync();
        if (gdn) gdn_prep(lds, tid, P, HB, AQK, HALO, AB, DEC, a.in[2] + (size_t)j * 4 * 3072, a.in[3] + j * 8, a.in[4] + j * 8);
        else hgrn_prep(lds, tid, P, AQK, DEC, (const float*)(ws + WS_LB) + j * 1024);
        grid.sync();
        scan_phase(lds, tid, gdn, P, HB, AQK, DEC, gdn ? a.in[5] + j * 128 : a.in[9] + j * 1024, SSO);
        grid.sync();
        {
            const bf16_t* Bt = gdn ? (const bf16_t*)(ws + WS_WGO) + (size_t)j * 1024 * 1024 : (const bf16_t*)(ws + WS_WHO) + (size_t)j * 1024 * 1024;
            pg8::Gemm g{P + 3 * PLANE, Bt, M_TOK, 1024, 1024}; pg8::StaticOrder S; S.init(M_TOK, 1024, G, (int)blockIdx.x);
            pg8::EpiRes E{i == 0 ? x : out, out, HB, SSA, gdn ? nullptr : SSO};
            pg8::gemm_phase<pg8::EpiRes, pg8::StaticOrder, true, true>(lds, g, S, E);
        }
        grid.sync();
        {
            pg8::Gemm g{HB, (const bf16_t*)(ws + WS_WUP) + (size_t)i * 4096 * 1024, M_TOK, 4096, 1024}; pg8::StaticOrder S; S.init(M_TOK, 4096, G, (int)blockIdx.x);
            pg8::EpiUp E{P, SSA};
            pg8::gemm_phase<pg8::EpiUp, pg8::StaticOrder, true, true>(lds, g, S, E);
        }
        grid.sync();
        {
            pg8::Gemm g{P, (const bf16_t*)(ws + WS_WDN) + (size_t)i * 1024 * 4096, M_TOK, 1024, 4096}; pg8::StaticOrder S; S.init(M_TOK, 1024, G, (int)blockIdx.x);
            pg8::EpiRes E{out, out, HB, SSB, nullptr};
            pg8::gemm_phase<pg8::EpiRes, pg8::StaticOrder, true, true>(lds, g, S, E);
        }
        grid.sync();
    }
    {
        const int lane = tid & 63, wave = tid >> 6; const int gw = blockIdx.x * NWAVES + wave, NGW = G * NWAVES;
        const f32x4* nf = (const f32x4*)a.in[15] + lane;
        f32x4 wv[4];
#pragma unroll
        for (int jx = 0; jx < 4; ++jx) wv[jx] = nf[64 * jx];
        for (int m = gw; m < M_TOK; m += NGW) {
            const float rs = pg8::row_rstd16(SSB, m); f32x4* o = (f32x4*)(out + (size_t)m * DMODEL) + lane;
#pragma unroll
            for (int jx = 0; jx < 4; ++jx) o[64 * jx] = o[64 * jx] * rs * wv[jx];
        }
    }
}

extern "C" void kernel_launch(void* const* d_in, const int* in_sizes, int n_in, void* d_out, int out_size, void* d_ws, size_t ws_size, hipStream_t stream) {
    static int grid = 0;
    if (grid == 0) {
        if (n_in != 16 || out_size != M_TOK * DMODEL || ws_size < WS_END) { fprintf(stderr, "kernel_launch: unexpected shapes (n_in %d, out %d, ws %zu; need ws >= %zu)\n", n_in, out_size, ws_size, (size_t)WS_END); grid = -1; return; }
        int dev = 0, cus = 0, per_cu = 0;
        (void)hipGetDevice(&dev); (void)hipDeviceGetAttribute(&cus, hipDeviceAttributeMultiprocessorCount, dev);
        (void)hipFuncSetAttribute((const void*)mega_fwd, hipFuncAttributeMaxDynamicSharedMemorySize, LDS_BYTES);
        if (hipOccupancyMaxActiveBlocksPerMultiprocessor(&per_cu, (const void*)mega_fwd, NTHREADS, LDS_BYTES) != hipSuccess || per_cu < 1) per_cu = 1;
        (void)hipGetLastError();
        grid = cus * (per_cu > 1 ? 1 : per_cu);
        if (grid <= 0) grid = 256;
    }
    if (grid < 0) return;
    Args a{};
    for (int i = 0; i < 16; ++i) a.in[i] = (const float*)d_in[i];
    a.out = (float*)d_out; a.ws = (unsigned char*)d_ws;
    void* args[] = {&a};
    hipError_t e = hipLaunchCooperativeKernel((const void*)mega_fwd, dim3(grid), dim3(NTHREADS), args, LDS_BYTES, stream);
    if (e != hipSuccess) fprintf(stderr, "cooperative launch failed: %s (grid %d)\n", hipGetErrorString(e), grid);
}
```

```cpp
#include <hip/hip_runtime.h>
#include <hip/hip_cooperative_groups.h>
#include <cstdio>
#include <cstdint>
namespace cg = cooperative_groups;
namespace pg8 {
#define PG8_LAS __attribute__((address_space(3)))
typedef unsigned short bf16_t;
typedef short bf16x8 __attribute__((ext_vector_type(8)));
typedef float f32x4 __attribute__((ext_vector_type(4)));
typedef unsigned u32x4 __attribute__((ext_vector_type(4)));
constexpr int BM = 256, BK = 64, HALF = 128, HTB = HALF * BK * 2  , STAGE_BYTES = 8 * HTB, NXCD = 8, WGM = 8;

__host__ __device__ __forceinline__ int lds_byte(int r, int c) { const int st = (r >> 4) * 2 + (c >> 5), rr = r & 15, cc = c & 31, ob = rr * 64 + cc * 2; return st * 1024 + (ob ^ (((ob >> 9) & 1) << 5)); }
__host__ __device__ __forceinline__ void stage_rc(int b, int& R, int& C) { const int st = b / 1024, sb = b % 1024, swz = sb ^ (((sb >> 9) & 1) << 5); R = (st >> 1) * 16 + swz / 64; C = (st & 1) * 32 + (swz % 64) / 2; }
__host__ __device__ __forceinline__ int perm32(int rho) { const int n = rho >> 4, i = rho & 15; return 8 * (i >> 2) + 4 * n + (i & 3); }

struct Unit { int pm, pn; };
struct Gemm { const bf16_t* A; const bf16_t* Bt; int M, N, K; };

struct StaticOrder {
    int nM, nN, nwg, G, c;
    __host__ __device__ void init(int M, int N, int G_, int c_) { nM = M / BM; nN = N / BM; nwg = nM * nN; G = G_; c = c_; }
    __host__ __device__ bool next(int i, Unit& u) const {
        const long L = (long)i * G + c; if (L >= nwg) return false;
        int wgid = (int)L; { const int q = nwg / NXCD, r = nwg % NXCD, xcd = wgid % NXCD, off = wgid / NXCD; wgid = (xcd < r ? xcd * (q + 1) : r * (q + 1) + (xcd - r) * q) + off; }
        const int nig = WGM * nN, gid = wgid / nig, fm = gid * WGM, gsz = (nM - fm) < WGM ? (nM - fm) : WGM;
        u.pm = fm + ((wgid % nig) % gsz); u.pn = (wgid % nig) / gsz; return true;
    }
    __device__ __forceinline__ void a_ready(const Unit&) const {}
    __device__ __forceinline__ void done(const Unit&) const {}
};


__device__ __forceinline__ unsigned cvt_pk_bf16(float lo, float hi) { unsigned r; asm volatile("v_cvt_pk_bf16_f32 %0, %1, %2" : "=v"(r) : "v"(lo), "v"(hi)); return r; }
constexpr float RMS_EPS = 1e-6f;
__device__ __forceinline__ float row_rstd16(const float* ssp, int row) {
    const f32x4* p = (const f32x4*)(ssp + (size_t)row * 16); const f32x4 a = p[0], b = p[1], c = p[2], d = p[3];
    const float s = (((a[0] + a[1]) + (a[2] + a[3])) + ((b[0] + b[1]) + (b[2] + b[3]))) + (((c[0] + c[1]) + (c[2] + c[3])) + ((d[0] + d[1]) + (d[2] + d[3])));
    return rsqrtf(s * (1.0f / 1024.0f) + RMS_EPS);
}
__device__ __forceinline__ float row_rstd8(const float* ssp, int row) {
    const f32x4* p = (const f32x4*)(ssp + (size_t)row * 8); const f32x4 a = p[0], b = p[1];
    const float s = ((a[0] + a[1]) + (a[2] + a[3])) + ((b[0] + b[1]) + (b[2] + b[3]));
    return rsqrtf(s * (1.0f / 1024.0f) + RMS_EPS);
}

struct EpiProj {
    static constexpr bool PERM = true, AFTER_DRAIN = false;
    bf16_t* O; size_t plane_stride; const float* ss; float* AB; bf16_t* halo;
    __device__ __forceinline__ void operator()(const f32x4 (&acc)[2][2][4][2], const Unit& u, int wr, int wc, int fr, int fq) const {
        const int row0 = u.pm * BM + wr * 64 + fr; const int colt = u.pn * BM;
        if (colt >= 4096) {
            if (wc == 0 && fq < 2) {
#pragma unroll
                for (int ai = 0; ai < 2; ++ai)
#pragma unroll
                    for (int m = 0; m < 4; ++m) { const int row = row0 + ai * HALF + m * 16; const float rs = row_rstd16(ss, row);
#pragma unroll
                        for (int n = 0; n < 2; ++n) { const f32x4 v = acc[ai][0][m][n] * rs; *(f32x4*)(AB + (size_t)row * 16 + 8 * fq + 4 * n) = v; } }
            }
            return;
        }
        const int plane = colt >> 10; bf16_t* base = O + (size_t)plane * plane_stride; const int col0 = (colt & 1023) + wc * 32 + 8 * fq;
#pragma unroll
        for (int ai = 0; ai < 2; ++ai)
#pragma unroll
            for (int m = 0; m < 4; ++m) { const int row = row0 + ai * HALF + m * 16; const float rs = row_rstd16(ss, row);
                bf16_t* rowp = base + (size_t)row * 1024 + col0;
#pragma unroll
                for (int bj = 0; bj < 2; ++bj) { const f32x4 v0 = acc[ai][bj][m][0] * rs, v1 = acc[ai][bj][m][1] * rs;
                    u32x4 w; w.x = cvt_pk_bf16(v0[0], v0[1]); w.y = cvt_pk_bf16(v0[2], v0[3]); w.z = cvt_pk_bf16(v1[0], v1[1]); w.w = cvt_pk_bf16(v1[2], v1[3]);
                    *(u32x4*)(rowp + bj * HALF) = w;
                    if (halo != nullptr && plane < 3 && m == 3 && fr >= 13) *(u32x4*)(halo + ((size_t)(row >> 6) * 3 + (fr - 13)) * 3072 + plane * 1024 + col0 + bj * HALF) = w; } }
    }
};
struct EpiUp {
    static constexpr bool PERM = true, AFTER_DRAIN = false;
    bf16_t* O; const float* ss;
    __device__ __forceinline__ void operator()(const f32x4 (&acc)[2][2][4][2], const Unit& u, int wr, int wc, int fr, int fq) const {
        const int row0 = u.pm * BM + wr * 64 + fr; const int col0 = u.pn * BM + wc * 32 + 8 * fq;
#pragma unroll
        for (int ai = 0; ai < 2; ++ai)
#pragma unroll
            for (int m = 0; m < 4; ++m) { const int row = row0 + ai * HALF + m * 16; const float rs = row_rstd16(ss, row);
                bf16_t* rowp = O + (size_t)row * 4096 + col0;
#pragma unroll
                for (int bj = 0; bj < 2; ++bj) { f32x4 v0 = acc[ai][bj][m][0] * rs, v1 = acc[ai][bj][m][1] * rs;
#pragma unroll
                    for (int e = 0; e < 4; ++e) { const float a0 = fmaxf(v0[e], 0.f), a1 = fmaxf(v1[e], 0.f); v0[e] = a0 * a0; v1[e] = a1 * a1; }
                    u32x4 w; w.x = cvt_pk_bf16(v0[0], v0[1]); w.y = cvt_pk_bf16(v0[2], v0[3]); w.z = cvt_pk_bf16(v1[0], v1[1]); w.w = cvt_pk_bf16(v1[2], v1[3]);
                    *(u32x4*)(rowp + bj * HALF) = w; } }
    }
};
struct EpiRes {
    static constexpr bool PERM = true, AFTER_DRAIN = false;
    const float* hin; float* hout; bf16_t* hb; float* ss_next; const float* rowss;
    __device__ __forceinline__ void operator()(const f32x4 (&acc)[2][2][4][2], const Unit& u, int wr, int wc, int fr_, int fq_) const {
        int fr = fr_, fq = fq_; asm volatile("" : "+v"(fr), "+v"(fq));
        const int row0 = u.pm * BM + wr * 64 + fr; const int col0 = u.pn * BM + wc * 32 + 8 * fq;
#pragma unroll
        for (int ai = 0; ai < 2; ++ai)
#pragma unroll
            for (int m = 0; m < 4; ++m) { const int row = row0 + ai * HALF + m * 16; const float sc = rowss ? row_rstd8(rowss, row) : 1.0f;
                const size_t off = (size_t)row * 1024 + col0; float q = 0.f;
#pragma unroll
                for (int bj = 0; bj < 2; ++bj) { const f32x4 h0 = *(const f32x4*)(hin + off + bj * HALF), h1 = *(const f32x4*)(hin + off + bj * HALF + 4);
                    const f32x4 v0 = h0 + acc[ai][bj][m][0] * sc, v1 = h1 + acc[ai][bj][m][1] * sc;
                    *(f32x4*)(hout + off + bj * HALF) = v0; *(f32x4*)(hout + off + bj * HALF + 4) = v1;
                    u32x4 w; w.x = cvt_pk_bf16(v0[0], v0[1]); w.y = cvt_pk_bf16(v0[2], v0[3]); w.z = cvt_pk_bf16(v1[0], v1[1]); w.w = cvt_pk_bf16(v1[2], v1[3]);
                    *(u32x4*)(hb + off + bj * HALF) = w;
                    q += (v0[0] * v0[0] + v0[1] * v0[1]) + (v0[2] * v0[2] + v0[3] * v0[3]) + (v1[0] * v1[0] + v1[1] * v1[1]) + (v1[2] * v1[2] + v1[3] * v1[3]); }
                q += __shfl_xor(q, 16); q += __shfl_xor(q, 32);
                if (fq == 0) ss_next[(size_t)row * 16 + u.pn * 4 + wc] = q;
                asm volatile("" ::: "memory"); }
    }
};

template <class Epi, class Sched, bool ALIGN_EPI = false, bool SP2 = false>
__device__ __forceinline__ void gemm_phase(PG8_LAS unsigned char* lds, const Gemm g, const Sched& S, const Epi& E) {
    int tid = threadIdx.x; asm volatile("" : "+v"(tid));
    const int wid = __builtin_amdgcn_readfirstlane(tid >> 6), lane = tid & 63, wr = wid >> 2, wc = wid & 3, fr = lane & 15, fq = lane >> 4;
    const int K = g.K, nt = K / BK;
    unsigned voffA[2], voffB[2];
#pragma unroll
    for (int i = 0; i < 2; ++i) { int R, C; stage_rc(tid * 16 + i * 8192, R, C); const int Rb = Epi::PERM ? ((R & ~31) + perm32(R & 31)) : R;
        voffA[i] = (unsigned)(R * K + C) * 2u; voffB[i] = (unsigned)(Rb * K + C) * 2u; }
    const size_t kstep = (size_t)(BK * 2);
    const size_t hstep = (size_t)HALF * K * 2;
    const size_t tstep = 2 * hstep;
    const unsigned ldsw = (unsigned)wid * 1024u;
    const int aoff = lds_byte(wr * 64 + fr, fq * 8), boff = lds_byte(wc * 32 + fr, fq * 8);
#define PG8_SA(b, h) (((b) * 2 + (h)) * HTB)
#define PG8_SB(b, h) ((4 + (b) * 2 + (h)) * HTB)
#define PG8_STAGE(bufoff, gbase, voff) do { _Pragma("unroll") for (int _i = 0; _i < 2; ++_i) \
        __builtin_amdgcn_global_load_lds((const unsigned*)((const char*)(gbase) + (voff)[_i]), (PG8_LAS unsigned*)(lds + (bufoff) + ldsw + _i * 8192), 16, 0, 0); } while (0)
#define PG8_LDA(dst, b, h) do { _Pragma("unroll") for (int m = 0; m < 4; ++m) _Pragma("unroll") for (int k = 0; k < 2; ++k) dst[m][k] = *(const PG8_LAS bf16x8*)(lds + PG8_SA(b, h) + aoff + m * 2048 + k * 1024); } while (0)
#define PG8_LDB(dst, b, h) do { _Pragma("unroll") for (int n = 0; n < 2; ++n) _Pragma("unroll") for (int k = 0; k < 2; ++k) dst[n][k] = *(const PG8_LAS bf16x8*)(lds + PG8_SB(b, h) + boff + n * 2048 + k * 1024); } while (0)
#define PG8_MMA(ai, bj, At, Bt) do { __builtin_amdgcn_s_setprio(1); _Pragma("unroll") for (int m = 0; m < 4; ++m) _Pragma("unroll") for (int n = 0; n < 2; ++n) _Pragma("unroll") for (int k = 0; k < 2; ++k) \
        acc[ai][bj][m][n] = __builtin_amdgcn_mfma_f32_16x16x32_bf16(Bt[n][k], At[m][k], acc[ai][bj][m][n], 0, 0, 0); __builtin_amdgcn_s_setprio(0); } while (0)
#define PG8_WAIT_V(n) asm volatile("s_waitcnt vmcnt(" #n ")" ::: "memory")
#define PG8_WAIT_L(n) asm volatile("s_waitcnt lgkmcnt(" #n ")" ::: "memory")
#define PG8_BAR __builtin_amdgcn_s_barrier()
#define PG8_SCHED __builtin_amdgcn_sched_barrier(0)
    Unit cur, nxt; int ui = 0;
    if (!S.next(0, cur)) return;
    f32x4 acc[2][2][4][2];
#pragma unroll
    for (int a = 0; a < 2; ++a)
#pragma unroll
        for (int b = 0; b < 2; ++b)
#pragma unroll
            for (int m = 0; m < 4; ++m)
#pragma unroll
                for (int n = 0; n < 2; ++n) acc[a][b][m][n] = (f32x4){0.f, 0.f, 0.f, 0.f};
    bf16x8 At[4][2], B0[2][2], B1[2][2];
    const char* cA = (const char*)g.A + (size_t)cur.pm * tstep; const char* cB = (const char*)g.Bt + (size_t)cur.pn * tstep;
    S.a_ready(cur);
    if constexpr (SP2) {
        PG8_STAGE(PG8_SB(0, 0), cB, voffB); PG8_STAGE(PG8_SB(0, 1), cB + hstep, voffB); PG8_STAGE(PG8_SA(0, 0), cA, voffA); PG8_STAGE(PG8_SA(0, 1), cA + hstep, voffA);
        if (wr == 1) PG8_BAR;
        PG8_WAIT_V(2); PG8_BAR;
        PG8_STAGE(PG8_SB(1, 0), cB + kstep, voffB); PG8_STAGE(PG8_SA(1, 0), cA + kstep, voffA); PG8_STAGE(PG8_SB(1, 1), cB + hstep + kstep, voffB);
        PG8_WAIT_V(6); PG8_BAR;
    } else {
        PG8_STAGE(PG8_SB(0, 0), cB, voffB); PG8_STAGE(PG8_SA(0, 0), cA, voffA); PG8_STAGE(PG8_SB(0, 1), cB + hstep, voffB); PG8_STAGE(PG8_SA(0, 1), cA + hstep, voffA);
        if (wr == 1) PG8_BAR;
        PG8_WAIT_V(4); PG8_BAR;
        PG8_STAGE(PG8_SB(1, 0), cB + kstep, voffB); PG8_STAGE(PG8_SA(1, 0), cA + kstep, voffA); PG8_STAGE(PG8_SB(1, 1), cB + hstep + kstep, voffB);
        PG8_WAIT_V(6); PG8_BAR;
    }
    for (;;) {
        const bool has_next = S.next(ui + 1, nxt);
        const char* nA = has_next ? (const char*)g.A + (size_t)nxt.pm * tstep : cA; const char* nB = has_next ? (const char*)g.Bt + (size_t)nxt.pn * tstep : cB;
        for (int t = 0; t < nt; t += 2) {
            const bool last = (t == nt - 2);
            const char* a1 = cA + (size_t)(t + 1) * kstep;
            const char* a2 = last ? nA : cA + (size_t)(t + 2) * kstep; const char* b2 = last ? nB : cB + (size_t)(t + 2) * kstep;
            const char* a3 = a2 + kstep; const char* b3 = b2 + kstep;
            if (last && has_next) S.a_ready(nxt);
            if constexpr (SP2) {
            PG8_LDB(B0, 0, 0); PG8_LDB(B1, 0, 1); PG8_SCHED; PG8_LDA(At, 0, 0); PG8_STAGE(PG8_SA(1, 1), a1 + hstep, voffA);
            PG8_WAIT_V(8); PG8_WAIT_L(0); PG8_BAR; PG8_MMA(0, 0, At, B0); PG8_MMA(0, 1, At, B1); PG8_BAR; PG8_SCHED;
            PG8_LDA(At, 0, 1); PG8_STAGE(PG8_SB(0, 0), b2, voffB); PG8_STAGE(PG8_SB(0, 1), b2 + hstep, voffB); PG8_STAGE(PG8_SA(0, 0), a2, voffA);
            PG8_WAIT_V(8); PG8_WAIT_L(0); PG8_BAR; PG8_MMA(1, 0, At, B0); PG8_MMA(1, 1, At, B1); PG8_BAR; PG8_SCHED;
            PG8_LDB(B0, 1, 0); PG8_LDB(B1, 1, 1); PG8_SCHED; PG8_LDA(At, 1, 0); PG8_STAGE(PG8_SA(0, 1), a2 + hstep, voffA);
            PG8_WAIT_V(8); PG8_WAIT_L(0); PG8_BAR; PG8_MMA(0, 0, At, B0); PG8_MMA(0, 1, At, B1); PG8_BAR; PG8_SCHED;
            PG8_LDA(At, 1, 1); PG8_STAGE(PG8_SB(1, 0), b3, voffB); PG8_STAGE(PG8_SB(1, 1), b3 + hstep, voffB); PG8_STAGE(PG8_SA(1, 0), a3, voffA);
            PG8_WAIT_V(8); PG8_WAIT_L(0); PG8_BAR; PG8_MMA(1, 0, At, B0); PG8_MMA(1, 1, At, B1); PG8_BAR; PG8_SCHED;
            } else {
            PG8_LDB(B0, 0, 0); PG8_SCHED; PG8_LDA(At, 0, 0); PG8_STAGE(PG8_SA(1, 1), a1 + hstep, voffA);
            PG8_WAIT_L(8); PG8_BAR; PG8_WAIT_L(0); PG8_MMA(0, 0, At, B0); PG8_BAR; PG8_SCHED;
            PG8_LDB(B1, 0, 1); PG8_STAGE(PG8_SB(0, 0), b2, voffB);
            PG8_BAR; PG8_WAIT_L(0); PG8_MMA(0, 1, At, B1); PG8_BAR;
            PG8_LDA(At, 0, 1); PG8_STAGE(PG8_SA(0, 0), a2, voffA);
            PG8_BAR; PG8_WAIT_L(0); PG8_MMA(1, 0, At, B0); PG8_BAR; PG8_SCHED;
            PG8_STAGE(PG8_SB(0, 1), b2 + hstep, voffB);
            PG8_WAIT_V(6); PG8_BAR; PG8_MMA(1, 1, At, B1); PG8_BAR;
            PG8_LDB(B0, 1, 0); PG8_SCHED; PG8_LDA(At, 1, 0); PG8_STAGE(PG8_SA(0, 1), a2 + hstep, voffA);
            PG8_WAIT_L(8); PG8_BAR; PG8_WAIT_L(0); PG8_MMA(0, 0, At, B0); PG8_BAR; PG8_SCHED;
            PG8_LDB(B1, 1, 1); PG8_STAGE(PG8_SB(1, 0), b3, voffB);
            PG8_BAR; PG8_WAIT_L(0); PG8_MMA(0, 1, At, B1); PG8_BAR;
            PG8_LDA(At, 1, 1); PG8_STAGE(PG8_SA(1, 0), a3, voffA);
            PG8_BAR; PG8_WAIT_L(0); PG8_MMA(1, 0, At, B0); PG8_BAR; PG8_SCHED;
            PG8_STAGE(PG8_SB(1, 1), b3 + hstep, voffB);
            PG8_WAIT_V(6); PG8_BAR; PG8_MMA(1, 1, At, B1); PG8_BAR;
            }
        }
        if constexpr (ALIGN_EPI) { if (wr == 0) PG8_BAR; }
        if constexpr (!Epi::AFTER_DRAIN) { E(acc, cur, wr, wc, fr, fq); S.done(cur); }
        if (!has_next) break;
#pragma unroll
        for (int a = 0; a < 2; ++a)
#pragma unroll
            for (int b = 0; b < 2; ++b)
#pragma unroll
                for (int m = 0; m < 4; ++m)
#pragma unroll
                    for (int n = 0; n < 2; ++n) acc[a][b][m][n] = (f32x4){0.f, 0.f, 0.f, 0.f};
        cur = nxt; cA = nA; cB = nB; ++ui;
        if constexpr (ALIGN_EPI) { if (wr == 1) PG8_BAR; }
    }
    PG8_WAIT_V(0);
    if constexpr (!ALIGN_EPI) { if (wr == 0) PG8_BAR; }
    PG8_BAR;
    if constexpr (Epi::AFTER_DRAIN) { E.fused(acc, cur, wr, wc, fr, fq, lds, wid, lane); S.done(cur); }
#undef PG8_SA
#undef PG8_SB
#undef PG8_STAGE
#undef PG8_LDA
#undef PG8_LDB
#undef PG8_MMA
#undef PG8_WAIT_V
#undef PG8_WAIT_L
#undef PG8_BAR
#undef PG8_SCHED
}
}

#define LAS __attribute__((address_space(3)))
typedef unsigned short bf16_t;
typedef short bf16x8 __attribute__((ext_vector_type(8)));
typedef float f32x4 __attribute__((ext_vector_type(4)));
typedef unsigned u32x4 __attribute__((ext_vector_type(4)));
typedef unsigned u32x2 __attribute__((ext_vector_type(2)));
constexpr int NWAVES = 8, NTHREADS = 512;
constexpr int M_TOK = 32768, DMODEL = 1024, NCH = 512  , NITEM = 4096  ;
constexpr float EPS = 1e-6f;
constexpr size_t MiB = 1u << 20;
constexpr size_t PLANE = (size_t)M_TOK * 1024;
constexpr size_t WS_SS = 0;
constexpr size_t WS_LB = 1536 * 1024;
constexpr size_t WS_WGI = 2 * MiB, WS_WGO = 19 * MiB, WS_WHI = 23 * MiB, WS_WHO = 39 * MiB, WS_WUP = 43 * MiB, WS_WDN = 75 * MiB;
constexpr size_t WS_PROJ = 108 * MiB;
constexpr size_t WS_HB = 364 * MiB;
constexpr size_t WS_AQK = 428 * MiB;
constexpr size_t WS_HALO = 460 * MiB;
constexpr size_t WS_AB = 470 * MiB;
constexpr size_t WS_DEC = 472 * MiB;
constexpr size_t WS_SSA = 474 * MiB, WS_SSB = 476 * MiB;
constexpr size_t WS_SSO = 478 * MiB;
constexpr size_t WS_END = 480 * MiB;
constexpr int GDN_NPAD = 4352;
constexpr int LDS_BYTES = 147456;

__device__ __forceinline__ float bf2f(unsigned v) { return __uint_as_float(v << 16); }
__device__ __forceinline__ float bflo(unsigned w) { return __uint_as_float(w << 16); }
__device__ __forceinline__ float bfhi(unsigned w) { return __uint_as_float(w & 0xffff0000u); }
__device__ __forceinline__ unsigned f2bf(float f) { unsigned u = __float_as_uint(f); return (u + 0x7fffu + ((u >> 16) & 1u)) >> 16; }
__device__ __forceinline__ unsigned pk2(float lo, float hi) { return pg8::cvt_pk_bf16(lo, hi); }
__device__ __forceinline__ float sigmoidf_(float x) { return 1.0f / (1.0f + __expf(-x)); }
__device__ __forceinline__ float siluf_(float x) { return x / (1.0f + __expf(-x)); }
__device__ __forceinline__ float wave_sum(float v) {
#pragma unroll
    for (int o = 1; o < 64; o <<= 1) v += __shfl_xor(v, o);
    return v;
}
#define LDS_WAIT() asm volatile("s_waitcnt lgkmcnt(0)" ::: "memory")

template <int K> __device__ __forceinline__ f32x4 mm_tile(const LAS bf16_t* A1, int s1, const LAS bf16_t* A2, int s2, f32x4 acc, int lane) {
    const LAS bf16_t* p1 = A1 + (lane & 15) * s1 + (lane >> 4) * 8;
    const LAS bf16_t* p2 = A2 + (lane & 15) * s2 + (lane >> 4) * 8;
#pragma unroll
    for (int k0 = 0; k0 < K; k0 += 32) {
        const bf16x8 a = *(const LAS bf16x8*)(p1 + k0); const bf16x8 b = *(const LAS bf16x8*)(p2 + k0);
        acc = __builtin_amdgcn_mfma_f32_16x16x32_bf16(a, b, acc, 0, 0, 0);
    }
    return acc;
}

#define XB_TMO      128
#define XB_XCNT(j)  (256  + 64 * (j))
#define XB_XSUB(j)  (1280 + 64 * (j))
#define XB_XGEN(j)  (2304 + 64 * (j))
#define XB_TOP      3328
#define XB_TOPGEN   3392
#define XCD_BAR_WORDS 3456
#define XB_SPIN_CAP (1u << 18)

__device__ __forceinline__ unsigned xb_ld(unsigned* p)              { return __hip_atomic_load(p, __ATOMIC_RELAXED, __HIP_MEMORY_SCOPE_AGENT); }
__device__ __forceinline__ unsigned xb_add(unsigned* p, unsigned v) { return __hip_atomic_fetch_add(p, v, __ATOMIC_RELAXED, __HIP_MEMORY_SCOPE_AGENT); }
__device__ __forceinline__ unsigned xb_xcc_id() { return (unsigned)__builtin_amdgcn_s_getreg((3 << 11) | 20) & 0xFu; }
#define XB_SPIN(cond, bar) do { unsigned _sp = 0; while (cond) { __builtin_amdgcn_s_sleep(1); \
    if ((++_sp & 255u) == 0u) { if (xb_ld(&(bar)[XB_TMO])) break; if (_sp > XB_SPIN_CAP) { atomicAdd(&(bar)[XB_TMO], 1u); break; } } } } while (0)

struct XcdBarrier {
    unsigned* bar; unsigned x;
    volatile LAS unsigned* st;
};

__device__ __forceinline__ XcdBarrier xcd_barrier_post(unsigned* bar, volatile LAS unsigned* st) {
    XcdBarrier b; b.bar = bar; b.x = xb_xcc_id(); b.st = st;
    if (threadIdx.x == 0) (void)xb_add(&bar[XB_XCNT(b.x)], 1u);
    return b;
}
__device__ __forceinline__ void xcd_barrier_complete(unsigned* bar, unsigned x, unsigned& nloc, unsigned& nx) {
    const unsigned G = gridDim.x * gridDim.y * gridDim.z;
    unsigned sum, cnt, mine, sp = 0u;
    for (;;) {
        sum = 0u; cnt = 0u; mine = 0u;
#pragma unroll
        for (unsigned j = 0; j < 16; ++j) { const unsigned c = xb_ld(&bar[XB_XCNT(j)]); sum += c; cnt += (c > 0u) ? 1u : 0u; mine = (j == x) ? c : mine; }
        if (sum == G) break;
        __builtin_amdgcn_s_sleep(1);
        if ((++sp & 255u) == 0u) { if (xb_ld(&bar[XB_TMO])) break; if (sp > XB_SPIN_CAP) { atomicAdd(&bar[XB_TMO], 1u); break; } }
    }
    nloc = mine > 0u ? mine : 1u; nx = cnt > 0u ? cnt : 1u;
}

__device__ __forceinline__ void xcd_barrier(const XcdBarrier& b) {
    asm volatile("s_waitcnt vmcnt(0)" ::: "memory");
    __syncthreads();
    if (threadIdx.x == 0) {
        unsigned* bar = b.bar;
        __builtin_amdgcn_s_waitcnt(0);
        unsigned nloc = b.st[0], nx = b.st[1];
        if (nloc == 0u) { xcd_barrier_complete(bar, b.x, nloc, nx); b.st[0] = nloc; b.st[1] = nx; }
        const unsigned old = xb_add(&bar[XB_XSUB(b.x)], 1u);
        const unsigned gen = old / nloc;
        if (old + 1u == (gen + 1u) * nloc) {
            __builtin_amdgcn_fence(__ATOMIC_RELEASE, "agent");
            asm volatile("s_waitcnt vmcnt(0)" ::: "memory");
            const unsigned og = xb_add(&bar[XB_TOP], 1u);
            const unsigned tg = og / nx;
            if (og + 1u == (tg + 1u) * nx) xb_add(&bar[XB_TOPGEN], 1u);
            else XB_SPIN(xb_ld(&bar[XB_TOPGEN]) == tg, bar);
            __builtin_amdgcn_fence(__ATOMIC_ACQUIRE, "agent");
            xb_add(&bar[XB_XGEN(b.x)], 1u);
            asm volatile("s_waitcnt vmcnt(0)" ::: "memory");
        } else {
            XB_SPIN(xb_ld(&bar[XB_XGEN(b.x)]) == gen, bar);
            __builtin_amdgcn_fence(__ATOMIC_ACQUIRE, "agent");
            asm volatile("s_waitcnt vmcnt(0)" ::: "memory");
        }
    }
    __syncthreads();
}
__device__ __forceinline__ void transpose_item(const float* W, int K, int Nsrc, int Npad, const float* nw, bf16_t* WT, LAS float* scr, int item, int lane) {
    const int nblk = Npad / 32, kb = item / nblk, nb = item % nblk, k0 = 64 * kb, n0 = 32 * nb;
#pragma unroll 8
    for (int i = 0; i < 32; ++i) { const int kk = 2 * i + (lane >> 5); const int n = n0 + (lane & 31);
        float v = (n < Nsrc) ? W[(size_t)(k0 + kk) * Nsrc + n] : 0.f; if (nw) v *= nw[k0 + kk]; scr[kk * 33 + (lane & 31)] = v; }
    LDS_WAIT(); asm volatile("" ::: "memory");
    const int c = lane & 7;
#pragma unroll
    for (int j = 0; j < 4; ++j) { const int n = (lane >> 3) + 8 * j; const LAS float* s = scr + (8 * c) * 33 + n;
        u32x4 o; o.x = pk2(s[0 * 33], s[1 * 33]); o.y = pk2(s[2 * 33], s[3 * 33]); o.z = pk2(s[4 * 33], s[5 * 33]); o.w = pk2(s[6 * 33], s[7 * 33]);
        *(u32x4*)(WT + (size_t)(n0 + n) * K + k0 + 8 * c) = o; }
    LDS_WAIT(); asm volatile("" ::: "memory");
}

struct Args { const float* in[16]; float* out; unsigned char* ws; };

__device__ __forceinline__ void prologue(const Args& a, LAS unsigned char* lds, int tid) {
    const int lane = tid & 63, wave = __builtin_amdgcn_readfirstlane(tid >> 6);
    unsigned char* ws = a.ws;
    LAS float* scr = (LAS float*)(lds + wave * 16384);
    const int gw = blockIdx.x * NWAVES + wave, NGW = gridDim.x * NWAVES;
    const float* gdn_w_in = a.in[1]; const float* gdn_w_out = a.in[6]; const float* hgrn_w_in = a.in[7]; const float* hgrn_w_out = a.in[10];
    const float* norm_mix = a.in[11]; const float* norm_mlp = a.in[12]; const float* w_up = a.in[13]; const float* w_down = a.in[14];
    constexpr int I_GI = 16 * (GDN_NPAD / 32), I_SQ = 16 * 32, I_HI = 16 * 128, I_UP = 16 * 128, I_DN = 64 * 32;
    constexpr int NITEMS = 2 * I_GI + 2 * I_SQ + 2 * I_HI + 2 * I_SQ + 4 * I_UP + 4 * I_DN;
    for (int it = gw; it < NITEMS; it += NGW) {
        int r = it;
        if (r < 2 * I_GI) { const int j = r / I_GI; r -= j * I_GI; transpose_item(gdn_w_in + (size_t)j * 1024 * 4112, 1024, 4112, GDN_NPAD, norm_mix + (2 * j) * 1024, (bf16_t*)(ws + WS_WGI) + (size_t)j * GDN_NPAD * 1024, scr, r, lane); continue; } r -= 2 * I_GI;
        if (r < 2 * I_SQ) { const int j = r / I_SQ; r -= j * I_SQ; transpose_item(gdn_w_out + (size_t)j * 1024 * 1024, 1024, 1024, 1024, nullptr, (bf16_t*)(ws + WS_WGO) + (size_t)j * 1024 * 1024, scr, r, lane); continue; } r -= 2 * I_SQ;
        if (r < 2 * I_HI) { const int j = r / I_HI; r -= j * I_HI; transpose_item(hgrn_w_in + (size_t)j * 1024 * 4096, 1024, 4096, 4096, norm_mix + (2 * j + 1) * 1024, (bf16_t*)(ws + WS_WHI) + (size_t)j * 4096 * 1024, scr, r, lane); continue; } r -= 2 * I_HI;
        if (r < 2 * I_SQ) { const int j = r / I_SQ; r -= j * I_SQ; transpose_item(hgrn_w_out + (size_t)j * 1024 * 1024, 1024, 1024, 1024, nullptr, (bf16_t*)(ws + WS_WHO) + (size_t)j * 1024 * 1024, scr, r, lane); continue; } r -= 2 * I_SQ;
        if (r < 4 * I_UP) { const int j = r / I_UP; r -= j * I_UP; transpose_item(w_up + (size_t)j * 1024 * 4096, 1024, 4096, 4096, norm_mlp + j * 1024, (bf16_t*)(ws + WS_WUP) + (size_t)j * 4096 * 1024, scr, r, lane); continue; } r -= 4 * I_UP;
        { const int j = r / I_DN; r -= j * I_DN; transpose_item(w_down + (size_t)j * 4096 * 1024, 4096, 1024, 1024, nullptr, (bf16_t*)(ws + WS_WDN) + (size_t)j * 1024 * 4096, scr, r, lane); }
    }
    float* SSB = (float*)(ws + WS_SSB); bf16_t* HB = (bf16_t*)(ws + WS_HB); const float* x = a.in[0];
    for (int m = gw; m < M_TOK; m += NGW) {
        const f32x4* xr = (const f32x4*)(x + (size_t)m * DMODEL) + lane; float s = 0.f; f32x4 v[4];
#pragma unroll
        for (int j = 0; j < 4; ++j) { v[j] = xr[64 * j]; s += (v[j][0] * v[j][0] + v[j][1] * v[j][1]) + (v[j][2] * v[j][2] + v[j][3] * v[j][3]); }
        s = wave_sum(s);
        u32x2* o8 = (u32x2*)(HB + (size_t)m * DMODEL) + lane;
#pragma unroll
        for (int j = 0; j < 4; ++j) { u32x2 w; w.x = pk2(v[j][0], v[j][1]); w.y = pk2(v[j][2], v[j][3]); o8[64 * j] = w; }
        if (lane < 16) SSB[(size_t)m * 16 + lane] = (lane == 0) ? s : 0.f;
    }
    if (blockIdx.x == 0) {
        const float* lg = a.in[8]; float* LB = (float*)(ws + WS_LB);
        for (int c = tid; c < 1024; c += NTHREADS) {
            const float l0 = lg[c], l1 = lg[1024 + c], l2 = lg[2048 + c], l3 = lg[3072 + c];
            const float mx = fmaxf(fmaxf(l0, l1), fmaxf(l2, l3));
            const float e0 = expf(l0 - mx), e1 = expf(l1 - mx), e2 = expf(l2 - mx), e3 = expf(l3 - mx); const float inv = 1.0f / (e0 + e1 + e2 + e3);
            LB[c] = e1 * inv; LB[1024 + c] = (e1 + e2 + e3) * inv;
        }
    }
}

__device__ __forceinline__ void gdn_prep(LAS unsigned char* lds, int tid, bf16_t* P, bf16_t* Wpl, bf16_t* AQK, const bf16_t* HALO, const float* AB, float* DEC,
                                         const float* conv_w, const float* a_log, const float* dt_bias) {
    asm volatile("" : "+v"(tid));
    const int lane = tid & 63, wave = __builtin_amdgcn_readfirstlane(tid >> 6);
    LAS bf16_t* QB = (LAS bf16_t*)lds; LAS bf16_t* KB = QB + 64 * 136; LAS bf16_t* VB = KB + 64 * 136;
    LAS float* LM = (LAS float*)(lds + 52224); LAS float* GC = LM + 4096; LAS float* BETA = GC + 64; LAS float* EG = BETA + 64; LAS float* BEG = EG + 64;
    for (int it = blockIdx.x; it < NITEM; it += gridDim.x) {
        const int h = it & 7, cidx = it >> 3, n = cidx & 31; const size_t row0 = (size_t)cidx * 64;
        if (tid < 384) {
            const int p = tid >> 7, seg = (tid >> 4) & 7, cg8 = tid & 15; const int ch = h * 128 + cg8 * 8;
            float cw[4][8];
#pragma unroll
            for (int kk = 0; kk < 4; ++kk) { const f32x4 c0 = *(const f32x4*)(conv_w + kk * 3072 + p * 1024 + ch), c1 = *(const f32x4*)(conv_w + kk * 3072 + p * 1024 + ch + 4);
#pragma unroll
                for (int e = 0; e < 4; ++e) { cw[kk][e] = c0[e]; cw[kk][4 + e] = c1[e]; } }
            const bf16_t* src = P + (size_t)p * PLANE + ch;
            u32x4 xr[11];
#pragma unroll
            for (int r = 0; r < 11; ++r) { const int t = seg * 8 - 3 + r;
                if (t >= 0) xr[r] = *(const u32x4*)(src + (row0 + t) * 1024);
                else if (n > 0) xr[r] = *(const u32x4*)(HALO + ((size_t)(cidx - 1) * 3 + (t + 3)) * 3072 + p * 1024 + ch);
                else xr[r] = (u32x4){0u, 0u, 0u, 0u}; }
            LAS bf16_t* dstb = QB + p * 64 * 136 + cg8 * 8;
#pragma unroll
            for (int tt = 0; tt < 8; ++tt) {
                float y[8];
#pragma unroll
                for (int e = 0; e < 8; ++e) y[e] = 0.f;
#pragma unroll
                for (int kk = 0; kk < 4; ++kk) { const u32x4 w = xr[tt + kk];
                    y[0] += cw[kk][0] * bflo(w.x); y[1] += cw[kk][1] * bfhi(w.x); y[2] += cw[kk][2] * bflo(w.y); y[3] += cw[kk][3] * bfhi(w.y);
                    y[4] += cw[kk][4] * bflo(w.z); y[5] += cw[kk][5] * bfhi(w.z); y[6] += cw[kk][6] * bflo(w.w); y[7] += cw[kk][7] * bfhi(w.w); }
                float ssq = 0.f;
#pragma unroll
                for (int e = 0; e < 8; ++e) { y[e] = siluf_(y[e]); ssq += y[e] * y[e]; }
                if (p < 2) {
                    ssq += __shfl_xor(ssq, 1); ssq += __shfl_xor(ssq, 2); ssq += __shfl_xor(ssq, 4); ssq += __shfl_xor(ssq, 8);
                    const float rn = rsqrtf(ssq + EPS) * (p == 0 ? 0.08838834764831845f : 1.0f);
#pragma unroll
                    for (int e = 0; e < 8; ++e) y[e] *= rn;
                }
                u32x4 o; o.x = pk2(y[0], y[1]); o.y = pk2(y[2], y[3]); o.z = pk2(y[4], y[5]); o.w = pk2(y[6], y[7]);
                *(LAS u32x4*)(dstb + (seg * 8 + tt) * 136) = o;
            }
        } else if (tid >= 448) {
            const float av = AB[(row0 + lane) * 16 + h], bv = AB[(row0 + lane) * 16 + 8 + h];
            const float beta = sigmoidf_(bv); const float xx = av + dt_bias[h];
            const float sp = fmaxf(xx, 0.f) + log1pf(expf(-fabsf(xx)));
            float g = -expf(a_log[h]) * sp;
#pragma unroll
            for (int o = 1; o < 64; o <<= 1) { const float v = __shfl_up(g, o); if (lane >= o) g += v; }
            GC[lane] = g; BETA[lane] = beta; { const float eg = expf(g); EG[lane] = eg; BEG[lane] = beta * eg; }
        }
        __syncthreads();
#pragma unroll
        for (int q4 = 0; q4 < 4; ++q4) {
            const int tt = wave * 4 + q4, sel = tt >> 4, mi = (tt & 15) >> 2, nj = tt & 3;
            f32x4 acc = (f32x4){0.f, 0.f, 0.f, 0.f};
            if (nj <= mi) acc = mm_tile<128>((sel ? QB : KB) + mi * 16 * 136, 136, KB + nj * 16 * 136, 136, acc, lane);
            const int jc = nj * 16 + (lane & 15); const float gj = GC[jc];
#pragma unroll
            for (int jj = 0; jj < 4; ++jj) { const int i = mi * 16 + (lane >> 4) * 4 + jj;
                if (sel == 0) { float val = 0.f; if (jc < i) val = BETA[i] * acc[jj] * __expf(GC[i] - gj); LM[i * 64 + jc] = val; }
                else { float val = 0.f; if (jc <= i) val = acc[jj] * __expf(GC[i] - gj); AQK[(size_t)it * 4096 + i * 64 + jc] = (bf16_t)f2bf(val); } }
        }
        __syncthreads();
        if (tid < 256) {
            const int c = tid; const bool isu = c < 128;
            unsigned a_src = (unsigned)(size_t)(isu ? (VB + c) : (KB + (c - 128))), a_fac = (unsigned)(size_t)(isu ? BETA : BEG), a_lm = (unsigned)(size_t)LM;
            asm volatile("" : "+v"(a_src), "+v"(a_fac), "+v"(a_lm));
            float sol[64];
#pragma unroll
            for (int i = 0; i < 64; ++i) {
                float r = bf2f(*(const LAS bf16_t*)(size_t)(a_src + i * 272)) * *(const LAS float*)(size_t)(a_fac + i * 4);
#pragma unroll
                for (int j4 = 0; j4 * 4 < i; ++j4) { const f32x4 l = *(const LAS f32x4*)(size_t)(a_lm + i * 256 + j4 * 16);
                    r -= l[0] * sol[j4 * 4];
                    if (j4 * 4 + 1 < i) r -= l[1] * sol[j4 * 4 + 1];
                    if (j4 * 4 + 2 < i) r -= l[2] * sol[j4 * 4 + 2];
                    if (j4 * 4 + 3 < i) r -= l[3] * sol[j4 * 4 + 3]; }
                sol[i] = r;
                asm volatile("" ::: "memory");
            }
            bf16_t* dst = (isu ? (P + 2 * PLANE) : Wpl) + row0 * 1024 + h * 128 + (c & 127);
#pragma unroll
            for (int i = 0; i < 64; ++i) dst[(size_t)i * 1024] = (bf16_t)f2bf(sol[i]);
        } else {
            const int t2 = tid - 256;
            { const int i = t2 >> 2, c0 = (t2 & 3) * 32; const float e = EG[i];
#pragma unroll
              for (int v = 0; v < 4; ++v) { const u32x4 w = *(const LAS u32x4*)(QB + i * 136 + c0 + v * 8); u32x4 o;
                  o.x = pk2(bflo(w.x) * e, bfhi(w.x) * e); o.y = pk2(bflo(w.y) * e, bfhi(w.y) * e); o.z = pk2(bflo(w.z) * e, bfhi(w.z) * e); o.w = pk2(bflo(w.w) * e, bfhi(w.w) * e);
                  *(u32x4*)(P + (row0 + i) * 1024 + h * 128 + c0 + v * 8) = o; } }
            { const int dk = t2 >> 1, cb = (t2 & 1) * 32; const float gl = GC[63];
#pragma unroll
              for (int v = 0; v < 4; ++v) { float t[8];
#pragma unroll
                  for (int e = 0; e < 8; ++e) { const int c = cb + v * 8 + e; t[e] = bf2f(KB[c * 136 + dk]) * __expf(gl - GC[c]); }
                  u32x4 o; o.x = pk2(t[0], t[1]); o.y = pk2(t[2], t[3]); o.z = pk2(t[4], t[5]); o.w = pk2(t[6], t[7]);
                  *(u32x4*)(P + PLANE + (row0 + (dk >> 1)) * 1024 + h * 128 + ((dk & 1) << 6) + cb + v * 8) = o; } }
            if (t2 < 128) DEC[(size_t)it * 128 + t2] = EG[63];
        }
        __syncthreads();
    }
}

__device__ __forceinline__ void hgrn_prep(LAS unsigned char* lds, int tid, bf16_t* P, bf16_t* AQK, float* DEC, const float* LBv) {
    asm volatile("" : "+v"(tid));
    const int lane = tid & 63, wave = __builtin_amdgcn_readfirstlane(tid >> 6);
    LAS bf16_t* QH = (LAS bf16_t*)lds; LAS bf16_t* KH = QH + 4 * 16 * 136; LAS float* TOT = (LAS float*)(lds + 14 * 16 * 136 * 2);
    const int d = tid & 127, s = tid >> 7;
    for (int it = blockIdx.x; it < NITEM; it += gridDim.x) {
        const int h = it & 7, cidx = it >> 3; const size_t row0 = (size_t)cidx * 64;
        const float lb = LBv[h * 128 + d];
        float qv[16], kv[16], gl[16]; float run = 0.f;
        bf16_t* q0 = P + (row0 + s * 16) * 1024 + h * 128 + d; const bf16_t* f0 = q0 + PLANE;
#pragma unroll
        for (int r = 0; r < 16; ++r) { const float qraw = bf2f(q0[(size_t)r * 1024]), fraw = bf2f(f0[(size_t)r * 1024]);
            const float sg = 1.0f / (1.0f + expf(-fraw)); const float ft = lb + (1.0f - lb) * sg; run += logf(ft); gl[r] = run;
            kv[r] = (1.0f - lb) / (1.0f + expf(fraw)); qv[r] = siluf_(qraw) * 0.08838834764831845f; }
        TOT[s * 128 + d] = run;
        __syncthreads();
        const float t0 = TOT[d], t1 = TOT[128 + d], t2 = TOT[256 + d], t3 = TOT[384 + d];
        const float gb = (s > 0 ? t0 : 0.f) + (s > 1 ? t1 : 0.f) + (s > 2 ? t2 : 0.f); const float glast = (t0 + t1) + (t2 + t3);
#pragma unroll
        for (int r = 0; r < 16; ++r) q0[(size_t)r * 1024] = (bf16_t)f2bf(qv[r] * __expf(gb + gl[r]));
        { float t[16];
#pragma unroll
          for (int r = 0; r < 16; ++r) t[r] = kv[r] * __expf(glast - gb - gl[r]);
          u32x4 o0, o1; o0.x = pk2(t[0], t[1]); o0.y = pk2(t[2], t[3]); o0.z = pk2(t[4], t[5]); o0.w = pk2(t[6], t[7]); o1.x = pk2(t[8], t[9]); o1.y = pk2(t[10], t[11]); o1.z = pk2(t[12], t[13]); o1.w = pk2(t[14], t[15]);
          bf16_t* kd = P + PLANE + (row0 + (d >> 1)) * 1024 + h * 128 + ((d & 1) << 6) + s * 16;
          *(u32x4*)kd = o0; *(u32x4*)(kd + 8) = o1; }
        if (s == 0) DEC[(size_t)it * 128 + d] = __expf(glast);
#pragma unroll
        for (int r = 0; r < 16; ++r) QH[(s * 16 + r) * 136 + d] = (bf16_t)f2bf(qv[r] * __expf(gl[r]));
#pragma unroll
        for (int st = 0; st < 4; ++st) {
            if (st >= s) {
                float off = 0.f;
                if (st > s) { if (s <= 0 && 0 < st) off += t0; if (s <= 1 && 1 < st) off += t1; if (s <= 2 && 2 < st) off += t2; }
                const int pidx = st * (st + 1) / 2 + s;
#pragma unroll
                for (int r = 0; r < 16; ++r) KH[(pidx * 16 + r) * 136 + d] = (bf16_t)f2bf(kv[r] * __expf(off - gl[r]));
            }
        }
        __syncthreads();
        for (int tile = wave; tile < 16; tile += 8) {
            const int st = tile >> 2, sj = tile & 3; f32x4 acc = (f32x4){0.f, 0.f, 0.f, 0.f};
            if (sj <= st) acc = mm_tile<128>(QH + st * 16 * 136, 136, KH + (st * (st + 1) / 2 + sj) * 16 * 136, 136, acc, lane);
            const int jc = sj * 16 + (lane & 15);
#pragma unroll
            for (int jj = 0; jj < 4; ++jj) { const int i = st * 16 + (lane >> 4) * 4 + jj; const float val = (sj <= st && jc <= i) ? acc[jj] : 0.f;
                AQK[(size_t)it * 4096 + i * 64 + jc] = (bf16_t)f2bf(val); }
        }
        __syncthreads();
    }
}

__device__ __forceinline__ void scan_phase(LAS unsigned char* lds, int tid, bool gdn, bf16_t* P, const bf16_t* Wpl, const bf16_t* AQK, const float* DEC, const float* nw, float* ss_o) {
    if (blockIdx.x >= 128) return;
    asm volatile("" : "+v"(tid));
    const int lane = tid & 63, wave = __builtin_amdgcn_readfirstlane(tid >> 6);
    const int b = blockIdx.x >> 3, h = blockIdx.x & 7;
    LAS bf16_t* ST = (LAS bf16_t*)lds; LAS bf16_t* VNT = (LAS bf16_t*)(lds + 34816); LAS bf16_t* WB = (LAS bf16_t*)(lds + 53248); LAS bf16_t* QD = (LAS bf16_t*)(lds + 70656);
    LAS bf16_t* AQ = (LAS bf16_t*)(lds + 88064); LAS bf16_t* KDT = (LAS bf16_t*)(lds + 97280); LAS float* DECV = (LAS float*)(lds + 115712); LAS float* OB = (LAS float*)(lds + 53248);
    f32x4 Sacc[8];
#pragma unroll
    for (int nt = 0; nt < 8; ++nt) Sacc[nt] = (f32x4){0.f, 0.f, 0.f, 0.f};
    for (int i = tid; i < 128 * 136 / 2; i += NTHREADS) ((LAS unsigned*)ST)[i] = 0u;
    const int mrow = wave * 16 + (lane >> 4) * 4;
    const LAS bf16_t* STw = ST + wave * 16 * 136; const LAS bf16_t* VNTw = VNT + wave * 16 * 72;
    __syncthreads();
    for (int n = 0; n < 32; ++n) {
        const int cidx = b * 32 + n, it = cidx * 8 + h; const size_t row0 = (size_t)cidx * 64;
#pragma unroll
        for (int i = 0; i < 2; ++i) { const int idx = tid + NTHREADS * i, r = idx >> 4, c8 = idx & 15; const size_t g = (row0 + r) * 1024 + h * 128 + c8 * 8;
            if (gdn) *(LAS u32x4*)(WB + r * 136 + c8 * 8) = *(const u32x4*)(Wpl + g);
            *(LAS u32x4*)(QD + r * 136 + c8 * 8) = *(const u32x4*)(P + g);
            *(LAS u32x4*)(KDT + (r * 2 + (c8 >> 3)) * 72 + (c8 & 7) * 8) = *(const u32x4*)(P + PLANE + g); }
        { const int r = tid >> 3, c8 = tid & 7; *(LAS u32x4*)(AQ + r * 72 + c8 * 8) = *(const u32x4*)(AQK + (size_t)it * 4096 + r * 64 + c8 * 8); }
        if (tid < 128) DECV[tid] = DEC[(size_t)it * 128 + tid];
        __syncthreads();
        f32x4 vn[4];
#pragma unroll
        for (int nt = 0; nt < 4; ++nt) { const u32x2 uu = *(const u32x2*)(P + 2 * PLANE + (row0 + nt * 16 + (lane & 15)) * 1024 + h * 128 + mrow);
            vn[nt] = (f32x4){bflo(uu.x), bfhi(uu.x), bflo(uu.y), bfhi(uu.y)}; }
        if (gdn) {
#pragma unroll
            for (int nt = 0; nt < 4; ++nt) { const f32x4 acc = mm_tile<128>(STw, 136, WB + nt * 16 * 136, 136, (f32x4){0.f, 0.f, 0.f, 0.f}, lane); vn[nt] = vn[nt] - acc; }
        }
#pragma unroll
        for (int nt = 0; nt < 4; ++nt)
#pragma unroll
            for (int jj = 0; jj < 4; ++jj) VNT[(mrow + jj) * 72 + nt * 16 + (lane & 15)] = (bf16_t)f2bf(vn[nt][jj]);
        LDS_WAIT();
        f32x4 o[4];
#pragma unroll
        for (int nt = 0; nt < 4; ++nt) { o[nt] = mm_tile<128>(STw, 136, QD + nt * 16 * 136, 136, (f32x4){0.f, 0.f, 0.f, 0.f}, lane);
            o[nt] = mm_tile<64>(VNTw, 72, AQ + nt * 16 * 72, 72, o[nt], lane); }
#pragma unroll
        for (int nt = 0; nt < 8; ++nt) { const float dcy = DECV[nt * 16 + (lane & 15)]; Sacc[nt] = Sacc[nt] * dcy;
            Sacc[nt] = mm_tile<64>(VNTw, 72, KDT + nt * 16 * 72, 72, Sacc[nt], lane); }
        __syncthreads();
#pragma unroll
        for (int nt = 0; nt < 8; ++nt)
#pragma unroll
            for (int jj = 0; jj < 4; ++jj) ST[(mrow + jj) * 136 + nt * 16 + (lane & 15)] = (bf16_t)f2bf(Sacc[nt][jj]);
#pragma unroll
        for (int nt = 0; nt < 4; ++nt) *(LAS f32x4*)(OB + (nt * 16 + (lane & 15)) * 132 + mrow) = o[nt];
        __syncthreads();
        { const int c = tid >> 3, seg = tid & 7; const size_t row = row0 + c; f32x4 ov[4]; float ssq = 0.f;
#pragma unroll
          for (int v = 0; v < 4; ++v) { ov[v] = *(const LAS f32x4*)(OB + c * 132 + seg * 16 + v * 4); ssq += (ov[v][0] * ov[v][0] + ov[v][1] * ov[v][1]) + (ov[v][2] * ov[v][2] + ov[v][3] * ov[v][3]); }
          ssq += __shfl_xor(ssq, 1); ssq += __shfl_xor(ssq, 2); ssq += __shfl_xor(ssq, 4);
          bf16_t* gp = P + 3 * PLANE + row * 1024 + h * 128 + seg * 16;
          const u32x4 g0 = *(const u32x4*)gp, g1 = *(const u32x4*)(gp + 8);
          const float rs = gdn ? rsqrtf(ssq * (1.0f / 128.0f) + EPS) : 1.0f;
          const float* nwp = nw + (gdn ? 0 : h * 128) + seg * 16;
          float gt[16]; gt[0] = bflo(g0.x); gt[1] = bfhi(g0.x); gt[2] = bflo(g0.y); gt[3] = bfhi(g0.y); gt[4] = bflo(g0.z); gt[5] = bfhi(g0.z); gt[6] = bflo(g0.w); gt[7] = bfhi(g0.w);
          gt[8] = bflo(g1.x); gt[9] = bfhi(g1.x); gt[10] = bflo(g1.y); gt[11] = bfhi(g1.y); gt[12] = bflo(g1.z); gt[13] = bfhi(g1.z); gt[14] = bflo(g1.w); gt[15] = bfhi(g1.w);
          float val[16];
#pragma unroll
          for (int e = 0; e < 16; ++e) val[e] = ov[e >> 2][e & 3] * rs * nwp[e] * siluf_(gt[e]);
          u32x4 o0, o1; o0.x = pk2(val[0], val[1]); o0.y = pk2(val[2], val[3]); o0.z = pk2(val[4], val[5]); o0.w = pk2(val[6], val[7]);
          o1.x = pk2(val[8], val[9]); o1.y = pk2(val[10], val[11]); o1.z = pk2(val[12], val[13]); o1.w = pk2(val[14], val[15]);
          *(u32x4*)gp = o0; *(u32x4*)(gp + 8) = o1;
          if (!gdn && seg == 0) ss_o[row * 8 + h] = ssq; }
        __syncthreads();
    }
}

__global__ void __launch_bounds__(NTHREADS, 2) mega_fwd(Args a) {
    extern __shared__ __attribute__((aligned(16))) unsigned char lds_raw[];
    LAS unsigned char* lds = (LAS unsigned char*)lds_raw;
    cg::grid_group grid = cg::this_grid();
    const int tid = threadIdx.x;
    unsigned char* ws = a.ws;
    float* SSA = (float*)(ws + WS_SSA); float* SSB = (float*)(ws + WS_SSB); float* SSO = (float*)(ws + WS_SSO); bf16_t* P = (bf16_t*)(ws + WS_PROJ); bf16_t* HB = (bf16_t*)(ws + WS_HB); bf16_t* AQK = (bf16_t*)(ws + WS_AQK);
    bf16_t* HALO = (bf16_t*)(ws + WS_HALO); float* AB = (float*)(ws + WS_AB); float* DEC = (float*)(ws + WS_DEC);
    const float* x = a.in[0]; float* out = a.out;
    const int G = gridDim.x;

    volatile LAS unsigned* misc = (volatile LAS unsigned*)(lds + 131072);
    if (tid < 4) misc[tid] = 0u;
    __syncthreads();
    const XcdBarrier bar = xcd_barrier_post((unsigned*)ws, misc);
#define GRID_BAR() xcd_barrier(bar)

    prologue(a, lds, tid);
    grid.sync();

    for (int i = 0; i < 4; ++i) {
        const int j = i >> 1; const bool gdn = (i & 1) == 0;
        {
            const bf16_t* Bt = gdn ? (const bf16_t*)(ws + WS_WGI) + (size_t)j * GDN_NPAD * 1024 : (const bf16_t*)(ws + WS_WHI) + (size_t)j * 4096 * 1024;
            pg8::Gemm g{HB, Bt, M_TOK, gdn ? GDN_NPAD : 4096, 1024}; pg8::StaticOrder S; S.init(M_TOK, g.N, G, (int)blockIdx.x);
            pg8::EpiProj E{P, PLANE, SSB, gdn ? AB : nullptr, gdn ? HALO : nullptr};
            pg8::gemm_phase<pg8::EpiProj, pg8::StaticOrder, true, true>(lds, g, S, E);
        }
        GRID_BAR();
        if (gdn) gdn_prep(lds, tid, P, HB, AQK, HALO, AB, DEC, a.in[2] + (size_t)j * 4 * 3072, a.in[3] + j * 8, a.in[4] + j * 8);
        else hgrn_prep(lds, tid, P, AQK, DEC, (const float*)(ws + WS_LB) + j * 1024);
        GRID_BAR();
        scan_phase(lds, tid, gdn, P, HB, AQK, DEC, gdn ? a.in[5] + j * 128 : a.in[9] + j * 1024, SSO);
        GRID_BAR();
        {
            const bf16_t* Bt = gdn ? (const bf16_t*)(ws + WS_WGO) + (size_t)j * 1024 * 1024 : (const bf16_t*)(ws + WS_WHO) + (size_t)j * 1024 * 1024;
            pg8::Gemm g{P + 3 * PLANE, Bt, M_TOK, 1024, 1024}; pg8::StaticOrder S; S.init(M_TOK, 1024, G, (int)blockIdx.x);
            pg8::EpiRes E{i == 0 ? x : out, out, HB, SSA, gdn ? nullptr : SSO};
            pg8::gemm_phase<pg8::EpiRes, pg8::StaticOrder, true, true>(lds, g, S, E);
        }
        GRID_BAR();
        {
            pg8::Gemm g{HB, (const bf16_t*)(ws + WS_WUP) + (size_t)i * 4096 * 1024, M_TOK, 4096, 1024}; pg8::StaticOrder S; S.init(M_TOK, 4096, G, (int)blockIdx.x);
            pg8::EpiUp E{P, SSA};
            pg8::gemm_phase<pg8::EpiUp, pg8::StaticOrder, true, true>(lds, g, S, E);
        }
        GRID_BAR();
        {
            pg8::Gemm g{P, (const bf16_t*)(ws + WS_WDN) + (size_t)i * 1024 * 4096, M_TOK, 1024, 4096}; pg8::StaticOrder S; S.init(M_TOK, 1024, G, (int)blockIdx.x);
            pg8::EpiRes E{out, out, HB, SSB, nullptr};
            pg8::gemm_phase<pg8::EpiRes, pg8::StaticOrder, true, true>(lds, g, S, E);
        }
        GRID_BAR();
    }
    {
        const int lane = tid & 63, wave = tid >> 6; const int gw = blockIdx.x * NWAVES + wave, NGW = G * NWAVES;
        const f32x4* nf = (const f32x4*)a.in[15] + lane;
        f32x4 wv[4];
#pragma unroll
        for (int jx = 0; jx < 4; ++jx) wv[jx] = nf[64 * jx];
        for (int m = gw; m < M_TOK; m += NGW) {
            const float rs = pg8::row_rstd16(SSB, m); f32x4* o = (f32x4*)(out + (size_t)m * DMODEL) + lane;
#pragma unroll
            for (int jx = 0; jx < 4; ++jx) o[64 * jx] = o[64 * jx] * rs * wv[jx];
        }
    }
}

extern "C" void kernel_launch(void* const* d_in, const int* in_sizes, int n_in, void* d_out, int out_size, void* d_ws, size_t ws_size, hipStream_t stream) {
    static int grid = 0;
    if (grid == 0) {
        if (n_in != 16 || out_size != M_TOK * DMODEL || ws_size < WS_END) { fprintf(stderr, "kernel_launch: unexpected shapes (n_in %d, out %d, ws %zu; need ws >= %zu)\n", n_in, out_size, ws_size, (size_t)WS_END); grid = -1; return; }
        int dev = 0, cus = 0, per_cu = 0;
        (void)hipGetDevice(&dev); (void)hipDeviceGetAttribute(&cus, hipDeviceAttributeMultiprocessorCount, dev);
        (void)hipFuncSetAttribute((const void*)mega_fwd, hipFuncAttributeMaxDynamicSharedMemorySize, LDS_BYTES);
        if (hipOccupancyMaxActiveBlocksPerMultiprocessor(&per_cu, (const void*)mega_fwd, NTHREADS, LDS_BYTES) != hipSuccess || per_cu < 1) per_cu = 1;
        (void)hipGetLastError();
        grid = cus * (per_cu > 1 ? 1 : per_cu);
        if (grid <= 0) grid = 256;
    }
    if (grid < 0) return;
    Args a{};
    for (int i = 0; i < 16; ++i) a.in[i] = (const float*)d_in[i];
    a.out = (float*)d_out; a.ws = (unsigned char*)d_ws;
    (void)hipMemsetAsync(d_ws, 0, 16384, stream);
    void* args[] = {&a};
    hipError_t e = hipLaunchCooperativeKernel((const void*)mega_fwd, dim3(grid), dim3(NTHREADS), args, LDS_BYTES, stream);
    if (e != hipSuccess) fprintf(stderr, "cooperative launch failed: %s (grid %d)\n", hipGetErrorString(e), grid);
}
```

```cpp
#include <hip/hip_runtime.h>
#include <hip/hip_cooperative_groups.h>
#include <cstdio>
#include <cstdint>
namespace cg = cooperative_groups;
namespace pg8 {
#define PG8_LAS __attribute__((address_space(3)))
typedef unsigned short bf16_t;
typedef short bf16x8 __attribute__((ext_vector_type(8)));
typedef float f32x4 __attribute__((ext_vector_type(4)));
typedef unsigned u32x4 __attribute__((ext_vector_type(4)));
constexpr int BM = 256, BK = 64, HALF = 128, HTB = HALF * BK * 2  , STAGE_BYTES = 8 * HTB, NXCD = 8, WGM = 8;

__host__ __device__ __forceinline__ int lds_byte(int r, int c) { const int st = (r >> 4) * 2 + (c >> 5), rr = r & 15, cc = c & 31, ob = rr * 64 + cc * 2; return st * 1024 + (ob ^ (((ob >> 9) & 1) << 5)); }
__host__ __device__ __forceinline__ void stage_rc(int b, int& R, int& C) { const int st = b / 1024, sb = b % 1024, swz = sb ^ (((sb >> 9) & 1) << 5); R = (st >> 1) * 16 + swz / 64; C = (st & 1) * 32 + (swz % 64) / 2; }
__host__ __device__ __forceinline__ int perm32(int rho) { const int n = rho >> 4, i = rho & 15; return 8 * (i >> 2) + 4 * n + (i & 3); }

struct Unit { int pm, pn; };
struct Gemm { const bf16_t* A; const bf16_t* Bt; int M, N, K; };

struct StaticOrder {
    int nM, nN, nwg, G, c;
    __host__ __device__ void init(int M, int N, int G_, int c_) { nM = M / BM; nN = N / BM; nwg = nM * nN; G = G_; c = c_; }
    __host__ __device__ bool next(int i, Unit& u) const {
        const long L = (long)i * G + c; if (L >= nwg) return false;
        int wgid = (int)L; { const int q = nwg / NXCD, r = nwg % NXCD, xcd = wgid % NXCD, off = wgid / NXCD; wgid = (xcd < r ? xcd * (q + 1) : r * (q + 1) + (xcd - r) * q) + off; }
        const int nig = WGM * nN, gid = wgid / nig, fm = gid * WGM, gsz = (nM - fm) < WGM ? (nM - fm) : WGM;
        u.pm = fm + ((wgid % nig) % gsz); u.pn = (wgid % nig) / gsz; return true;
    }
    __device__ __forceinline__ void a_ready(const Unit&) const {}
    __device__ __forceinline__ void done(const Unit&) const {}
};


__device__ __forceinline__ unsigned cvt_pk_bf16(float lo, float hi) { unsigned r; asm volatile("v_cvt_pk_bf16_f32 %0, %1, %2" : "=v"(r) : "v"(lo), "v"(hi)); return r; }
constexpr float RMS_EPS = 1e-6f;
__device__ __forceinline__ float row_rstd16(const float* ssp, int row) {
    const f32x4* p = (const f32x4*)(ssp + (size_t)row * 16); const f32x4 a = p[0], b = p[1], c = p[2], d = p[3];
    const float s = (((a[0] + a[1]) + (a[2] + a[3])) + ((b[0] + b[1]) + (b[2] + b[3]))) + (((c[0] + c[1]) + (c[2] + c[3])) + ((d[0] + d[1]) + (d[2] + d[3])));
    return rsqrtf(s * (1.0f / 1024.0f) + RMS_EPS);
}
__device__ __forceinline__ float row_rstd8(const float* ssp, int row) {
    const f32x4* p = (const f32x4*)(ssp + (size_t)row * 8); const f32x4 a = p[0], b = p[1];
    const float s = ((a[0] + a[1]) + (a[2] + a[3])) + ((b[0] + b[1]) + (b[2] + b[3]));
    return rsqrtf(s * (1.0f / 1024.0f) + RMS_EPS);
}

struct EpiProj {
    static constexpr bool PERM = true, AFTER_DRAIN = false;
    bf16_t* O; size_t plane_stride; const float* ss; float* AB; bf16_t* halo;
    __device__ __forceinline__ void operator()(const f32x4 (&acc)[2][2][4][2], const Unit& u, int wr, int wc, int fr, int fq) const {
        const int row0 = u.pm * BM + wr * 64 + fr; const int colt = u.pn * BM;
        if (colt >= 4096) {
            if (wc == 0 && fq < 2) {
#pragma unroll
                for (int ai = 0; ai < 2; ++ai)
#pragma unroll
                    for (int m = 0; m < 4; ++m) { const int row = row0 + ai * HALF + m * 16; const float rs = row_rstd16(ss, row);
#pragma unroll
                        for (int n = 0; n < 2; ++n) { const f32x4 v = acc[ai][0][m][n] * rs; *(f32x4*)(AB + (size_t)row * 16 + 8 * fq + 4 * n) = v; } }
            }
            return;
        }
        const int plane = colt >> 10; bf16_t* base = O + (size_t)plane * plane_stride; const int col0 = (colt & 1023) + wc * 32 + 8 * fq;
#pragma unroll
        for (int ai = 0; ai < 2; ++ai)
#pragma unroll
            for (int m = 0; m < 4; ++m) { const int row = row0 + ai * HALF + m * 16; const float rs = row_rstd16(ss, row);
                bf16_t* rowp = base + (size_t)row * 1024 + col0;
#pragma unroll
                for (int bj = 0; bj < 2; ++bj) { const f32x4 v0 = acc[ai][bj][m][0] * rs, v1 = acc[ai][bj][m][1] * rs;
                    u32x4 w; w.x = cvt_pk_bf16(v0[0], v0[1]); w.y = cvt_pk_bf16(v0[2], v0[3]); w.z = cvt_pk_bf16(v1[0], v1[1]); w.w = cvt_pk_bf16(v1[2], v1[3]);
                    *(u32x4*)(rowp + bj * HALF) = w;
                    if (halo != nullptr && plane < 3 && m == 3 && fr >= 13) *(u32x4*)(halo + ((size_t)(row >> 6) * 3 + (fr - 13)) * 3072 + plane * 1024 + col0 + bj * HALF) = w; } }
    }
};
struct EpiUp {
    static constexpr bool PERM = true, AFTER_DRAIN = false;
    bf16_t* O; const float* ss;
    __device__ __forceinline__ void operator()(const f32x4 (&acc)[2][2][4][2], const Unit& u, int wr, int wc, int fr, int fq) const {
        const int row0 = u.pm * BM + wr * 64 + fr; const int col0 = u.pn * BM + wc * 32 + 8 * fq;
#pragma unroll
        for (int ai = 0; ai < 2; ++ai)
#pragma unroll
            for (int m = 0; m < 4; ++m) { const int row = row0 + ai * HALF + m * 16; const float rs = row_rstd16(ss, row);
                bf16_t* rowp = O + (size_t)row * 4096 + col0;
#pragma unroll
                for (int bj = 0; bj < 2; ++bj) { f32x4 v0 = acc[ai][bj][m][0] * rs, v1 = acc[ai][bj][m][1] * rs;
#pragma unroll
                    for (int e = 0; e < 4; ++e) { const float a0 = fmaxf(v0[e], 0.f), a1 = fmaxf(v1[e], 0.f); v0[e] = a0 * a0; v1[e] = a1 * a1; }
                    u32x4 w; w.x = cvt_pk_bf16(v0[0], v0[1]); w.y = cvt_pk_bf16(v0[2], v0[3]); w.z = cvt_pk_bf16(v1[0], v1[1]); w.w = cvt_pk_bf16(v1[2], v1[3]);
                    *(u32x4*)(rowp + bj * HALF) = w; } }
    }
};
struct EpiRes {
    static constexpr bool PERM = true, AFTER_DRAIN = false;
    const float* hin; float* hout; bf16_t* hb; float* ss_next; const float* rowss;
    __device__ __forceinline__ void operator()(const f32x4 (&acc)[2][2][4][2], const Unit& u, int wr, int wc, int fr_, int fq_) const {
        int fr = fr_, fq = fq_; asm volatile("" : "+v"(fr), "+v"(fq));
        const int row0 = u.pm * BM + wr * 64 + fr; const int col0 = u.pn * BM + wc * 32 + 8 * fq;
#pragma unroll
        for (int ai = 0; ai < 2; ++ai)
#pragma unroll
            for (int m = 0; m < 4; ++m) { const int row = row0 + ai * HALF + m * 16; const float sc = rowss ? row_rstd8(rowss, row) : 1.0f;
                const size_t off = (size_t)row * 1024 + col0; float q = 0.f;
#pragma unroll
                for (int bj = 0; bj < 2; ++bj) { const f32x4 h0 = *(const f32x4*)(hin + off + bj * HALF), h1 = *(const f32x4*)(hin + off + bj * HALF + 4);
                    const f32x4 v0 = h0 + acc[ai][bj][m][0] * sc, v1 = h1 + acc[ai][bj][m][1] * sc;
                    *(f32x4*)(hout + off + bj * HALF) = v0; *(f32x4*)(hout + off + bj * HALF + 4) = v1;
                    u32x4 w; w.x = cvt_pk_bf16(v0[0], v0[1]); w.y = cvt_pk_bf16(v0[2], v0[3]); w.z = cvt_pk_bf16(v1[0], v1[1]); w.w = cvt_pk_bf16(v1[2], v1[3]);
                    *(u32x4*)(hb + off + bj * HALF) = w;
                    q += (v0[0] * v0[0] + v0[1] * v0[1]) + (v0[2] * v0[2] + v0[3] * v0[3]) + (v1[0] * v1[0] + v1[1] * v1[1]) + (v1[2] * v1[2] + v1[3] * v1[3]); }
                q += __shfl_xor(q, 16); q += __shfl_xor(q, 32);
                if (fq == 0) ss_next[(size_t)row * 16 + u.pn * 4 + wc] = q;
                asm volatile("" ::: "memory"); }
    }
};

template <class Epi, class Sched, bool ALIGN_EPI = false, bool SP2 = false>
__device__ __forceinline__ void gemm_phase(PG8_LAS unsigned char* lds, const Gemm g, const Sched& S, const Epi& E) {
    int tid = threadIdx.x; asm volatile("" : "+v"(tid));
    const int wid = __builtin_amdgcn_readfirstlane(tid >> 6), lane = tid & 63, wr = wid >> 2, wc = wid & 3, fr = lane & 15, fq = lane >> 4;
    const int K = g.K, nt = K / BK;
    unsigned voffA[2], voffB[2];
#pragma unroll
    for (int i = 0; i < 2; ++i) { int R, C; stage_rc(tid * 16 + i * 8192, R, C); const int Rb = Epi::PERM ? ((R & ~31) + perm32(R & 31)) : R;
        voffA[i] = (unsigned)(R * K + C) * 2u; voffB[i] = (unsigned)(Rb * K + C) * 2u; }
    const size_t kstep = (size_t)(BK * 2);
    const size_t hstep = (size_t)HALF * K * 2;
    const size_t tstep = 2 * hstep;
    const unsigned ldsw = (unsigned)wid * 1024u;
    const int aoff = lds_byte(wr * 64 + fr, fq * 8), boff = lds_byte(wc * 32 + fr, fq * 8);
#define PG8_SA(b, h) (((b) * 2 + (h)) * HTB)
#define PG8_SB(b, h) ((4 + (b) * 2 + (h)) * HTB)
#define PG8_STAGE(bufoff, gbase, voff) do { _Pragma("unroll") for (int _i = 0; _i < 2; ++_i) \
        __builtin_amdgcn_global_load_lds((const unsigned*)((const char*)(gbase) + (voff)[_i]), (PG8_LAS unsigned*)(lds + (bufoff) + ldsw + _i * 8192), 16, 0, 0); } while (0)
#define PG8_LDA(dst, b, h) do { _Pragma("unroll") for (int m = 0; m < 4; ++m) _Pragma("unroll") for (int k = 0; k < 2; ++k) dst[m][k] = *(const PG8_LAS bf16x8*)(lds + PG8_SA(b, h) + aoff + m * 2048 + k * 1024); } while (0)
#define PG8_LDB(dst, b, h) do { _Pragma("unroll") for (int n = 0; n < 2; ++n) _Pragma("unroll") for (int k = 0; k < 2; ++k) dst[n][k] = *(const PG8_LAS bf16x8*)(lds + PG8_SB(b, h) + boff + n * 2048 + k * 1024); } while (0)
#define PG8_MMA(ai, bj, At, Bt) do { __builtin_amdgcn_s_setprio(1); _Pragma("unroll") for (int m = 0; m < 4; ++m) _Pragma("unroll") for (int n = 0; n < 2; ++n) _Pragma("unroll") for (int k = 0; k < 2; ++k) \
        acc[ai][bj][m][n] = __builtin_amdgcn_mfma_f32_16x16x32_bf16(Bt[n][k], At[m][k], acc[ai][bj][m][n], 0, 0, 0); __builtin_amdgcn_s_setprio(0); } while (0)
#define PG8_WAIT_V(n) asm volatile("s_waitcnt vmcnt(" #n ")" ::: "memory")
#define PG8_WAIT_L(n) asm volatile("s_waitcnt lgkmcnt(" #n ")" ::: "memory")
#define PG8_BAR __builtin_amdgcn_s_barrier()
#define PG8_SCHED __builtin_amdgcn_sched_barrier(0)
    Unit cur, nxt; int ui = 0;
    if (!S.next(0, cur)) return;
    f32x4 acc[2][2][4][2];
#pragma unroll
    for (int a = 0; a < 2; ++a)
#pragma unroll
        for (int b = 0; b < 2; ++b)
#pragma unroll
            for (int m = 0; m < 4; ++m)
#pragma unroll
                for (int n = 0; n < 2; ++n) acc[a][b][m][n] = (f32x4){0.f, 0.f, 0.f, 0.f};
    bf16x8 At[4][2], B0[2][2], B1[2][2];
    const char* cA = (const char*)g.A + (size_t)cur.pm * tstep; const char* cB = (const char*)g.Bt + (size_t)cur.pn * tstep;
    S.a_ready(cur);
    if constexpr (SP2) {
        PG8_STAGE(PG8_SB(0, 0), cB, voffB); PG8_STAGE(PG8_SB(0, 1), cB + hstep, voffB); PG8_STAGE(PG8_SA(0, 0), cA, voffA); PG8_STAGE(PG8_SA(0, 1), cA + hstep, voffA);
        if (wr == 1) PG8_BAR;
        PG8_WAIT_V(2); PG8_BAR;
        PG8_STAGE(PG8_SB(1, 0), cB + kstep, voffB); PG8_STAGE(PG8_SA(1, 0), cA + kstep, voffA); PG8_STAGE(PG8_SB(1, 1), cB + hstep + kstep, voffB);
        PG8_WAIT_V(6); PG8_BAR;
    } else {
        PG8_STAGE(PG8_SB(0, 0), cB, voffB); PG8_STAGE(PG8_SA(0, 0), cA, voffA); PG8_STAGE(PG8_SB(0, 1), cB + hstep, voffB); PG8_STAGE(PG8_SA(0, 1), cA + hstep, voffA);
        if (wr == 1) PG8_BAR;
        PG8_WAIT_V(4); PG8_BAR;
        PG8_STAGE(PG8_SB(1, 0), cB + kstep, voffB); PG8_STAGE(PG8_SA(1, 0), cA + kstep, voffA); PG8_STAGE(PG8_SB(1, 1), cB + hstep + kstep, voffB);
        PG8_WAIT_V(6); PG8_BAR;
    }
    for (;;) {
        const bool has_next = S.next(ui + 1, nxt);
        const char* nA = has_next ? (const char*)g.A + (size_t)nxt.pm * tstep : cA; const char* nB = has_next ? (const char*)g.Bt + (size_t)nxt.pn * tstep : cB;
        for (int t = 0; t < nt; t += 2) {
            const bool last = (t == nt - 2);
            const char* a1 = cA + (size_t)(t + 1) * kstep;
            const char* a2 = last ? nA : cA + (size_t)(t + 2) * kstep; const char* b2 = last ? nB : cB + (size_t)(t + 2) * kstep;
            const char* a3 = a2 + kstep; const char* b3 = b2 + kstep;
            if (last && has_next) S.a_ready(nxt);
            if constexpr (SP2) {
            PG8_LDB(B0, 0, 0); PG8_LDB(B1, 0, 1); PG8_SCHED; PG8_LDA(At, 0, 0); PG8_STAGE(PG8_SA(1, 1), a1 + hstep, voffA);
            PG8_WAIT_V(8); PG8_WAIT_L(0); PG8_BAR; PG8_MMA(0, 0, At, B0); PG8_MMA(0, 1, At, B1); PG8_BAR; PG8_SCHED;
            PG8_LDA(At, 0, 1); PG8_STAGE(PG8_SB(0, 0), b2, voffB); PG8_STAGE(PG8_SB(0, 1), b2 + hstep, voffB); PG8_STAGE(PG8_SA(0, 0), a2, voffA);
            PG8_WAIT_V(8); PG8_WAIT_L(0); PG8_BAR; PG8_MMA(1, 0, At, B0); PG8_MMA(1, 1, At, B1); PG8_BAR; PG8_SCHED;
            PG8_LDB(B0, 1, 0); PG8_LDB(B1, 1, 1); PG8_SCHED; PG8_LDA(At, 1, 0); PG8_STAGE(PG8_SA(0, 1), a2 + hstep, voffA);
            PG8_WAIT_V(8); PG8_WAIT_L(0); PG8_BAR; PG8_MMA(0, 0, At, B0); PG8_MMA(0, 1, At, B1); PG8_BAR; PG8_SCHED;
            PG8_LDA(At, 1, 1); PG8_STAGE(PG8_SB(1, 0), b3, voffB); PG8_STAGE(PG8_SB(1, 1), b3 + hstep, voffB); PG8_STAGE(PG8_SA(1, 0), a3, voffA);
            PG8_WAIT_V(8); PG8_WAIT_L(0); PG8_BAR; PG8_MMA(1, 0, At, B0); PG8_MMA(1, 1, At, B1); PG8_BAR; PG8_SCHED;
            } else {
            PG8_LDB(B0, 0, 0); PG8_SCHED; PG8_LDA(At, 0, 0); PG8_STAGE(PG8_SA(1, 1), a1 + hstep, voffA);
            PG8_WAIT_L(8); PG8_BAR; PG8_WAIT_L(0); PG8_MMA(0, 0, At, B0); PG8_BAR; PG8_SCHED;
            PG8_LDB(B1, 0, 1); PG8_STAGE(PG8_SB(0, 0), b2, voffB);
            PG8_BAR; PG8_WAIT_L(0); PG8_MMA(0, 1, At, B1); PG8_BAR;
            PG8_LDA(At, 0, 1); PG8_STAGE(PG8_SA(0, 0), a2, voffA);
            PG8_BAR; PG8_WAIT_L(0); PG8_MMA(1, 0, At, B0); PG8_BAR; PG8_SCHED;
            PG8_STAGE(PG8_SB(0, 1), b2 + hstep, voffB);
            PG8_WAIT_V(6); PG8_BAR; PG8_MMA(1, 1, At, B1); PG8_BAR;
            PG8_LDB(B0, 1, 0); PG8_SCHED; PG8_LDA(At, 1, 0); PG8_STAGE(PG8_SA(0, 1), a2 + hstep, voffA);
            PG8_WAIT_L(8); PG8_BAR; PG8_WAIT_L(0); PG8_MMA(0, 0, At, B0); PG8_BAR; PG8_SCHED;
            PG8_LDB(B1, 1, 1); PG8_STAGE(PG8_SB(1, 0), b3, voffB);
            PG8_BAR; PG8_WAIT_L(0); PG8_MMA(0, 1, At, B1); PG8_BAR;
            PG8_LDA(At, 1, 1); PG8_STAGE(PG8_SA(1, 0), a3, voffA);
            PG8_BAR; PG8_WAIT_L(0); PG8_MMA(1, 0, At, B0); PG8_BAR; PG8_SCHED;
            PG8_STAGE(PG8_SB(1, 1), b3 + hstep, voffB);
            PG8_WAIT_V(6); PG8_BAR; PG8_MMA(1, 1, At, B1); PG8_BAR;
            }
        }
        if constexpr (ALIGN_EPI) { if (wr == 0) PG8_BAR; }
        if constexpr (!Epi::AFTER_DRAIN) { E(acc, cur, wr, wc, fr, fq); S.done(cur); }
        if (!has_next) break;
#pragma unroll
        for (int a = 0; a < 2; ++a)
#pragma unroll
            for (int b = 0; b < 2; ++b)
#pragma unroll
                for (int m = 0; m < 4; ++m)
#pragma unroll
                    for (int n = 0; n < 2; ++n) acc[a][b][m][n] = (f32x4){0.f, 0.f, 0.f, 0.f};
        cur = nxt; cA = nA; cB = nB; ++ui;
        if constexpr (ALIGN_EPI) { if (wr == 1) PG8_BAR; }
    }
    PG8_WAIT_V(0);
    if constexpr (!ALIGN_EPI) { if (wr == 0) PG8_BAR; }
    PG8_BAR;
    if constexpr (Epi::AFTER_DRAIN) { E.fused(acc, cur, wr, wc, fr, fq, lds, wid, lane); S.done(cur); }
#undef PG8_SA
#undef PG8_SB
#undef PG8_STAGE
#undef PG8_LDA
#undef PG8_LDB
#undef PG8_MMA
#undef PG8_WAIT_V
#undef PG8_WAIT_L
#undef PG8_BAR
#undef PG8_SCHED
}
}

#define LAS __attribute__((address_space(3)))
typedef unsigned short bf16_t;
typedef short bf16x8 __attribute__((ext_vector_type(8)));
typedef float f32x4 __attribute__((ext_vector_type(4)));
typedef unsigned u32x4 __attribute__((ext_vector_type(4)));
typedef unsigned u32x2 __attribute__((ext_vector_type(2)));
constexpr int NWAVES = 8, NTHREADS = 512;
constexpr int M_TOK = 32768, DMODEL = 1024, NCH = 512  , NITEM = 4096  ;
constexpr float EPS = 1e-6f;
constexpr size_t MiB = 1u << 20;
constexpr size_t PLANE = (size_t)M_TOK * 1024;
constexpr size_t WS_SS = 0;
constexpr size_t WS_LB = 1536 * 1024;
constexpr size_t WS_WGI = 2 * MiB, WS_WGO = 19 * MiB, WS_WHI = 23 * MiB, WS_WHO = 39 * MiB, WS_WUP = 43 * MiB, WS_WDN = 75 * MiB;
constexpr size_t WS_PROJ = 108 * MiB;
constexpr size_t WS_HB = 364 * MiB;
constexpr size_t WS_AQK = 428 * MiB;
constexpr size_t WS_HALO = 460 * MiB;
constexpr size_t WS_AB = 470 * MiB;
constexpr size_t WS_DEC = 472 * MiB;
constexpr size_t WS_SSA = 474 * MiB, WS_SSB = 476 * MiB;
constexpr size_t WS_SSO = 478 * MiB;
constexpr size_t WS_END = 480 * MiB;
constexpr int GDN_NPAD = 4352;
constexpr int LDS_BYTES = 147456;

__device__ __forceinline__ float bf2f(unsigned v) { return __uint_as_float(v << 16); }
__device__ __forceinline__ float bflo(unsigned w) { return __uint_as_float(w << 16); }
__device__ __forceinline__ float bfhi(unsigned w) { return __uint_as_float(w & 0xffff0000u); }
__device__ __forceinline__ unsigned f2bf(float f) { unsigned u = __float_as_uint(f); return (u + 0x7fffu + ((u >> 16) & 1u)) >> 16; }
__device__ __forceinline__ unsigned pk2(float lo, float hi) { return pg8::cvt_pk_bf16(lo, hi); }
__device__ __forceinline__ float sigmoidf_(float x) { return 1.0f / (1.0f + __expf(-x)); }
__device__ __forceinline__ float siluf_(float x) { return x / (1.0f + __expf(-x)); }
__device__ __forceinline__ float wave_sum(float v) {
#pragma unroll
    for (int o = 1; o < 64; o <<= 1) v += __shfl_xor(v, o);
    return v;
}
#define LDS_WAIT() asm volatile("s_waitcnt lgkmcnt(0)" ::: "memory")

template <int K> __device__ __forceinline__ f32x4 mm_tile(const LAS bf16_t* A1, int s1, const LAS bf16_t* A2, int s2, f32x4 acc, int lane) {
    const LAS bf16_t* p1 = A1 + (lane & 15) * s1 + (lane >> 4) * 8;
    const LAS bf16_t* p2 = A2 + (lane & 15) * s2 + (lane >> 4) * 8;
#pragma unroll
    for (int k0 = 0; k0 < K; k0 += 32) {
        const bf16x8 a = *(const LAS bf16x8*)(p1 + k0); const bf16x8 b = *(const LAS bf16x8*)(p2 + k0);
        acc = __builtin_amdgcn_mfma_f32_16x16x32_bf16(a, b, acc, 0, 0, 0);
    }
    return acc;
}

#define XB_TMO      128
#define XB_XCNT(j)  (256  + 64 * (j))
#define XB_XSUB(j)  (1280 + 64 * (j))
#define XB_XGEN(j)  (2304 + 64 * (j))
#define XB_TOP      3328
#define XB_TOPGEN   3392
#define XCD_BAR_WORDS 3456
#define XB_SPIN_CAP (1u << 18)

__device__ __forceinline__ unsigned xb_ld(unsigned* p)              { return __hip_atomic_load(p, __ATOMIC_RELAXED, __HIP_MEMORY_SCOPE_AGENT); }
__device__ __forceinline__ unsigned xb_add(unsigned* p, unsigned v) { return __hip_atomic_fetch_add(p, v, __ATOMIC_RELAXED, __HIP_MEMORY_SCOPE_AGENT); }
__device__ __forceinline__ unsigned xb_xcc_id() { return (unsigned)__builtin_amdgcn_s_getreg((3 << 11) | 20) & 0xFu; }
#define XB_SPIN(cond, bar) do { unsigned _sp = 0; while (cond) { __builtin_amdgcn_s_sleep(1); \
    if ((++_sp & 255u) == 0u) { if (xb_ld(&(bar)[XB_TMO])) break; if (_sp > XB_SPIN_CAP) { atomicAdd(&(bar)[XB_TMO], 1u); break; } } } } while (0)

struct XcdBarrier {
    unsigned* bar; unsigned x;
    volatile LAS unsigned* st;
};

__device__ __forceinline__ XcdBarrier xcd_barrier_post(unsigned* bar, volatile LAS unsigned* st) {
    XcdBarrier b; b.bar = bar; b.x = xb_xcc_id(); b.st = st;
    if (threadIdx.x == 0) (void)xb_add(&bar[XB_XCNT(b.x)], 1u);
    return b;
}
__device__ __forceinline__ void xcd_barrier_complete(unsigned* bar, unsigned x, unsigned& nloc, unsigned& nx) {
    const unsigned G = gridDim.x * gridDim.y * gridDim.z;
    unsigned sum, cnt, mine, sp = 0u;
    for (;;) {
        sum = 0u; cnt = 0u; mine = 0u;
#pragma unroll
        for (unsigned j = 0; j < 16; ++j) { const unsigned c = xb_ld(&bar[XB_XCNT(j)]); sum += c; cnt += (c > 0u) ? 1u : 0u; mine = (j == x) ? c : mine; }
        if (sum == G) break;
        __builtin_amdgcn_s_sleep(1);
        if ((++sp & 255u) == 0u) { if (xb_ld(&bar[XB_TMO])) break; if (sp > XB_SPIN_CAP) { atomicAdd(&bar[XB_TMO], 1u); break; } }
    }
    nloc = mine > 0u ? mine : 1u; nx = cnt > 0u ? cnt : 1u;
}

__device__ __forceinline__ void xcd_barrier(const XcdBarrier& b) {
    asm volatile("s_waitcnt vmcnt(0)" ::: "memory");
    __syncthreads();
    if (threadIdx.x == 0) {
        unsigned* bar = b.bar;
        __builtin_amdgcn_s_waitcnt(0);
        unsigned nloc = b.st[0], nx = b.st[1];
        if (nloc == 0u) { xcd_barrier_complete(bar, b.x, nloc, nx); b.st[0] = nloc; b.st[1] = nx; }
        const unsigned old = xb_add(&bar[XB_XSUB(b.x)], 1u);
        const unsigned gen = old / nloc;
        if (old + 1u == (gen + 1u) * nloc) {
            __builtin_amdgcn_fence(__ATOMIC_RELEASE, "agent");
            asm volatile("s_waitcnt vmcnt(0)" ::: "memory");
            const unsigned og = xb_add(&bar[XB_TOP], 1u);
            const unsigned tg = og / nx;
            if (og + 1u == (tg + 1u) * nx) xb_add(&bar[XB_TOPGEN], 1u);
            else XB_SPIN(xb_ld(&bar[XB_TOPGEN]) == tg, bar);
            __builtin_amdgcn_fence(__ATOMIC_ACQUIRE, "agent");
            xb_add(&bar[XB_XGEN(b.x)], 1u);
            asm volatile("s_waitcnt vmcnt(0)" ::: "memory");
        } else {
            XB_SPIN(xb_ld(&bar[XB_XGEN(b.x)]) == gen, bar);
            __builtin_amdgcn_fence(__ATOMIC_ACQUIRE, "agent");
            asm volatile("s_waitcnt vmcnt(0)" ::: "memory");
        }
    }
    __syncthreads();
}
__device__ __forceinline__ void transpose_item(const float* W, int K, int Nsrc, int Npad, const float* nw, bf16_t* WT, LAS float* scr, int item, int lane) {
    const int nblk = Npad / 32, kb = item / nblk, nb = item % nblk, k0 = 64 * kb, n0 = 32 * nb;
#pragma unroll 8
    for (int i = 0; i < 32; ++i) { const int kk = 2 * i + (lane >> 5); const int n = n0 + (lane & 31);
        float v = (n < Nsrc) ? W[(size_t)(k0 + kk) * Nsrc + n] : 0.f; if (nw) v *= nw[k0 + kk]; scr[kk * 33 + (lane & 31)] = v; }
    LDS_WAIT(); asm volatile("" ::: "memory");
    const int c = lane & 7;
#pragma unroll
    for (int j = 0; j < 4; ++j) { const int n = (lane >> 3) + 8 * j; const LAS float* s = scr + (8 * c) * 33 + n;
        u32x4 o; o.x = pk2(s[0 * 33], s[1 * 33]); o.y = pk2(s[2 * 33], s[3 * 33]); o.z = pk2(s[4 * 33], s[5 * 33]); o.w = pk2(s[6 * 33], s[7 * 33]);
        *(u32x4*)(WT + (size_t)(n0 + n) * K + k0 + 8 * c) = o; }
    LDS_WAIT(); asm volatile("" ::: "memory");
}

struct Args { const float* in[16]; float* out; unsigned char* ws; };

__device__ __forceinline__ void prologue(const Args& a, LAS unsigned char* lds, int tid) {
    const int lane = tid & 63, wave = __builtin_amdgcn_readfirstlane(tid >> 6);
    unsigned char* ws = a.ws;
    LAS float* scr = (LAS float*)(lds + wave * 16384);
    const int gw = blockIdx.x * NWAVES + wave, NGW = gridDim.x * NWAVES;
    const float* gdn_w_in = a.in[1]; const float* gdn_w_out = a.in[6]; const float* hgrn_w_in = a.in[7]; const float* hgrn_w_out = a.in[10];
    const float* norm_mix = a.in[11]; const float* norm_mlp = a.in[12]; const float* w_up = a.in[13]; const float* w_down = a.in[14];
    constexpr int I_GI = 16 * (GDN_NPAD / 32), I_SQ = 16 * 32, I_HI = 16 * 128, I_UP = 16 * 128, I_DN = 64 * 32;
    constexpr int NITEMS = 2 * I_GI + 2 * I_SQ + 2 * I_HI + 2 * I_SQ + 4 * I_UP + 4 * I_DN;
    for (int it = gw; it < NITEMS; it += NGW) {
        int r = it;
        if (r < 2 * I_GI) { const int j = r / I_GI; r -= j * I_GI; transpose_item(gdn_w_in + (size_t)j * 1024 * 4112, 1024, 4112, GDN_NPAD, norm_mix + (2 * j) * 1024, (bf16_t*)(ws + WS_WGI) + (size_t)j * GDN_NPAD * 1024, scr, r, lane); continue; } r -= 2 * I_GI;
        if (r < 2 * I_SQ) { const int j = r / I_SQ; r -= j * I_SQ; transpose_item(gdn_w_out + (size_t)j * 1024 * 1024, 1024, 1024, 1024, nullptr, (bf16_t*)(ws + WS_WGO) + (size_t)j * 1024 * 1024, scr, r, lane); continue; } r -= 2 * I_SQ;
        if (r < 2 * I_HI) { const int j = r / I_HI; r -= j * I_HI; transpose_item(hgrn_w_in + (size_t)j * 1024 * 4096, 1024, 4096, 4096, norm_mix + (2 * j + 1) * 1024, (bf16_t*)(ws + WS_WHI) + (size_t)j * 4096 * 1024, scr, r, lane); continue; } r -= 2 * I_HI;
        if (r < 2 * I_SQ) { const int j = r / I_SQ; r -= j * I_SQ; transpose_item(hgrn_w_out + (size_t)j * 1024 * 1024, 1024, 1024, 1024, nullptr, (bf16_t*)(ws + WS_WHO) + (size_t)j * 1024 * 1024, scr, r, lane); continue; } r -= 2 * I_SQ;
        if (r < 4 * I_UP) { const int j = r / I_UP; r -= j * I_UP; transpose_item(w_up + (size_t)j * 1024 * 4096, 1024, 4096, 4096, norm_mlp + j * 1024, (bf16_t*)(ws + WS_WUP) + (size_t)j * 4096 * 1024, scr, r, lane); continue; } r -= 4 * I_UP;
        { const int j = r / I_DN; r -= j * I_DN; transpose_item(w_down + (size_t)j * 4096 * 1024, 4096, 1024, 1024, nullptr, (bf16_t*)(ws + WS_WDN) + (size_t)j * 1024 * 4096, scr, r, lane); }
    }
    float* SSB = (float*)(ws + WS_SSB); bf16_t* HB = (bf16_t*)(ws + WS_HB); const float* x = a.in[0];
    for (int m = gw; m < M_TOK; m += NGW) {
        const f32x4* xr = (const f32x4*)(x + (size_t)m * DMODEL) + lane; float s = 0.f; f32x4 v[4];
#pragma unroll
        for (int j = 0; j < 4; ++j) { v[j] = xr[64 * j]; s += (v[j][0] * v[j][0] + v[j][1] * v[j][1]) + (v[j][2] * v[j][2] + v[j][3] * v[j][3]); }
        s = wave_sum(s);
        u32x2* o8 = (u32x2*)(HB + (size_t)m * DMODEL) + lane;
#pragma unroll
        for (int j = 0; j < 4; ++j) { u32x2 w; w.x = pk2(v[j][0], v[j][1]); w.y = pk2(v[j][2], v[j][3]); o8[64 * j] = w; }
        if (lane < 16) SSB[(size_t)m * 16 + lane] = (lane == 0) ? s : 0.f;
    }
    if (blockIdx.x == 0) {
        const float* lg = a.in[8]; float* LB = (float*)(ws + WS_LB);
        for (int c = tid; c < 1024; c += NTHREADS) {
            const float l0 = lg[c], l1 = lg[1024 + c], l2 = lg[2048 + c], l3 = lg[3072 + c];
            const float mx = fmaxf(fmaxf(l0, l1), fmaxf(l2, l3));
            const float e0 = expf(l0 - mx), e1 = expf(l1 - mx), e2 = expf(l2 - mx), e3 = expf(l3 - mx); const float inv = 1.0f / (e0 + e1 + e2 + e3);
            LB[c] = e1 * inv; LB[1024 + c] = (e1 + e2 + e3) * inv;
        }
    }
}

__device__ __forceinline__ void gdn_prep(LAS unsigned char* lds, int tid, bf16_t* P, bf16_t* Wpl, bf16_t* AQK, const bf16_t* HALO, const float* AB, float* DEC,
                                         const float* conv_w, const float* a_log, const float* dt_bias) {
    asm volatile("" : "+v"(tid));
    const int lane = tid & 63, wave = __builtin_amdgcn_readfirstlane(tid >> 6);
    LAS bf16_t* QB = (LAS bf16_t*)lds; LAS bf16_t* KB = QB + 64 * 136; LAS bf16_t* VB = KB + 64 * 136;
    LAS float* LM = (LAS float*)(lds + 52224); LAS float* GC = LM + 4096; LAS float* BETA = GC + 64; LAS float* EG = BETA + 64; LAS float* BEG = EG + 64;
    for (int it = blockIdx.x; it < NITEM; it += gridDim.x) {
        const int h = it & 7, cidx = it >> 3, n = cidx & 31; const size_t row0 = (size_t)cidx * 64;
        if (tid < 384) {
            const int p = tid >> 7, seg = (tid >> 4) & 7, cg8 = tid & 15; const int ch = h * 128 + cg8 * 8;
            float cw[4][8];
#pragma unroll
            for (int kk = 0; kk < 4; ++kk) { const f32x4 c0 = *(const f32x4*)(conv_w + kk * 3072 + p * 1024 + ch), c1 = *(const f32x4*)(conv_w + kk * 3072 + p * 1024 + ch + 4);
#pragma unroll
                for (int e = 0; e < 4; ++e) { cw[kk][e] = c0[e]; cw[kk][4 + e] = c1[e]; } }
            const bf16_t* src = P + (size_t)p * PLANE + ch;
            u32x4 xr[11];
#pragma unroll
            for (int r = 0; r < 11; ++r) { const int t = seg * 8 - 3 + r;
                if (t >= 0) xr[r] = *(const u32x4*)(src + (row0 + t) * 1024);
                else if (n > 0) xr[r] = *(const u32x4*)(HALO + ((size_t)(cidx - 1) * 3 + (t + 3)) * 3072 + p * 1024 + ch);
                else xr[r] = (u32x4){0u, 0u, 0u, 0u}; }
            LAS bf16_t* dstb = QB + p * 64 * 136 + cg8 * 8;
#pragma unroll
            for (int tt = 0; tt < 8; ++tt) {
                float y[8];
#pragma unroll
                for (int e = 0; e < 8; ++e) y[e] = 0.f;
#pragma unroll
                for (int kk = 0; kk < 4; ++kk) { const u32x4 w = xr[tt + kk];
                    y[0] += cw[kk][0] * bflo(w.x); y[1] += cw[kk][1] * bfhi(w.x); y[2] += cw[kk][2] * bflo(w.y); y[3] += cw[kk][3] * bfhi(w.y);
                    y[4] += cw[kk][4] * bflo(w.z); y[5] += cw[kk][5] * bfhi(w.z); y[6] += cw[kk][6] * bflo(w.w); y[7] += cw[kk][7] * bfhi(w.w); }
                float ssq = 0.f;
#pragma unroll
                for (int e = 0; e < 8; ++e) { y[e] = siluf_(y[e]); ssq += y[e] * y[e]; }
                if (p < 2) {
                    ssq += __shfl_xor(ssq, 1); ssq += __shfl_xor(ssq, 2); ssq += __shfl_xor(ssq, 4); ssq += __shfl_xor(ssq, 8);
                    const float rn = rsqrtf(ssq + EPS) * (p == 0 ? 0.08838834764831845f : 1.0f);
#pragma unroll
                    for (int e = 0; e < 8; ++e) y[e] *= rn;
                }
                u32x4 o; o.x = pk2(y[0], y[1]); o.y = pk2(y[2], y[3]); o.z = pk2(y[4], y[5]); o.w = pk2(y[6], y[7]);
                *(LAS u32x4*)(dstb + (seg * 8 + tt) * 136) = o;
            }
        } else if (tid >= 448) {
            const float av = AB[(row0 + lane) * 16 + h], bv = AB[(row0 + lane) * 16 + 8 + h];
            const float beta = sigmoidf_(bv); const float xx = av + dt_bias[h];
            const float sp = fmaxf(xx, 0.f) + log1pf(expf(-fabsf(xx)));
            float g = -expf(a_log[h]) * sp;
#pragma unroll
            for (int o = 1; o < 64; o <<= 1) { const float v = __shfl_up(g, o); if (lane >= o) g += v; }
            GC[lane] = g; BETA[lane] = beta; { const float eg = expf(g); EG[lane] = eg; BEG[lane] = beta * eg; }
        }
        __syncthreads();
#pragma unroll
        for (int q4 = 0; q4 < 4; ++q4) {
            const int tt = wave * 4 + q4, sel = tt >> 4, mi = (tt & 15) >> 2, nj = tt & 3;
            f32x4 acc = (f32x4){0.f, 0.f, 0.f, 0.f};
            if (nj <= mi) acc = mm_tile<128>((sel ? QB : KB) + mi * 16 * 136, 136, KB + nj * 16 * 136, 136, acc, lane);
            const int jc = nj * 16 + (lane & 15); const float gj = GC[jc];
#pragma unroll
            for (int jj = 0; jj < 4; ++jj) { const int i = mi * 16 + (lane >> 4) * 4 + jj;
                if (sel == 0) { float val = 0.f; if (jc < i) val = BETA[i] * acc[jj] * __expf(GC[i] - gj); LM[i * 64 + jc] = val; }
                else { float val = 0.f; if (jc <= i) val = acc[jj] * __expf(GC[i] - gj); AQK[(size_t)it * 4096 + i * 64 + jc] = (bf16_t)f2bf(val); } }
        }
        __syncthreads();
        if (tid < 256) {
            const int c = tid; const bool isu = c < 128;
            unsigned a_src = (unsigned)(size_t)(isu ? (VB + c) : (KB + (c - 128))), a_fac = (unsigned)(size_t)(isu ? BETA : BEG), a_lm = (unsigned)(size_t)LM;
            asm volatile("" : "+v"(a_src), "+v"(a_fac), "+v"(a_lm));
            float sol[64];
#pragma unroll
            for (int i = 0; i < 64; ++i) {
                float r = bf2f(*(const LAS bf16_t*)(size_t)(a_src + i * 272)) * *(const LAS float*)(size_t)(a_fac + i * 4);
#pragma unroll
                for (int j4 = 0; j4 * 4 < i; ++j4) { const f32x4 l = *(const LAS f32x4*)(size_t)(a_lm + i * 256 + j4 * 16);
                    r -= l[0] * sol[j4 * 4];
                    if (j4 * 4 + 1 < i) r -= l[1] * sol[j4 * 4 + 1];
                    if (j4 * 4 + 2 < i) r -= l[2] * sol[j4 * 4 + 2];
                    if (j4 * 4 + 3 < i) r -= l[3] * sol[j4 * 4 + 3]; }
                sol[i] = r;
                asm volatile("" ::: "memory");
            }
            bf16_t* dst = (isu ? (P + 2 * PLANE) : Wpl) + row0 * 1024 + h * 128 + (c & 127);
#pragma unroll
            for (int i = 0; i < 64; ++i) dst[(size_t)i * 1024] = (bf16_t)f2bf(sol[i]);
        } else {
            const int t2 = tid - 256;
            { const int i = t2 >> 2, c0 = (t2 & 3) * 32; const float e = EG[i];
#pragma unroll
              for (int v = 0; v < 4; ++v) { const u32x4 w = *(const LAS u32x4*)(QB + i * 136 + c0 + v * 8); u32x4 o;
                  o.x = pk2(bflo(w.x) * e, bfhi(w.x) * e); o.y = pk2(bflo(w.y) * e, bfhi(w.y) * e); o.z = pk2(bflo(w.z) * e, bfhi(w.z) * e); o.w = pk2(bflo(w.w) * e, bfhi(w.w) * e);
                  *(u32x4*)(P + (row0 + i) * 1024 + h * 128 + c0 + v * 8) = o; } }
            { const int dk = t2 >> 1, cb = (t2 & 1) * 32; const float gl = GC[63];
#pragma unroll
              for (int v = 0; v < 4; ++v) { float t[8];
#pragma unroll
                  for (int e = 0; e < 8; ++e) { const int c = cb + v * 8 + e; t[e] = bf2f(KB[c * 136 + dk]) * __expf(gl - GC[c]); }
                  u32x4 o; o.x = pk2(t[0], t[1]); o.y = pk2(t[2], t[3]); o.z = pk2(t[4], t[5]); o.w = pk2(t[6], t[7]);
                  *(u32x4*)(P + PLANE + (row0 + (dk >> 1)) * 1024 + h * 128 + ((dk & 1) << 6) + cb + v * 8) = o; } }
            if (t2 < 128) DEC[(size_t)it * 128 + t2] = EG[63];
        }
        __syncthreads();
    }
}

__device__ __forceinline__ void hgrn_prep(LAS unsigned char* lds, int tid, bf16_t* P, bf16_t* AQK, float* DEC, const float* LBv) {
    asm volatile("" : "+v"(tid));
    const int lane = tid & 63, wave = __builtin_amdgcn_readfirstlane(tid >> 6);
    LAS bf16_t* QH = (LAS bf16_t*)lds; LAS bf16_t* KH = QH + 4 * 16 * 136; LAS float* TOT = (LAS float*)(lds + 14 * 16 * 136 * 2);
    const int d = tid & 127, s = tid >> 7;
    for (int it = blockIdx.x; it < NITEM; it += gridDim.x) {
        const int h = it & 7, cidx = it >> 3; const size_t row0 = (size_t)cidx * 64;
        const float lb = LBv[h * 128 + d];
        float qv[16], kv[16], gl[16]; float run = 0.f;
        bf16_t* q0 = P + (row0 + s * 16) * 1024 + h * 128 + d; const bf16_t* f0 = q0 + PLANE;
#pragma unroll
        for (int r = 0; r < 16; ++r) { const float qraw = bf2f(q0[(size_t)r * 1024]), fraw = bf2f(f0[(size_t)r * 1024]);
            const float sg = 1.0f / (1.0f + expf(-fraw)); const float ft = lb + (1.0f - lb) * sg; run += logf(ft); gl[r] = run;
            kv[r] = (1.0f - lb) / (1.0f + expf(fraw)); qv[r] = siluf_(qraw) * 0.08838834764831845f; }
        TOT[s * 128 + d] = run;
        __syncthreads();
        const float t0 = TOT[d], t1 = TOT[128 + d], t2 = TOT[256 + d], t3 = TOT[384 + d];
        const float gb = (s > 0 ? t0 : 0.f) + (s > 1 ? t1 : 0.f) + (s > 2 ? t2 : 0.f); const float glast = (t0 + t1) + (t2 + t3);
#pragma unroll
        for (int r = 0; r < 16; ++r) q0[(size_t)r * 1024] = (bf16_t)f2bf(qv[r] * __expf(gb + gl[r]));
        { float t[16];
#pragma unroll
          for (int r = 0; r < 16; ++r) t[r] = kv[r] * __expf(glast - gb - gl[r]);
          u32x4 o0, o1; o0.x = pk2(t[0], t[1]); o0.y = pk2(t[2], t[3]); o0.z = pk2(t[4], t[5]); o0.w = pk2(t[6], t[7]); o1.x = pk2(t[8], t[9]); o1.y = pk2(t[10], t[11]); o1.z = pk2(t[12], t[13]); o1.w = pk2(t[14], t[15]);
          bf16_t* kd = P + PLANE + (row0 + (d >> 1)) * 1024 + h * 128 + ((d & 1) << 6) + s * 16;
          *(u32x4*)kd = o0; *(u32x4*)(kd + 8) = o1; }
        if (s == 0) DEC[(size_t)it * 128 + d] = __expf(glast);
#pragma unroll
        for (int r = 0; r < 16; ++r) QH[(s * 16 + r) * 136 + d] = (bf16_t)f2bf(qv[r] * __expf(gl[r]));
#pragma unroll
        for (int st = 0; st < 4; ++st) {
            if (st >= s) {
                float off = 0.f;
                if (st > s) { if (s <= 0 && 0 < st) off += t0; if (s <= 1 && 1 < st) off += t1; if (s <= 2 && 2 < st) off += t2; }
                const int pidx = st * (st + 1) / 2 + s;
#pragma unroll
                for (int r = 0; r < 16; ++r) KH[(pidx * 16 + r) * 136 + d] = (bf16_t)f2bf(kv[r] * __expf(off - gl[r]));
            }
        }
        __syncthreads();
        for (int tile = wave; tile < 16; tile += 8) {
            const int st = tile >> 2, sj = tile & 3; f32x4 acc = (f32x4){0.f, 0.f, 0.f, 0.f};
            if (sj <= st) acc = mm_tile<128>(QH + st * 16 * 136, 136, KH + (st * (st + 1) / 2 + sj) * 16 * 136, 136, acc, lane);
            const int jc = sj * 16 + (lane & 15);
#pragma unroll
            for (int jj = 0; jj < 4; ++jj) { const int i = st * 16 + (lane >> 4) * 4 + jj; const float val = (sj <= st && jc <= i) ? acc[jj] : 0.f;
                AQK[(size_t)it * 4096 + i * 64 + jc] = (bf16_t)f2bf(val); }
        }
        __syncthreads();
    }
}

__device__ __forceinline__ void scan_phase(LAS unsigned char* lds, int tid, bool gdn, bf16_t* P, const bf16_t* Wpl, const bf16_t* AQK, const float* DEC, const float* nw, float* ss_o) {
    if (blockIdx.x >= 128) return;
    asm volatile("" : "+v"(tid));
    const int lane = tid & 63, wave = __builtin_amdgcn_readfirstlane(tid >> 6);
    const int b = blockIdx.x >> 3, h = blockIdx.x & 7;
    LAS bf16_t* ST = (LAS bf16_t*)lds; LAS bf16_t* VNT = (LAS bf16_t*)(lds + 34816); LAS bf16_t* WB = (LAS bf16_t*)(lds + 53248); LAS bf16_t* QD = (LAS bf16_t*)(lds + 70656);
    LAS bf16_t* AQ = (LAS bf16_t*)(lds + 88064); LAS bf16_t* KDT = (LAS bf16_t*)(lds + 97280); LAS float* DECV = (LAS float*)(lds + 115712); LAS float* SSQ = (LAS float*)(lds + 116224);
    const f32x4 Z4 = (f32x4){0.f, 0.f, 0.f, 0.f};
    f32x4 Sacc[8];
#pragma unroll
    for (int nt = 0; nt < 8; ++nt) Sacc[nt] = Z4;
    for (int i = tid; i < 128 * 136 / 2; i += NTHREADS) ((LAS unsigned*)ST)[i] = 0u;
    const int l15 = lane & 15, lq = lane >> 4, mrow = wave * 16 + lq * 4;
    const f32x4 nwv = *(const f32x4*)(nw + (gdn ? 0 : h * 128) + mrow);
    const LAS bf16_t* stf = ST + (wave * 16 + l15) * 136 + lq * 8; const LAS bf16_t* vnf = VNT + (wave * 16 + l15) * 72 + lq * 8;
    const LAS bf16_t* wbf = WB + l15 * 136 + lq * 8; const LAS bf16_t* qdf = QD + l15 * 136 + lq * 8; const LAS bf16_t* aqf = AQ + l15 * 72 + lq * 8; const LAS bf16_t* kdf = KDT + l15 * 72 + lq * 8;
    const int sr0 = tid >> 4, sc8 = tid & 15, ar = tid >> 3, ac8 = tid & 7;
    u32x4 pw[2], pq[2], pk[2], pa; u32x2 pu[4], pg[4], cu[4], cgt[4]; float pdec = 0.f;
    pw[0] = pw[1] = (u32x4){0u, 0u, 0u, 0u};
#define SCAN_ISSUE(nn) do { const int cidx_ = b * 32 + (nn); const size_t it_ = (size_t)cidx_ * 8 + h, row0_ = (size_t)cidx_ * 64; \
        _Pragma("unroll") for (int i_ = 0; i_ < 2; ++i_) { const size_t g_ = (row0_ + sr0 + 32 * i_) * 1024 + h * 128 + sc8 * 8; \
            if (gdn) pw[i_] = *(const u32x4*)(Wpl + g_); pq[i_] = *(const u32x4*)(P + g_); pk[i_] = *(const u32x4*)(P + PLANE + g_); } \
        pa = *(const u32x4*)(AQK + it_ * 4096 + ar * 64 + ac8 * 8); \
        _Pragma("unroll") for (int nt_ = 0; nt_ < 4; ++nt_) { const size_t g2_ = (row0_ + nt_ * 16 + l15) * 1024 + h * 128 + mrow; \
            pu[nt_] = *(const u32x2*)(P + 2 * PLANE + g2_); pg[nt_] = *(const u32x2*)(P + 3 * PLANE + g2_); } \
        if (tid < 128) pdec = DEC[it_ * 128 + tid]; } while (0)
#define SCAN_COMMIT() do { \
        _Pragma("unroll") for (int i_ = 0; i_ < 2; ++i_) { const int r_ = sr0 + 32 * i_; \
            if (gdn) *(LAS u32x4*)(WB + r_ * 136 + sc8 * 8) = pw[i_]; *(LAS u32x4*)(QD + r_ * 136 + sc8 * 8) = pq[i_]; \
            *(LAS u32x4*)(KDT + (r_ * 2 + (sc8 >> 3)) * 72 + (sc8 & 7) * 8) = pk[i_]; } \
        *(LAS u32x4*)(AQ + ar * 72 + ac8 * 8) = pa; if (tid < 128) DECV[tid] = pdec; \
        _Pragma("unroll") for (int nt_ = 0; nt_ < 4; ++nt_) { cu[nt_] = pu[nt_]; cgt[nt_] = pg[nt_]; } } while (0)
    SCAN_ISSUE(0);
    SCAN_COMMIT();
    __syncthreads();
    for (int n = 0; n < 32; ++n) {
        const size_t row0 = (size_t)(b * 32 + n) * 64;
        if (n < 31) SCAN_ISSUE(n + 1);
        bf16x8 sf[4];
#pragma unroll
        for (int k = 0; k < 4; ++k) sf[k] = *(const LAS bf16x8*)(stf + k * 32);
        f32x4 vn[4];
#pragma unroll
        for (int nt = 0; nt < 4; ++nt) vn[nt] = (f32x4){bflo(cu[nt].x), bfhi(cu[nt].x), bflo(cu[nt].y), bfhi(cu[nt].y)};
        if (gdn) {
#pragma unroll
            for (int nt = 0; nt < 4; ++nt) { f32x4 acc = Z4;
#pragma unroll
                for (int k = 0; k < 4; ++k) acc = __builtin_amdgcn_mfma_f32_16x16x32_bf16(sf[k], *(const LAS bf16x8*)(wbf + nt * 16 * 136 + k * 32), acc, 0, 0, 0);
                vn[nt] = vn[nt] - acc; }
        }
#pragma unroll
        for (int nt = 0; nt < 4; ++nt)
#pragma unroll
            for (int jj = 0; jj < 4; ++jj) VNT[(mrow + jj) * 72 + nt * 16 + l15] = (bf16_t)f2bf(vn[nt][jj]);
        LDS_WAIT();
        bf16x8 vf[2];
#pragma unroll
        for (int k = 0; k < 2; ++k) vf[k] = *(const LAS bf16x8*)(vnf + k * 32);
        f32x4 o[4];
#pragma unroll
        for (int nt = 0; nt < 4; ++nt) { f32x4 acc = Z4;
#pragma unroll
            for (int k = 0; k < 4; ++k) acc = __builtin_amdgcn_mfma_f32_16x16x32_bf16(sf[k], *(const LAS bf16x8*)(qdf + nt * 16 * 136 + k * 32), acc, 0, 0, 0);
#pragma unroll
            for (int k = 0; k < 2; ++k) acc = __builtin_amdgcn_mfma_f32_16x16x32_bf16(vf[k], *(const LAS bf16x8*)(aqf + nt * 16 * 72 + k * 32), acc, 0, 0, 0);
            o[nt] = acc; }
#pragma unroll
        for (int nt = 0; nt < 8; ++nt) { const float dcy = DECV[nt * 16 + l15]; f32x4 acc = Sacc[nt] * dcy;
#pragma unroll
            for (int k = 0; k < 2; ++k) acc = __builtin_amdgcn_mfma_f32_16x16x32_bf16(vf[k], *(const LAS bf16x8*)(kdf + nt * 16 * 72 + k * 32), acc, 0, 0, 0);
            Sacc[nt] = acc; }
#pragma unroll
        for (int nt = 0; nt < 4; ++nt) { float q = (o[nt][0] * o[nt][0] + o[nt][1] * o[nt][1]) + (o[nt][2] * o[nt][2] + o[nt][3] * o[nt][3]);
            q += __shfl_xor(q, 16); q += __shfl_xor(q, 32); if (lq == 0) SSQ[wave * 64 + nt * 16 + l15] = q; }
        __syncthreads();
#pragma unroll
        for (int nt = 0; nt < 8; ++nt)
#pragma unroll
            for (int jj = 0; jj < 4; ++jj) ST[(mrow + jj) * 136 + nt * 16 + l15] = (bf16_t)f2bf(Sacc[nt][jj]);
#pragma unroll
        for (int nt = 0; nt < 4; ++nt) { const int tok = nt * 16 + l15; float tot = 0.f;
#pragma unroll
            for (int w = 0; w < 8; ++w) tot += SSQ[w * 64 + tok];
            const float rs = gdn ? rsqrtf(tot * (1.0f / 128.0f) + EPS) : 1.0f;
            const float g0 = bflo(cgt[nt].x), g1 = bfhi(cgt[nt].x), g2 = bflo(cgt[nt].y), g3 = bfhi(cgt[nt].y);
            u32x2 ow; ow.x = pk2(o[nt][0] * rs * nwv[0] * siluf_(g0), o[nt][1] * rs * nwv[1] * siluf_(g1)); ow.y = pk2(o[nt][2] * rs * nwv[2] * siluf_(g2), o[nt][3] * rs * nwv[3] * siluf_(g3));
            *(u32x2*)(P + 3 * PLANE + (row0 + tok) * 1024 + h * 128 + mrow) = ow;
            if (!gdn && wave == 0 && lq == 0) ss_o[(row0 + tok) * 8 + h] = tot; }
        if (n < 31) SCAN_COMMIT();
        __syncthreads();
    }
#undef SCAN_ISSUE
#undef SCAN_COMMIT
}

__global__ void __launch_bounds__(NTHREADS, 2) mega_fwd(Args a) {
    extern __shared__ __attribute__((aligned(16))) unsigned char lds_raw[];
    LAS unsigned char* lds = (LAS unsigned char*)lds_raw;
    cg::grid_group grid = cg::this_grid();
    const int tid = threadIdx.x;
    unsigned char* ws = a.ws;
    float* SSA = (float*)(ws + WS_SSA); float* SSB = (float*)(ws + WS_SSB); float* SSO = (float*)(ws + WS_SSO); bf16_t* P = (bf16_t*)(ws + WS_PROJ); bf16_t* HB = (bf16_t*)(ws + WS_HB); bf16_t* AQK = (bf16_t*)(ws + WS_AQK);
    bf16_t* HALO = (bf16_t*)(ws + WS_HALO); float* AB = (float*)(ws + WS_AB); float* DEC = (float*)(ws + WS_DEC);
    const float* x = a.in[0]; float* out = a.out;
    const int G = gridDim.x;

    volatile LAS unsigned* misc = (volatile LAS unsigned*)(lds + 131072);
    if (tid < 4) misc[tid] = 0u;
    __syncthreads();
    const XcdBarrier bar = xcd_barrier_post((unsigned*)ws, misc);
#define GRID_BAR() xcd_barrier(bar)

    prologue(a, lds, tid);
    grid.sync();

    for (int i = 0; i < 4; ++i) {
        const int j = i >> 1; const bool gdn = (i & 1) == 0;
        {
            const bf16_t* Bt = gdn ? (const bf16_t*)(ws + WS_WGI) + (size_t)j * GDN_NPAD * 1024 : (const bf16_t*)(ws + WS_WHI) + (size_t)j * 4096 * 1024;
            pg8::Gemm g{HB, Bt, M_TOK, gdn ? GDN_NPAD : 4096, 1024}; pg8::StaticOrder S; S.init(M_TOK, g.N, G, (int)blockIdx.x);
            pg8::EpiProj E{P, PLANE, SSB, gdn ? AB : nullptr, gdn ? HALO : nullptr};
            pg8::gemm_phase<pg8::EpiProj, pg8::StaticOrder, true, true>(lds, g, S, E);
        }
        GRID_BAR();
        if (gdn) gdn_prep(lds, tid, P, HB, AQK, HALO, AB, DEC, a.in[2] + (size_t)j * 4 * 3072, a.in[3] + j * 8, a.in[4] + j * 8);
        else hgrn_prep(lds, tid, P, AQK, DEC, (const float*)(ws + WS_LB) + j * 1024);
        GRID_BAR();
        scan_phase(lds, tid, gdn, P, HB, AQK, DEC, gdn ? a.in[5] + j * 128 : a.in[9] + j * 1024, SSO);
        GRID_BAR();
        {
            const bf16_t* Bt = gdn ? (const bf16_t*)(ws + WS_WGO) + (size_t)j * 1024 * 1024 : (const bf16_t*)(ws + WS_WHO) + (size_t)j * 1024 * 1024;
            pg8::Gemm g{P + 3 * PLANE, Bt, M_TOK, 1024, 1024}; pg8::StaticOrder S; S.init(M_TOK, 1024, G, (int)blockIdx.x);
            pg8::EpiRes E{i == 0 ? x : out, out, HB, SSA, gdn ? nullptr : SSO};
            pg8::gemm_phase<pg8::EpiRes, pg8::StaticOrder, true, true>(lds, g, S, E);
        }
        GRID_BAR();
        {
            pg8::Gemm g{HB, (const bf16_t*)(ws + WS_WUP) + (size_t)i * 4096 * 1024, M_TOK, 4096, 1024}; pg8::StaticOrder S; S.init(M_TOK, 4096, G, (int)blockIdx.x);
            pg8::EpiUp E{P, SSA};
            pg8::gemm_phase<pg8::EpiUp, pg8::StaticOrder, true, true>(lds, g, S, E);
        }
        GRID_BAR();
        {
            pg8::Gemm g{P, (const bf16_t*)(ws + WS_WDN) + (size_t)i * 1024 * 4096, M_TOK, 1024, 4096}; pg8::StaticOrder S; S.init(M_TOK, 1024, G, (int)blockIdx.x);
            pg8::EpiRes E{out, out, HB, SSB, nullptr};
            pg8::gemm_phase<pg8::EpiRes, pg8::StaticOrder, true, true>(lds, g, S, E);
        }
        GRID_BAR();
    }
    {
        const int lane = tid & 63, wave = tid >> 6; const int gw = blockIdx.x * NWAVES + wave, NGW = G * NWAVES;
        const f32x4* nf = (const f32x4*)a.in[15] + lane;
        f32x4 wv[4];
#pragma unroll
        for (int jx = 0; jx < 4; ++jx) wv[jx] = nf[64 * jx];
        for (int m = gw; m < M_TOK; m += NGW) {
            const float rs = pg8::row_rstd16(SSB, m); f32x4* o = (f32x4*)(out + (size_t)m * DMODEL) + lane;
#pragma unroll
            for (int jx = 0; jx < 4; ++jx) o[64 * jx] = o[64 * jx] * rs * wv[jx];
        }
    }
}

extern "C" void kernel_launch(void* const* d_in, const int* in_sizes, int n_in, void* d_out, int out_size, void* d_ws, size_t ws_size, hipStream_t stream) {
    static int grid = 0;
    if (grid == 0) {
        if (n_in != 16 || out_size != M_TOK * DMODEL || ws_size < WS_END) { fprintf(stderr, "kernel_launch: unexpected shapes (n_in %d, out %d, ws %zu; need ws >= %zu)\n", n_in, out_size, ws_size, (size_t)WS_END); grid = -1; return; }
        int dev = 0, cus = 0, per_cu = 0;
        (void)hipGetDevice(&dev); (void)hipDeviceGetAttribute(&cus, hipDeviceAttributeMultiprocessorCount, dev);
        (void)hipFuncSetAttribute((const void*)mega_fwd, hipFuncAttributeMaxDynamicSharedMemorySize, LDS_BYTES);
        if (hipOccupancyMaxActiveBlocksPerMultiprocessor(&per_cu, (const void*)mega_fwd, NTHREADS, LDS_BYTES) != hipSuccess || per_cu < 1) per_cu = 1;
        (void)hipGetLastError();
        grid = cus * (per_cu > 1 ? 1 : per_cu);
        if (grid <= 0) grid = 256;
    }
    if (grid < 0) return;
    Args a{};
    for (int i = 0; i < 16; ++i) a.in[i] = (const float*)d_in[i];
    a.out = (float*)d_out; a.ws = (unsigned char*)d_ws;
    (void)hipMemsetAsync(d_ws, 0, 16384, stream);
    void* args[] = {&a};
    hipError_t e = hipLaunchCooperativeKernel((const void*)mega_fwd, dim3(grid), dim3(NTHREADS), args, LDS_BYTES, stream);
    if (e != hipSuccess) fprintf(stderr, "cooperative launch failed: %s (grid %d)\n", hipGetErrorString(e), grid);
}
```

```cpp
#include <hip/hip_runtime.h>
#include <hip/hip_cooperative_groups.h>
#include <cstdio>
#include <cstdint>
namespace cg = cooperative_groups;
namespace pg8 {
#define PG8_LAS __attribute__((address_space(3)))
typedef unsigned short bf16_t;
typedef short bf16x8 __attribute__((ext_vector_type(8)));
typedef float f32x4 __attribute__((ext_vector_type(4)));
typedef unsigned u32x4 __attribute__((ext_vector_type(4)));
constexpr int BM = 256, BK = 64, HALF = 128, HTB = HALF * BK * 2  , STAGE_BYTES = 8 * HTB, NXCD = 8, WGM = 8;

__host__ __device__ __forceinline__ int lds_byte(int r, int c) { const int st = (r >> 4) * 2 + (c >> 5), rr = r & 15, cc = c & 31, ob = rr * 64 + cc * 2; return st * 1024 + (ob ^ (((ob >> 9) & 1) << 5)); }
__host__ __device__ __forceinline__ void stage_rc(int b, int& R, int& C) { const int st = b / 1024, sb = b % 1024, swz = sb ^ (((sb >> 9) & 1) << 5); R = (st >> 1) * 16 + swz / 64; C = (st & 1) * 32 + (swz % 64) / 2; }
__host__ __device__ __forceinline__ int perm32(int rho) { const int n = rho >> 4, i = rho & 15; return 8 * (i >> 2) + 4 * n + (i & 3); }

struct Unit { int pm, pn; };
struct Gemm { const bf16_t* A; const bf16_t* Bt; int M, N, K; };

struct StaticOrder {
    int nM, nN, nwg, G, c;
    __host__ __device__ void init(int M, int N, int G_, int c_) { nM = M / BM; nN = N / BM; nwg = nM * nN; G = G_; c = c_; }
    __host__ __device__ bool next(int i, Unit& u) const {
        const long L = (long)i * G + c; if (L >= nwg) return false;
        int wgid = (int)L; { const int q = nwg / NXCD, r = nwg % NXCD, xcd = wgid % NXCD, off = wgid / NXCD; wgid = (xcd < r ? xcd * (q + 1) : r * (q + 1) + (xcd - r) * q) + off; }
        const int nig = WGM * nN, gid = wgid / nig, fm = gid * WGM, gsz = (nM - fm) < WGM ? (nM - fm) : WGM;
        u.pm = fm + ((wgid % nig) % gsz); u.pn = (wgid % nig) / gsz; return true;
    }
    __device__ __forceinline__ void a_ready(const Unit&) const {}
    __device__ __forceinline__ void done(const Unit&) const {}
};


__device__ __forceinline__ unsigned cvt_pk_bf16(float lo, float hi) { unsigned r; asm volatile("v_cvt_pk_bf16_f32 %0, %1, %2" : "=v"(r) : "v"(lo), "v"(hi)); return r; }
constexpr float RMS_EPS = 1e-6f;
__device__ __forceinline__ float row_rstd16(const float* ssp, int row) {
    const f32x4* p = (const f32x4*)(ssp + (size_t)row * 16); const f32x4 a = p[0], b = p[1], c = p[2], d = p[3];
    const float s = (((a[0] + a[1]) + (a[2] + a[3])) + ((b[0] + b[1]) + (b[2] + b[3]))) + (((c[0] + c[1]) + (c[2] + c[3])) + ((d[0] + d[1]) + (d[2] + d[3])));
    return rsqrtf(s * (1.0f / 1024.0f) + RMS_EPS);
}
__device__ __forceinline__ float row_rstd8(const float* ssp, int row) {
    const f32x4* p = (const f32x4*)(ssp + (size_t)row * 8); const f32x4 a = p[0], b = p[1];
    const float s = ((a[0] + a[1]) + (a[2] + a[3])) + ((b[0] + b[1]) + (b[2] + b[3]));
    return rsqrtf(s * (1.0f / 1024.0f) + RMS_EPS);
}

struct EpiProj {
    static constexpr bool PERM = true, AFTER_DRAIN = false;
    bf16_t* O; size_t plane_stride; const float* ss; float* AB; bf16_t* halo; const PG8_LAS float* rs_tab; int pm_a, pm_b;
    __device__ __forceinline__ void operator()(const f32x4 (&acc)[2][2][4][2], const Unit& u, int wr, int wc, int fr, int fq) const {
        const int tsel = (u.pm == pm_a) ? 0 : ((u.pm == pm_b) ? 256 : -1);
        const int row0 = u.pm * BM + wr * 64 + fr; const int colt = u.pn * BM;
        if (colt >= 4096) {
            if (wc == 0 && fq < 2) {
#pragma unroll
                for (int ai = 0; ai < 2; ++ai)
#pragma unroll
                    for (int m = 0; m < 4; ++m) { const int row = row0 + ai * HALF + m * 16; const float rs = row_rstd16(ss, row);
#pragma unroll
                        for (int n = 0; n < 2; ++n) { const f32x4 v = acc[ai][0][m][n] * rs; *(f32x4*)(AB + (size_t)row * 16 + 8 * fq + 4 * n) = v; } }
            }
            return;
        }
        const int plane = colt >> 10; bf16_t* base = O + (size_t)plane * plane_stride; const int col0 = (colt & 1023) + wc * 32 + 8 * fq;
#pragma unroll
        for (int ai = 0; ai < 2; ++ai)
#pragma unroll
            for (int m = 0; m < 4; ++m) { const int row = row0 + ai * HALF + m * 16; const float rs = (tsel >= 0) ? rs_tab[tsel + (row & 255)] : row_rstd16(ss, row);
                bf16_t* rowp = base + (size_t)row * 1024 + col0;
#pragma unroll
                for (int bj = 0; bj < 2; ++bj) { f32x4 v0 = acc[ai][bj][m][0] * rs, v1 = acc[ai][bj][m][1] * rs;
                    if (plane == 3) {
#pragma unroll
                        for (int e = 0; e < 4; ++e) { v0[e] = v0[e] * __builtin_amdgcn_rcpf(1.0f + __expf(-v0[e])); v1[e] = v1[e] * __builtin_amdgcn_rcpf(1.0f + __expf(-v1[e])); } }
                    u32x4 w; w.x = cvt_pk_bf16(v0[0], v0[1]); w.y = cvt_pk_bf16(v0[2], v0[3]); w.z = cvt_pk_bf16(v1[0], v1[1]); w.w = cvt_pk_bf16(v1[2], v1[3]);
                    *(u32x4*)(rowp + bj * HALF) = w;
                    if (halo != nullptr && plane < 3 && m == 3 && fr >= 13) *(u32x4*)(halo + ((size_t)(row >> 6) * 3 + (fr - 13)) * 3072 + plane * 1024 + col0 + bj * HALF) = w; } }
    }
};
struct EpiUp {
    static constexpr bool PERM = true, AFTER_DRAIN = false;
    bf16_t* O; const float* ss; const PG8_LAS float* rs_tab; int pm_a, pm_b;
    __device__ __forceinline__ void operator()(const f32x4 (&acc)[2][2][4][2], const Unit& u, int wr, int wc, int fr, int fq) const {
        const int tsel = (u.pm == pm_a) ? 0 : ((u.pm == pm_b) ? 256 : -1);
        const int row0 = u.pm * BM + wr * 64 + fr; const int col0 = u.pn * BM + wc * 32 + 8 * fq;
#pragma unroll
        for (int ai = 0; ai < 2; ++ai)
#pragma unroll
            for (int m = 0; m < 4; ++m) { const int row = row0 + ai * HALF + m * 16; const float rs = (tsel >= 0) ? rs_tab[tsel + (row & 255)] : row_rstd16(ss, row);
                bf16_t* rowp = O + (size_t)row * 4096 + col0;
#pragma unroll
                for (int bj = 0; bj < 2; ++bj) { f32x4 v0 = acc[ai][bj][m][0] * rs, v1 = acc[ai][bj][m][1] * rs;
#pragma unroll
                    for (int e = 0; e < 4; ++e) { const float a0 = fmaxf(v0[e], 0.f), a1 = fmaxf(v1[e], 0.f); v0[e] = a0 * a0; v1[e] = a1 * a1; }
                    u32x4 w; w.x = cvt_pk_bf16(v0[0], v0[1]); w.y = cvt_pk_bf16(v0[2], v0[3]); w.z = cvt_pk_bf16(v1[0], v1[1]); w.w = cvt_pk_bf16(v1[2], v1[3]);
                    *(u32x4*)(rowp + bj * HALF) = w; } }
    }
};
struct EpiRes {
    static constexpr bool PERM = true, AFTER_DRAIN = false;
    bf16_t* hb; float* ss_next; const float* rowss; const PG8_LAS float* rs_tab; int pm_a, pm_b;
    __device__ __forceinline__ void operator()(const f32x4 (&acc)[2][2][4][2], const Unit& u, int wr, int wc, int fr_, int fq_) const {
        int fr = fr_, fq = fq_; asm volatile("" : "+v"(fr), "+v"(fq));
        const int tsel = (u.pm == pm_a) ? 0 : ((u.pm == pm_b) ? 256 : -1);
        const int row0 = u.pm * BM + wr * 64 + fr; const int col0 = u.pn * BM + wc * 32 + 8 * fq;
        u32x4 hq[3][2];
#define EPIRES_LD(slot, g_) do { const size_t off_ = (size_t)(row0 + ((g_) >> 2) * HALF + ((g_) & 3) * 16) * 1024 + col0; hq[slot][0] = *(const u32x4*)(hb + off_); hq[slot][1] = *(const u32x4*)(hb + off_ + HALF); } while (0)
        EPIRES_LD(0, 0); EPIRES_LD(1, 1);
#pragma unroll
        for (int g = 0; g < 8; ++g) { const int ai = g >> 2, m = g & 3; const int row = row0 + ai * HALF + m * 16;
            if (g + 2 < 8) EPIRES_LD((g + 2) % 3, g + 2);
            const float sc = rowss ? ((tsel >= 0) ? rs_tab[tsel + (row & 255)] : row_rstd16(rowss, row)) : 1.0f;
            const size_t off = (size_t)row * 1024 + col0; float q = 0.f;
#pragma unroll
            for (int bj = 0; bj < 2; ++bj) { const u32x4 hw = hq[g % 3][bj];
                const f32x4 h0 = (f32x4){__uint_as_float(hw.x << 16), __uint_as_float(hw.x & 0xffff0000u), __uint_as_float(hw.y << 16), __uint_as_float(hw.y & 0xffff0000u)};
                const f32x4 h1 = (f32x4){__uint_as_float(hw.z << 16), __uint_as_float(hw.z & 0xffff0000u), __uint_as_float(hw.w << 16), __uint_as_float(hw.w & 0xffff0000u)};
                const f32x4 v0 = h0 + acc[ai][bj][m][0] * sc, v1 = h1 + acc[ai][bj][m][1] * sc;
                u32x4 w; w.x = cvt_pk_bf16(v0[0], v0[1]); w.y = cvt_pk_bf16(v0[2], v0[3]); w.z = cvt_pk_bf16(v1[0], v1[1]); w.w = cvt_pk_bf16(v1[2], v1[3]);
                *(u32x4*)(hb + off + bj * HALF) = w;
                q += (v0[0] * v0[0] + v0[1] * v0[1]) + (v0[2] * v0[2] + v0[3] * v0[3]) + (v1[0] * v1[0] + v1[1] * v1[1]) + (v1[2] * v1[2] + v1[3] * v1[3]); }
            q += __shfl_xor(q, 16); q += __shfl_xor(q, 32);
            if (fq == 0) ss_next[(size_t)row * 16 + u.pn * 4 + wc] = q;
            asm volatile("" ::: "memory"); }
#undef EPIRES_LD
    }
};

template <class Epi, class Sched, bool ALIGN_EPI = false, bool SP2 = false>
__device__ __forceinline__ void gemm_phase(PG8_LAS unsigned char* lds, const Gemm g, const Sched& S, const Epi& E) {
    int tid = threadIdx.x; asm volatile("" : "+v"(tid));
    const int wid = __builtin_amdgcn_readfirstlane(tid >> 6), lane = tid & 63, wr = wid >> 2, wc = wid & 3, fr = lane & 15, fq = lane >> 4;
    const int K = g.K, nt = K / BK;
    unsigned voffA[2], voffB[2];
#pragma unroll
    for (int i = 0; i < 2; ++i) { int R, C; stage_rc(tid * 16 + i * 8192, R, C); const int Rb = Epi::PERM ? ((R & ~31) + perm32(R & 31)) : R;
        voffA[i] = (unsigned)(R * K + C) * 2u; voffB[i] = (unsigned)(Rb * K + C) * 2u; }
    const size_t kstep = (size_t)(BK * 2);
    const size_t hstep = (size_t)HALF * K * 2;
    const size_t tstep = 2 * hstep;
    const unsigned ldsw = (unsigned)wid * 1024u;
    const int aoff = lds_byte(wr * 64 + fr, fq * 8), boff = lds_byte(wc * 32 + fr, fq * 8);
#define PG8_SA(b, h) (((b) * 2 + (h)) * HTB)
#define PG8_SB(b, h) ((4 + (b) * 2 + (h)) * HTB)
#define PG8_STAGE(bufoff, gbase, voff) do { _Pragma("unroll") for (int _i = 0; _i < 2; ++_i) \
        __builtin_amdgcn_global_load_lds((const unsigned*)((const char*)(gbase) + (voff)[_i]), (PG8_LAS unsigned*)(lds + (bufoff) + ldsw + _i * 8192), 16, 0, 0); } while (0)
#define PG8_LDA(dst, b, h) do { _Pragma("unroll") for (int m = 0; m < 4; ++m) _Pragma("unroll") for (int k = 0; k < 2; ++k) dst[m][k] = *(const PG8_LAS bf16x8*)(lds + PG8_SA(b, h) + aoff + m * 2048 + k * 1024); } while (0)
#define PG8_LDB(dst, b, h) do { _Pragma("unroll") for (int n = 0; n < 2; ++n) _Pragma("unroll") for (int k = 0; k < 2; ++k) dst[n][k] = *(const PG8_LAS bf16x8*)(lds + PG8_SB(b, h) + boff + n * 2048 + k * 1024); } while (0)
#define PG8_MMA(ai, bj, At, Bt) do { __builtin_amdgcn_s_setprio(1); _Pragma("unroll") for (int m = 0; m < 4; ++m) _Pragma("unroll") for (int n = 0; n < 2; ++n) _Pragma("unroll") for (int k = 0; k < 2; ++k) \
        acc[ai][bj][m][n] = __builtin_amdgcn_mfma_f32_16x16x32_bf16(Bt[n][k], At[m][k], acc[ai][bj][m][n], 0, 0, 0); __builtin_amdgcn_s_setprio(0); } while (0)
#define PG8_WAIT_V(n) asm volatile("s_waitcnt vmcnt(" #n ")" ::: "memory")
#define PG8_WAIT_L(n) asm volatile("s_waitcnt lgkmcnt(" #n ")" ::: "memory")
#define PG8_BAR __builtin_amdgcn_s_barrier()
#define PG8_SCHED __builtin_amdgcn_sched_barrier(0)
    Unit cur, nxt; int ui = 0;
    if (!S.next(0, cur)) return;
    f32x4 acc[2][2][4][2];
#pragma unroll
    for (int a = 0; a < 2; ++a)
#pragma unroll
        for (int b = 0; b < 2; ++b)
#pragma unroll
            for (int m = 0; m < 4; ++m)
#pragma unroll
                for (int n = 0; n < 2; ++n) acc[a][b][m][n] = (f32x4){0.f, 0.f, 0.f, 0.f};
    bf16x8 At[4][2], B0[2][2], B1[2][2];
    const char* cA = (const char*)g.A + (size_t)cur.pm * tstep; const char* cB = (const char*)g.Bt + (size_t)cur.pn * tstep;
    S.a_ready(cur);
    if constexpr (SP2) {
        PG8_STAGE(PG8_SB(0, 0), cB, voffB); PG8_STAGE(PG8_SB(0, 1), cB + hstep, voffB); PG8_STAGE(PG8_SA(0, 0), cA, voffA); PG8_STAGE(PG8_SA(0, 1), cA + hstep, voffA);
        if (wr == 1) PG8_BAR;
        PG8_WAIT_V(2); PG8_BAR;
        PG8_STAGE(PG8_SB(1, 0), cB + kstep, voffB); PG8_STAGE(PG8_SA(1, 0), cA + kstep, voffA); PG8_STAGE(PG8_SB(1, 1), cB + hstep + kstep, voffB);
        PG8_WAIT_V(6); PG8_BAR;
    } else {
        PG8_STAGE(PG8_SB(0, 0), cB, voffB); PG8_STAGE(PG8_SA(0, 0), cA, voffA); PG8_STAGE(PG8_SB(0, 1), cB + hstep, voffB); PG8_STAGE(PG8_SA(0, 1), cA + hstep, voffA);
        if (wr == 1) PG8_BAR;
        PG8_WAIT_V(4); PG8_BAR;
        PG8_STAGE(PG8_SB(1, 0), cB + kstep, voffB); PG8_STAGE(PG8_SA(1, 0), cA + kstep, voffA); PG8_STAGE(PG8_SB(1, 1), cB + hstep + kstep, voffB);
        PG8_WAIT_V(6); PG8_BAR;
    }
    for (;;) {
        const bool has_next = S.next(ui + 1, nxt);
        const char* nA = has_next ? (const char*)g.A + (size_t)nxt.pm * tstep : cA; const char* nB = has_next ? (const char*)g.Bt + (size_t)nxt.pn * tstep : cB;
        for (int t = 0; t < nt; t += 2) {
            const bool last = (t == nt - 2);
            const char* a1 = cA + (size_t)(t + 1) * kstep;
            const char* a2 = last ? nA : cA + (size_t)(t + 2) * kstep; const char* b2 = last ? nB : cB + (size_t)(t + 2) * kstep;
            const char* a3 = a2 + kstep; const char* b3 = b2 + kstep;
            if (last && has_next) S.a_ready(nxt);
            if constexpr (SP2) {
            PG8_LDB(B0, 0, 0); PG8_LDB(B1, 0, 1); PG8_SCHED; PG8_LDA(At, 0, 0); PG8_STAGE(PG8_SA(1, 1), a1 + hstep, voffA);
            PG8_WAIT_V(8); PG8_WAIT_L(0); PG8_BAR; PG8_MMA(0, 0, At, B0); PG8_MMA(0, 1, At, B1); PG8_BAR; PG8_SCHED;
            PG8_LDA(At, 0, 1); PG8_STAGE(PG8_SB(0, 0), b2, voffB); PG8_STAGE(PG8_SB(0, 1), b2 + hstep, voffB); PG8_STAGE(PG8_SA(0, 0), a2, voffA);
            PG8_WAIT_V(8); PG8_WAIT_L(0); PG8_BAR; PG8_MMA(1, 0, At, B0); PG8_MMA(1, 1, At, B1); PG8_BAR; PG8_SCHED;
            PG8_LDB(B0, 1, 0); PG8_LDB(B1, 1, 1); PG8_SCHED; PG8_LDA(At, 1, 0); PG8_STAGE(PG8_SA(0, 1), a2 + hstep, voffA);
            PG8_WAIT_V(8); PG8_WAIT_L(0); PG8_BAR; PG8_MMA(0, 0, At, B0); PG8_MMA(0, 1, At, B1); PG8_BAR; PG8_SCHED;
            PG8_LDA(At, 1, 1); PG8_STAGE(PG8_SB(1, 0), b3, voffB); PG8_STAGE(PG8_SB(1, 1), b3 + hstep, voffB); PG8_STAGE(PG8_SA(1, 0), a3, voffA);
            PG8_WAIT_V(8); PG8_WAIT_L(0); PG8_BAR; PG8_MMA(1, 0, At, B0); PG8_MMA(1, 1, At, B1); PG8_BAR; PG8_SCHED;
            } else {
            PG8_LDB(B0, 0, 0); PG8_SCHED; PG8_LDA(At, 0, 0); PG8_STAGE(PG8_SA(1, 1), a1 + hstep, voffA);
            PG8_WAIT_L(8); PG8_BAR; PG8_WAIT_L(0); PG8_MMA(0, 0, At, B0); PG8_BAR; PG8_SCHED;
            PG8_LDB(B1, 0, 1); PG8_STAGE(PG8_SB(0, 0), b2, voffB);
            PG8_BAR; PG8_WAIT_L(0); PG8_MMA(0, 1, At, B1); PG8_BAR;
            PG8_LDA(At, 0, 1); PG8_STAGE(PG8_SA(0, 0), a2, voffA);
            PG8_BAR; PG8_WAIT_L(0); PG8_MMA(1, 0, At, B0); PG8_BAR; PG8_SCHED;
            PG8_STAGE(PG8_SB(0, 1), b2 + hstep, voffB);
            PG8_WAIT_V(6); PG8_BAR; PG8_MMA(1, 1, At, B1); PG8_BAR;
            PG8_LDB(B0, 1, 0); PG8_SCHED; PG8_LDA(At, 1, 0); PG8_STAGE(PG8_SA(0, 1), a2 + hstep, voffA);
            PG8_WAIT_L(8); PG8_BAR; PG8_WAIT_L(0); PG8_MMA(0, 0, At, B0); PG8_BAR; PG8_SCHED;
            PG8_LDB(B1, 1, 1); PG8_STAGE(PG8_SB(1, 0), b3, voffB);
            PG8_BAR; PG8_WAIT_L(0); PG8_MMA(0, 1, At, B1); PG8_BAR;
            PG8_LDA(At, 1, 1); PG8_STAGE(PG8_SA(1, 0), a3, voffA);
            PG8_BAR; PG8_WAIT_L(0); PG8_MMA(1, 0, At, B0); PG8_BAR; PG8_SCHED;
            PG8_STAGE(PG8_SB(1, 1), b3 + hstep, voffB);
            PG8_WAIT_V(6); PG8_BAR; PG8_MMA(1, 1, At, B1); PG8_BAR;
            }
        }
        if constexpr (ALIGN_EPI) { if (wr == 0) PG8_BAR; }
        if constexpr (!Epi::AFTER_DRAIN) { E(acc, cur, wr, wc, fr, fq); S.done(cur); }
        if (!has_next) break;
#pragma unroll
        for (int a = 0; a < 2; ++a)
#pragma unroll
            for (int b = 0; b < 2; ++b)
#pragma unroll
                for (int m = 0; m < 4; ++m)
#pragma unroll
                    for (int n = 0; n < 2; ++n) acc[a][b][m][n] = (f32x4){0.f, 0.f, 0.f, 0.f};
        cur = nxt; cA = nA; cB = nB; ++ui;
        if constexpr (ALIGN_EPI) { if (wr == 1) PG8_BAR; }
    }
    PG8_WAIT_V(0);
    if constexpr (!ALIGN_EPI) { if (wr == 0) PG8_BAR; }
    PG8_BAR;
    if constexpr (Epi::AFTER_DRAIN) { E.fused(acc, cur, wr, wc, fr, fq, lds, wid, lane); S.done(cur); }
#undef PG8_SA
#undef PG8_SB
#undef PG8_STAGE
#undef PG8_LDA
#undef PG8_LDB
#undef PG8_MMA
#undef PG8_WAIT_V
#undef PG8_WAIT_L
#undef PG8_BAR
#undef PG8_SCHED
}
}

#define LAS __attribute__((address_space(3)))
typedef unsigned short bf16_t;
typedef short bf16x8 __attribute__((ext_vector_type(8)));
typedef float f32x4 __attribute__((ext_vector_type(4)));
typedef unsigned u32x4 __attribute__((ext_vector_type(4)));
typedef unsigned u32x2 __attribute__((ext_vector_type(2)));
constexpr int NWAVES = 8, NTHREADS = 512;
constexpr int M_TOK = 32768, DMODEL = 1024, NCH = 512  , NITEM = 4096  ;
constexpr float EPS = 1e-6f;
constexpr size_t MiB = 1u << 20;
constexpr size_t PLANE = (size_t)M_TOK * 1024;
constexpr size_t WS_BAR = 0;
constexpr size_t WS_LB = 1536 * 1024;
constexpr size_t WS_WGI = 2 * MiB, WS_WGO = 19 * MiB, WS_WHI = 23 * MiB, WS_WHO = 39 * MiB, WS_WUP = 43 * MiB, WS_WDN = 75 * MiB;
constexpr size_t WS_PROJ = 108 * MiB;
constexpr size_t WS_HB = 364 * MiB;
constexpr size_t WS_AQK = 428 * MiB;
constexpr size_t WS_HALO = 460 * MiB;
constexpr size_t WS_AB = 470 * MiB;
constexpr size_t WS_DEC = 472 * MiB;
constexpr size_t WS_SSA = 474 * MiB, WS_SSB = 476 * MiB;
constexpr size_t WS_SSO = 478 * MiB;
constexpr size_t WS_END = 480 * MiB;
constexpr int GDN_NPAD = 4352;
constexpr int LDS_BYTES = 147456;

__device__ __forceinline__ float bf2f(unsigned v) { return __uint_as_float(v << 16); }
__device__ __forceinline__ float bflo(unsigned w) { return __uint_as_float(w << 16); }
__device__ __forceinline__ float bfhi(unsigned w) { return __uint_as_float(w & 0xffff0000u); }
__device__ __forceinline__ unsigned f2bf(float f) { unsigned u = __float_as_uint(f); return (u + 0x7fffu + ((u >> 16) & 1u)) >> 16; }
__device__ __forceinline__ unsigned pk2(float lo, float hi) { return pg8::cvt_pk_bf16(lo, hi); }
__device__ __forceinline__ float frcp_(float x) { return __builtin_amdgcn_rcpf(x); }
__device__ __forceinline__ float sigmoidf_(float x) { return frcp_(1.0f + __expf(-x)); }
__device__ __forceinline__ float siluf_(float x) { return x * frcp_(1.0f + __expf(-x)); }
__device__ __forceinline__ float row16_sum(float v);
__device__ __forceinline__ float wave_sum(float v) {
    v = row16_sum(v);
    { const auto r16 = __builtin_amdgcn_permlane16_swap(__float_as_uint(v), __float_as_uint(v), false, false); v = __uint_as_float(r16[0]) + __uint_as_float(r16[1]); }
    { const auto r32 = __builtin_amdgcn_permlane32_swap(__float_as_uint(v), __float_as_uint(v), false, false); v = __uint_as_float(r32[0]) + __uint_as_float(r32[1]); }
    return v;
}
#define LDS_WAIT() asm volatile("s_waitcnt lgkmcnt(0)" ::: "memory")
__device__ __forceinline__ float row16_sum(float v) {
    v += __builtin_bit_cast(float, __builtin_amdgcn_update_dpp(0, __builtin_bit_cast(int, v), 0xB1, 0xF, 0xF, false));
    v += __builtin_bit_cast(float, __builtin_amdgcn_update_dpp(0, __builtin_bit_cast(int, v), 0x4E, 0xF, 0xF, false));
    v += __builtin_bit_cast(float, __builtin_amdgcn_update_dpp(0, __builtin_bit_cast(int, v), 0x141, 0xF, 0xF, false));
    v += __builtin_bit_cast(float, __builtin_amdgcn_update_dpp(0, __builtin_bit_cast(int, v), 0x140, 0xF, 0xF, false));
    return v;
}
#define LBAR() do { asm volatile("s_waitcnt lgkmcnt(0)" ::: "memory"); __builtin_amdgcn_s_barrier(); asm volatile("" ::: "memory"); } while (0)

template <int K> __device__ __forceinline__ f32x4 mm_tile(const LAS bf16_t* A1, int s1, const LAS bf16_t* A2, int s2, f32x4 acc, int lane) {
    const LAS bf16_t* p1 = A1 + (lane & 15) * s1 + (lane >> 4) * 8;
    const LAS bf16_t* p2 = A2 + (lane & 15) * s2 + (lane >> 4) * 8;
#pragma unroll
    for (int k0 = 0; k0 < K; k0 += 32) {
        const bf16x8 a = *(const LAS bf16x8*)(p1 + k0); const bf16x8 b = *(const LAS bf16x8*)(p2 + k0);
        acc = __builtin_amdgcn_mfma_f32_16x16x32_bf16(a, b, acc, 0, 0, 0);
    }
    return acc;
}

#define XB_TMO      128
#define XB_XCNT(j)  (256  + 64 * (j))
#define XB_XSUB(j)  (1280 + 64 * (j))
#define XB_XGEN(j)  (2304 + 64 * (j))
#define XB_TOP      3328
#define XB_TOPGEN   3392
#define XCD_BAR_WORDS 3456
#define XB_SPIN_CAP (1u << 18)

__device__ __forceinline__ unsigned xb_ld(unsigned* p)              { return __hip_atomic_load(p, __ATOMIC_RELAXED, __HIP_MEMORY_SCOPE_AGENT); }
__device__ __forceinline__ unsigned xb_add(unsigned* p, unsigned v) { return __hip_atomic_fetch_add(p, v, __ATOMIC_RELAXED, __HIP_MEMORY_SCOPE_AGENT); }
__device__ __forceinline__ unsigned xb_xcc_id() { return (unsigned)__builtin_amdgcn_s_getreg((3 << 11) | 20) & 0xFu; }
#define XB_SPIN(cond, bar) do { unsigned _sp = 0; while (cond) { __builtin_amdgcn_s_sleep(1); \
    if ((++_sp & 255u) == 0u) { if (xb_ld(&(bar)[XB_TMO])) break; if (_sp > XB_SPIN_CAP) { atomicAdd(&(bar)[XB_TMO], 1u); break; } } } } while (0)

struct XcdBarrier {
    unsigned* bar; unsigned x;
    volatile LAS unsigned* st;
};

__device__ __forceinline__ XcdBarrier xcd_barrier_post(unsigned* bar, volatile LAS unsigned* st) {
    XcdBarrier b; b.bar = bar; b.x = xb_xcc_id(); b.st = st;
    if (threadIdx.x == 0) (void)xb_add(&bar[XB_XCNT(b.x)], 1u);
    return b;
}
__device__ __forceinline__ void xcd_barrier_complete(unsigned* bar, unsigned x, unsigned& nloc, unsigned& nx) {
    const unsigned G = gridDim.x * gridDim.y * gridDim.z;
    unsigned sum, cnt, mine, sp = 0u;
    for (;;) {
        sum = 0u; cnt = 0u; mine = 0u;
#pragma unroll
        for (unsigned j = 0; j < 16; ++j) { const unsigned c = xb_ld(&bar[XB_XCNT(j)]); sum += c; cnt += (c > 0u) ? 1u : 0u; mine = (j == x) ? c : mine; }
        if (sum == G) break;
        __builtin_amdgcn_s_sleep(1);
        if ((++sp & 255u) == 0u) { if (xb_ld(&bar[XB_TMO])) break; if (sp > XB_SPIN_CAP) { atomicAdd(&bar[XB_TMO], 1u); break; } }
    }
    nloc = mine > 0u ? mine : 1u; nx = cnt > 0u ? cnt : 1u;
}

__device__ __forceinline__ void xcd_barrier(const XcdBarrier& b) {
    asm volatile("s_waitcnt vmcnt(0)" ::: "memory");
    __syncthreads();
    if (threadIdx.x == 0) {
        unsigned* bar = b.bar;
        __builtin_amdgcn_s_waitcnt(0);
        unsigned nloc = b.st[0], nx = b.st[1];
        if (nloc == 0u) { xcd_barrier_complete(bar, b.x, nloc, nx); b.st[0] = nloc; b.st[1] = nx; }
        const unsigned old = xb_add(&bar[XB_XSUB(b.x)], 1u);
        const unsigned gen = old / nloc;
        if (old + 1u == (gen + 1u) * nloc) {
            __builtin_amdgcn_fence(__ATOMIC_RELEASE, "agent");
            asm volatile("s_waitcnt vmcnt(0)" ::: "memory");
            const unsigned og = xb_add(&bar[XB_TOP], 1u);
            const unsigned tg = og / nx;
            if (og + 1u == (tg + 1u) * nx) xb_add(&bar[XB_TOPGEN], 1u);
            else XB_SPIN(xb_ld(&bar[XB_TOPGEN]) == tg, bar);
            __builtin_amdgcn_fence(__ATOMIC_ACQUIRE, "agent");
            xb_add(&bar[XB_XGEN(b.x)], 1u);
            asm volatile("s_waitcnt vmcnt(0)" ::: "memory");
        } else {
            XB_SPIN(xb_ld(&bar[XB_XGEN(b.x)]) == gen, bar);
            __builtin_amdgcn_fence(__ATOMIC_ACQUIRE, "agent");
            asm volatile("s_waitcnt vmcnt(0)" ::: "memory");
        }
    }
    __syncthreads();
}
__device__ __forceinline__ void transpose_item(const float* W, int K, int Nsrc, int Npad, const float* nw, bf16_t* WT, LAS float* scr, int item, int lane) {
    const int nblk = Npad / 32, kb = item / nblk, nb = item % nblk, k0 = 64 * kb, n0 = 32 * nb;
    { const int c4 = lane & 7, n = n0 + c4 * 4; f32x4 v[8];
#pragma unroll
      for (int i = 0; i < 8; ++i) { const int kk = 8 * i + (lane >> 3); v[i] = (n < Nsrc) ? *(const f32x4*)(W + (size_t)(k0 + kk) * Nsrc + n) : (f32x4){0.f, 0.f, 0.f, 0.f}; }
#pragma unroll
      for (int i = 0; i < 8; ++i) { const int kk = 8 * i + (lane >> 3); const float sc = nw ? nw[k0 + kk] : 1.0f;
          scr[kk * 33 + c4 * 4 + 0] = v[i][0] * sc; scr[kk * 33 + c4 * 4 + 1] = v[i][1] * sc; scr[kk * 33 + c4 * 4 + 2] = v[i][2] * sc; scr[kk * 33 + c4 * 4 + 3] = v[i][3] * sc; } }
    LDS_WAIT(); asm volatile("" ::: "memory");
    const int c = lane & 7;
#pragma unroll
    for (int j = 0; j < 4; ++j) { const int n = (lane >> 3) + 8 * j; const LAS float* s = scr + (8 * c) * 33 + n;
        u32x4 o; o.x = pk2(s[0 * 33], s[1 * 33]); o.y = pk2(s[2 * 33], s[3 * 33]); o.z = pk2(s[4 * 33], s[5 * 33]); o.w = pk2(s[6 * 33], s[7 * 33]);
        *(u32x4*)(WT + (size_t)(n0 + n) * K + k0 + 8 * c) = o; }
    LDS_WAIT(); asm volatile("" ::: "memory");
}

struct Args { const float* in[16]; float* out; unsigned char* ws; };

__device__ __forceinline__ void convert_layer_weights(const Args& a, LAS unsigned char* lds, int tid, int i, int nworkers) {
    asm volatile("" : "+v"(tid));
    const int worker = ((int)blockIdx.x - 128) * NWAVES + (tid >> 6);
    const int lane = tid & 63, wave = __builtin_amdgcn_readfirstlane(tid >> 6); unsigned char* ws = a.ws; LAS float* scr = (LAS float*)(lds + wave * 16384);
    const int j = i >> 1; const bool gdn = (i & 1) == 0;
    constexpr int I_GI = 16 * (GDN_NPAD / 32), I_SQ = 16 * 32, I_HI = 16 * 128, I_UP = 16 * 128, I_DN = 64 * 32;
    const int n_next = (i == 3) ? 0 : (gdn ? I_HI : I_GI);
    const int total = I_SQ + I_UP + I_DN + n_next;
    for (int it = worker; it < total; it += nworkers) {
        int r = it; const float* W; const float* nw = nullptr; bf16_t* WT; int K = 1024, Nsrc = 1024, Npad = 1024;
        if (r < I_SQ) { W = (gdn ? a.in[6] : a.in[10]) + (size_t)j * 1024 * 1024; WT = (bf16_t*)(ws + (gdn ? WS_WGO : WS_WHO)) + (size_t)j * 1024 * 1024; }
        else if (r < I_SQ + I_UP) { r -= I_SQ; W = a.in[13] + (size_t)i * 1024 * 4096; Nsrc = 4096; Npad = 4096; nw = a.in[12] + i * 1024; WT = (bf16_t*)(ws + WS_WUP) + (size_t)i * 4096 * 1024; }
        else if (r < I_SQ + I_UP + I_DN) { r -= I_SQ + I_UP; W = a.in[14] + (size_t)i * 4096 * 1024; K = 4096; WT = (bf16_t*)(ws + WS_WDN) + (size_t)i * 1024 * 4096; }
        else { r -= I_SQ + I_UP + I_DN; nw = a.in[11] + (size_t)(i + 1) * 1024;
            if (gdn) { W = a.in[7] + (size_t)j * 1024 * 4096; Nsrc = 4096; Npad = 4096; WT = (bf16_t*)(ws + WS_WHI) + (size_t)j * 4096 * 1024; }
            else { W = a.in[1] + (size_t)(j + 1) * 1024 * 4112; Nsrc = 4112; Npad = GDN_NPAD; WT = (bf16_t*)(ws + WS_WGI) + (size_t)(j + 1) * GDN_NPAD * 1024; } }
        transpose_item(W, K, Nsrc, Npad, nw, WT, scr, r, lane);
    }
}

__device__ __forceinline__ void prologue(const Args& a, LAS unsigned char* lds, int tid) {
    asm volatile("" : "+v"(tid));
    const int lane = tid & 63, wave = __builtin_amdgcn_readfirstlane(tid >> 6);
    unsigned char* ws = a.ws;
    LAS float* scr = (LAS float*)(lds + wave * 16384);
    const int gw = blockIdx.x * NWAVES + wave, NGW = gridDim.x * NWAVES;
    const float* gdn_w_in = a.in[1]; const float* norm_mix = a.in[11];
    constexpr int I_GI = 16 * (GDN_NPAD / 32);
    for (int it = gw; it < I_GI; it += NGW) transpose_item(gdn_w_in, 1024, 4112, GDN_NPAD, norm_mix, (bf16_t*)(ws + WS_WGI), scr, it, lane);
    float* SSB = (float*)(ws + WS_SSB); bf16_t* HB = (bf16_t*)(ws + WS_HB); const float* x = a.in[0];
    for (int m = gw; m < M_TOK; m += NGW) {
        const f32x4* xr = (const f32x4*)(x + (size_t)m * DMODEL) + lane; float s = 0.f; f32x4 v[4];
#pragma unroll
        for (int j = 0; j < 4; ++j) { v[j] = xr[64 * j]; s += (v[j][0] * v[j][0] + v[j][1] * v[j][1]) + (v[j][2] * v[j][2] + v[j][3] * v[j][3]); }
        s = wave_sum(s);
        u32x2* o8 = (u32x2*)(HB + (size_t)m * DMODEL) + lane;
#pragma unroll
        for (int j = 0; j < 4; ++j) { u32x2 w; w.x = pk2(v[j][0], v[j][1]); w.y = pk2(v[j][2], v[j][3]); o8[64 * j] = w; }
        if (lane < 16) SSB[(size_t)m * 16 + lane] = (lane == 0) ? s : 0.f;
    }
    if (blockIdx.x == 0) {
        const float* lg = a.in[8]; float* LB = (float*)(ws + WS_LB);
        for (int c = tid; c < 1024; c += NTHREADS) {
            const float l0 = lg[c], l1 = lg[1024 + c], l2 = lg[2048 + c], l3 = lg[3072 + c];
            const float mx = fmaxf(fmaxf(l0, l1), fmaxf(l2, l3));
            const float e0 = expf(l0 - mx), e1 = expf(l1 - mx), e2 = expf(l2 - mx), e3 = expf(l3 - mx); const float inv = 1.0f / (e0 + e1 + e2 + e3);
            LB[c] = e1 * inv; LB[1024 + c] = (e1 + e2 + e3) * inv;
        }
    }
}

__device__ __forceinline__ void gdn_prep(LAS unsigned char* lds, int tid, bf16_t* P, bf16_t* Wpl, bf16_t* AQK, const bf16_t* HALO, const float* AB, float* DEC,
                                         const float* conv_w, const float* a_log, const float* dt_bias
#ifdef PROBE_SEL
                                         , unsigned& tacc, unsigned& tprev
#endif
                                         ) {
#ifdef PROBE_SEL
#define PSTAMP(k) do { const unsigned t_ = (unsigned)__builtin_amdgcn_s_memrealtime(); if ((k) == PROBE_SEL) tacc += t_ - tprev; tprev = t_; } while (0)
#else
#define PSTAMP(k) do {} while (0)
#endif
    asm volatile("" : "+v"(tid));
    const int lane = tid & 63, wave = __builtin_amdgcn_readfirstlane(tid >> 6);
    LAS bf16_t* QB = (LAS bf16_t*)lds; LAS bf16_t* KB = QB + 64 * 136; LAS bf16_t* VB = KB + 64 * 136;
    LAS float* LM = (LAS float*)(lds + 52224);
    LAS float* GC = (LAS float*)(lds + 69632); LAS float* BETA = GC + 64; LAS float* EG = BETA + 64; LAS float* BEG = EG + 64;
    LAS bf16_t* LBh = (LAS bf16_t*)(lds + 70656);
    LAS bf16_t* SOLT = (LAS bf16_t*)(lds + 79872);
    LAS float* XU = (LAS float*)(lds + 116736);
    LAS bf16_t* AQT = (LAS bf16_t*)(lds + 116736);
    LAS float* CW = (LAS float*)(lds + 133376);
    for (int i = tid; i < 256 * 72 / 2; i += NTHREADS) ((LAS unsigned*)SOLT)[i] = 0u;
    const int h = blockIdx.x & 7;
    for (int i = tid; i < 3 * 4 * 128; i += NTHREADS) { const int pp = i >> 9, kk = (i >> 7) & 3, c = i & 127; CW[i] = conv_w[kk * 3072 + pp * 1024 + h * 128 + c]; }
    __syncthreads();
    const float ealog_h = expf(a_log[h]), dtb_h = dt_bias[h];
    u32x4 xa[7], xb[5]; float pav = 0.f, pbv = 0.f; bool za = false; int zb = 0;
#pragma unroll
    for (int r = 0; r < 7; ++r) xa[r] = (u32x4){0u, 0u, 0u, 0u};
#pragma unroll
    for (int r = 0; r < 5; ++r) xb[r] = (u32x4){0u, 0u, 0u, 0u};
#define GDN_LOADS(itx) do { const int cidx_ = (itx) >> 3, n_ = cidx_ & 31; const unsigned cb_ = (unsigned)cidx_ * 131072u; const unsigned PL2_ = (unsigned)(PLANE * 2); \
        const bf16_t* hal_ = HALO + (size_t)(n_ > 0 ? cidx_ - 1 : cidx_) * 3 * 3072 + ch;     \
        _Pragma("unroll") for (int r_ = 0; r_ < 7; ++r_) { const int t_ = segA * 4 - 3 + r_; const bf16_t* q_ = (const bf16_t*)((const char*)P + ((unsigned)pA * PL2_ + cb_ + (unsigned)(((t_ < 0 ? 0 : t_) * 1024 + ch) * 2))); \
            const bf16_t* a_ = (r_ < 3 && t_ < 0) ? hal_ + (size_t)(t_ + 3) * 3072 + pA * 1024 : q_; xa[r_] = *(const u32x4*)a_; } \
        _Pragma("unroll") for (int r_ = 0; r_ < 5; ++r_) { const int t_ = segB * 2 - 3 + r_; const bf16_t* q_ = (const bf16_t*)((const char*)P + (2u * PL2_ + cb_ + (unsigned)(((t_ < 0 ? 0 : t_) * 1024 + ch) * 2))); \
            const bf16_t* a_ = (r_ < 3 && t_ < 0) ? hal_ + (size_t)(t_ + 3) * 3072 + 2 * 1024 : q_; xb[r_] = *(const u32x4*)a_; } \
        za = (n_ == 0 && segA == 0); zb = (n_ == 0) ? (3 - segB * 2) : 0; \
        if (tid >= 448) { pav = AB[((size_t)cidx_ * 64 + lane) * 16 + h]; pbv = AB[((size_t)cidx_ * 64 + lane) * 16 + 8 + h]; } } while (0)
    const int tid_in = tid;
    if ((int)blockIdx.x < NITEM) { const int pA = tid >> 8, segA = (tid >> 4) & 15, segB = tid >> 4, cg8 = tid & 15; const int ch = h * 128 + cg8 * 8; GDN_LOADS((int)blockIdx.x); }
    for (int it = blockIdx.x; it < NITEM; it += gridDim.x) {
        int tid = tid_in; asm volatile("" : "+v"(tid));
        const int lane = tid & 63;
        const int pA = tid >> 8, segA = (tid >> 4) & 15, segB = tid >> 4, cg8 = tid & 15; const int ch = h * 128 + cg8 * 8;
        const int cidx = it >> 3; const size_t row0 = (size_t)cidx * 64;
        {
            typedef float f32x2 __attribute__((ext_vector_type(2)));
#define GDN_CONV_TOKEN(xf_, tt_, y_) do { \
                _Pragma("unroll") for (int e_ = 0; e_ < 4; ++e_) y_[e_] = cw[0][e_] * xf_[(tt_)][e_]; \
                _Pragma("unroll") for (int kk_ = 1; kk_ < 4; ++kk_) _Pragma("unroll") for (int e_ = 0; e_ < 4; ++e_) y_[e_] = cw[kk_][e_] * xf_[(tt_) + kk_][e_] + y_[e_]; \
                _Pragma("unroll") for (int e_ = 0; e_ < 4; ++e_) { f32x2 ex_; ex_.x = __expf(-y_[e_].x); ex_.y = __expf(-y_[e_].y); ex_ = ex_ + 1.0f; f32x2 rc_; rc_.x = frcp_(ex_.x); rc_.y = frcp_(ex_.y); y_[e_] = y_[e_] * rc_; } } while (0)
            f32x2 cw[4][4];
            {
#pragma unroll
                for (int kk = 0; kk < 4; ++kk) { const f32x4 c0 = *(const LAS f32x4*)(CW + (pA * 4 + kk) * 128 + cg8 * 8), c1 = *(const LAS f32x4*)(CW + (pA * 4 + kk) * 128 + cg8 * 8 + 4);
                    cw[kk][0] = (f32x2){c0[0], c0[1]}; cw[kk][1] = (f32x2){c0[2], c0[3]}; cw[kk][2] = (f32x2){c1[0], c1[1]}; cw[kk][3] = (f32x2){c1[2], c1[3]}; }
                f32x2 xf[7][4];
#pragma unroll
                for (int r = 0; r < 7; ++r) { const u32x4 w = (r < 3 && za) ? (u32x4){0u, 0u, 0u, 0u} : xa[r]; xf[r][0] = (f32x2){bflo(w.x), bfhi(w.x)}; xf[r][1] = (f32x2){bflo(w.y), bfhi(w.y)}; xf[r][2] = (f32x2){bflo(w.z), bfhi(w.z)}; xf[r][3] = (f32x2){bflo(w.w), bfhi(w.w)}; }
                LAS bf16_t* dstb = QB + pA * 64 * 136 + cg8 * 8;
#pragma unroll
                for (int tt = 0; tt < 4; ++tt) {
                    f32x2 y[4]; GDN_CONV_TOKEN(xf, tt, y);
                    f32x2 sq = (f32x2){0.f, 0.f};
#pragma unroll
                    for (int e = 0; e < 4; ++e) sq = y[e] * y[e] + sq;
                    const float ssq = row16_sum(sq.x + sq.y);
                    const float rn = rsqrtf(ssq + EPS) * (pA == 0 ? 0.08838834764831845f : 1.0f);
#pragma unroll
                    for (int e = 0; e < 4; ++e) y[e] = y[e] * rn;
                    u32x4 o; o.x = pk2(y[0].x, y[0].y); o.y = pk2(y[1].x, y[1].y); o.z = pk2(y[2].x, y[2].y); o.w = pk2(y[3].x, y[3].y);
                    *(LAS u32x4*)(dstb + (segA * 4 + tt) * 136) = o;
                }
            }
            {
#pragma unroll
                for (int kk = 0; kk < 4; ++kk) { const f32x4 c0 = *(const LAS f32x4*)(CW + (2 * 4 + kk) * 128 + cg8 * 8), c1 = *(const LAS f32x4*)(CW + (2 * 4 + kk) * 128 + cg8 * 8 + 4);
                    cw[kk][0] = (f32x2){c0[0], c0[1]}; cw[kk][1] = (f32x2){c0[2], c0[3]}; cw[kk][2] = (f32x2){c1[0], c1[1]}; cw[kk][3] = (f32x2){c1[2], c1[3]}; }
                f32x2 xf[5][4];
#pragma unroll
                for (int r = 0; r < 5; ++r) { const u32x4 w = (r < 3 && r < zb) ? (u32x4){0u, 0u, 0u, 0u} : xb[r]; xf[r][0] = (f32x2){bflo(w.x), bfhi(w.x)}; xf[r][1] = (f32x2){bflo(w.y), bfhi(w.y)}; xf[r][2] = (f32x2){bflo(w.z), bfhi(w.z)}; xf[r][3] = (f32x2){bflo(w.w), bfhi(w.w)}; }
                LAS bf16_t* dstb = VB + cg8 * 8;
#pragma unroll
                for (int tt = 0; tt < 2; ++tt) {
                    f32x2 y[4]; GDN_CONV_TOKEN(xf, tt, y);
                    u32x4 o; o.x = pk2(y[0].x, y[0].y); o.y = pk2(y[1].x, y[1].y); o.z = pk2(y[2].x, y[2].y); o.w = pk2(y[3].x, y[3].y);
                    *(LAS u32x4*)(dstb + (segB * 2 + tt) * 136) = o;
                }
            }
#undef GDN_CONV_TOKEN
        }
        if (tid >= 448) {
            const float beta = sigmoidf_(pbv); const float xx = pav + dtb_h;
            const float sp = fmaxf(xx, 0.f) + __logf(1.0f + __expf(-fabsf(xx)));
            float g = -ealog_h * sp;
#pragma unroll
            for (int o = 1; o < 64; o <<= 1) { const float v = __shfl_up(g, o); if (lane >= o) g += v; }
            GC[lane] = g; BETA[lane] = beta; { const float eg = __expf(g); EG[lane] = eg; BEG[lane] = beta * eg; }
        }
        { const int itn = it + (int)gridDim.x; if (itn < NITEM) GDN_LOADS(itn); }
        LBAR(); PSTAMP(20);
#pragma unroll
        for (int q4 = 0; q4 < 4; ++q4) {
            const int tt = wave * 4 + q4, sel = tt >> 4, mi = (tt & 15) >> 2, nj = tt & 3;
            f32x4 acc = (f32x4){0.f, 0.f, 0.f, 0.f};
            if (nj <= mi) acc = mm_tile<128>((sel ? QB : KB) + mi * 16 * 136, 136, KB + nj * 16 * 136, 136, acc, lane);
            const int jc = nj * 16 + (lane & 15); const float gj = GC[jc];
#pragma unroll
            for (int jj = 0; jj < 4; ++jj) { const int i = mi * 16 + (lane >> 4) * 4 + jj;
                if (sel == 0) { float val = 0.f; if (jc < i) val = BETA[i] * acc[jj] * __expf(GC[i] - gj); LM[i * 68 + jc] = val; LBh[i * 72 + jc] = (bf16_t)f2bf(nj < mi ? val : 0.f); }
                else { float val = 0.f; if (jc <= i) val = acc[jj] * __expf(GC[i] - gj); AQT[i * 72 + jc] = (bf16_t)f2bf(val); } }
        }
        LBAR(); PSTAMP(21);
#pragma unroll
        for (int i2 = 0; i2 < 2; ++i2) { const int idx = tid + NTHREADS * i2, i = idx >> 4, c8 = idx & 15; const float e = EG[i];
            const u32x4 w = *(const LAS u32x4*)(QB + i * 136 + c8 * 8); u32x4 o;
            o.x = pk2(bflo(w.x) * e, bfhi(w.x) * e); o.y = pk2(bflo(w.y) * e, bfhi(w.y) * e); o.z = pk2(bflo(w.z) * e, bfhi(w.z) * e); o.w = pk2(bflo(w.w) * e, bfhi(w.w) * e);
            *(u32x4*)((char*)P + ((unsigned)cidx * 131072u + (unsigned)((i * 1024 + h * 128 + c8 * 8) * 2))) = o; }
        { const int dk = tid >> 2, cb = (tid & 3) * 16; const float gl = GC[63];
#pragma unroll
          for (int v = 0; v < 2; ++v) { float t[8];
#pragma unroll
              for (int e = 0; e < 8; ++e) { const int c = cb + v * 8 + e; t[e] = bf2f(KB[c * 136 + dk]) * __expf(gl - GC[c]); }
              u32x4 o; o.x = pk2(t[0], t[1]); o.y = pk2(t[2], t[3]); o.z = pk2(t[4], t[5]); o.w = pk2(t[6], t[7]);
              *(u32x4*)((char*)P + ((unsigned)(PLANE * 2) + (unsigned)cidx * 131072u + (unsigned)((((dk >> 1)) * 1024 + h * 128 + ((dk & 1) << 6) + cb + v * 8) * 2))) = o; } }
        { const int r = tid >> 3, c8 = tid & 7; *(u32x4*)((char*)AQK + ((unsigned)it * 8192u + (unsigned)((r * 64 + c8 * 8) * 2))) = *(const LAS u32x4*)(AQT + r * 72 + c8 * 8); }
        if (tid < 128) DEC[(size_t)it * 128 + tid] = EG[63];
        const bool solver = tid < 256; const bool isu = tid < 128;
        unsigned a_lm = (unsigned)(size_t)LM, a_xu = (unsigned)(size_t)(XU + (tid & 255)), a_nat = (unsigned)(size_t)((isu ? QB : KB) + (tid & 127));
        unsigned a_src = (unsigned)(size_t)(isu ? (VB + (tid & 127)) : (KB + (tid & 127))), a_fac = (unsigned)(size_t)(isu ? BETA : BEG);
        asm volatile("" : "+v"(a_src), "+v"(a_fac), "+v"(a_lm), "+v"(a_xu), "+v"(a_nat));
        LBAR(); PSTAMP(22);
#define GDN_SOLVE_BLOCK(bi) do { float sol_[16]; \
            _Pragma("unroll") for (int r_ = 0; r_ < 16; ++r_) { const int i_ = (bi) * 16 + r_; \
                float v_ = bf2f(*(const LAS bf16_t*)(size_t)(a_src + i_ * 272)) * *(const LAS float*)(size_t)(a_fac + i_ * 4); \
                if ((bi) > 0) v_ -= *(const LAS float*)(size_t)(a_xu + r_ * 1040); \
                _Pragma("unroll") for (int j4_ = 0; j4_ * 4 < r_; ++j4_) { const f32x4 l_ = *(const LAS f32x4*)(size_t)(a_lm + (i_ * 68 + (bi) * 16 + j4_ * 4) * 4); \
                    v_ -= l_[0] * sol_[j4_ * 4]; if (j4_ * 4 + 1 < r_) v_ -= l_[1] * sol_[j4_ * 4 + 1]; if (j4_ * 4 + 2 < r_) v_ -= l_[2] * sol_[j4_ * 4 + 2]; if (j4_ * 4 + 3 < r_) v_ -= l_[3] * sol_[j4_ * 4 + 3]; } \
                sol_[r_] = v_; if ((r_ & 3) == 3) asm volatile("" ::: "memory"); } \
            u32x4 s0_, s1_; s0_.x = pk2(sol_[0], sol_[1]); s0_.y = pk2(sol_[2], sol_[3]); s0_.z = pk2(sol_[4], sol_[5]); s0_.w = pk2(sol_[6], sol_[7]); \
            s1_.x = pk2(sol_[8], sol_[9]); s1_.y = pk2(sol_[10], sol_[11]); s1_.z = pk2(sol_[12], sol_[13]); s1_.w = pk2(sol_[14], sol_[15]); \
            *(LAS u32x4*)(SOLT + tid * 72 + (bi) * 16) = s0_; *(LAS u32x4*)(SOLT + tid * 72 + (bi) * 16 + 8) = s1_; \
            const unsigned w_[8] = {s0_.x, s0_.y, s0_.z, s0_.w, s1_.x, s1_.y, s1_.z, s1_.w}; \
            _Pragma("unroll") for (int r_ = 0; r_ < 16; r_ += 2) { *(LAS bf16_t*)(size_t)(a_nat + ((bi) * 16 + r_) * 272) = (bf16_t)w_[r_ >> 1]; *(LAS bf16_t*)(size_t)(a_nat + ((bi) * 16 + r_ + 1) * 272) = (bf16_t)(w_[r_ >> 1] >> 16); } } while (0)
#define GDN_UPDATE_BLOCK(bi, KK) do { \
            _Pragma("unroll") for (int q2_ = 0; q2_ < 2; ++q2_) { const int nt_ = wave * 2 + q2_; \
                const f32x4 d_ = mm_tile<KK>(LBh + (bi) * 16 * 72, 72, SOLT + nt_ * 16 * 72, 72, (f32x4){0.f, 0.f, 0.f, 0.f}, lane); \
                _Pragma("unroll") for (int jj_ = 0; jj_ < 4; ++jj_) XU[((lane >> 4) * 4 + jj_) * 260 + nt_ * 16 + (lane & 15)] = d_[jj_]; } } while (0)
        if (solver) { GDN_SOLVE_BLOCK(0); }
        LBAR(); PSTAMP(23);
        GDN_UPDATE_BLOCK(1, 32); LBAR(); if (solver) { GDN_SOLVE_BLOCK(1); } LBAR();
        GDN_UPDATE_BLOCK(2, 32); LBAR(); if (solver) { GDN_SOLVE_BLOCK(2); } LBAR();
        GDN_UPDATE_BLOCK(3, 64); LBAR(); if (solver) { GDN_SOLVE_BLOCK(3); } LBAR(); PSTAMP(24);
#undef GDN_SOLVE_BLOCK
#undef GDN_UPDATE_BLOCK
#pragma unroll
        for (int i4 = 0; i4 < 4; ++i4) { const int idx = tid + NTHREADS * i4, arr = idx >> 10, r = (idx >> 4) & 63, c8 = idx & 15;
            const u32x4 w = *(const LAS u32x4*)((arr ? KB : QB) + r * 136 + c8 * 8);
            *(u32x4*)((char*)(arr ? Wpl : (P + 2 * PLANE)) + ((unsigned)cidx * 131072u + (unsigned)((r * 1024 + h * 128 + c8 * 8) * 2))) = w; }
        LBAR(); PSTAMP(25);
    }
#undef GDN_LOADS
}

__device__ __forceinline__ void hgrn_prep(LAS unsigned char* lds, int tid, bf16_t* P, bf16_t* AQK, float* DEC, const float* LBv) {
    asm volatile("" : "+v"(tid));
    const int lane = tid & 63, wave = __builtin_amdgcn_readfirstlane(tid >> 6);
    LAS bf16_t* QH = (LAS bf16_t*)lds; LAS bf16_t* KH = QH + 4 * 16 * 136; LAS float* TOT = (LAS float*)(lds + 14 * 16 * 136 * 2);
    LAS bf16_t* AQT = (LAS bf16_t*)(lds + 14 * 16 * 136 * 2 + 2048);
    const int d = tid & 127, s = tid >> 7;
    const int h = blockIdx.x & 7;
    const float lb = LBv[h * 128 + d];
    bf16_t pq[16], pf[16];
    const char* Pb = (const char*)P; const unsigned PLB = (unsigned)(PLANE * 2);
    const unsigned hq0 = (unsigned)(((s * 16) * 1024 + h * 128 + d) * 2);
#define HG_LOADS(itx) do { const unsigned o_ = hq0 + (unsigned)((itx) >> 3) * 131072u; \
        _Pragma("unroll") for (int r_ = 0; r_ < 16; ++r_) { pq[r_] = *(const bf16_t*)(Pb + (o_ + 2048u * r_)); pf[r_] = *(const bf16_t*)(Pb + (PLB + o_ + 2048u * r_)); } } while (0)
    if ((int)blockIdx.x < NITEM) HG_LOADS((int)blockIdx.x);
    int it_prev = -1;
    for (int it = blockIdx.x; it < NITEM; it += gridDim.x) {
        const int cidx = it >> 3; const size_t row0 = (size_t)cidx * 64;
        float qv[16], kv[16], gl[16]; float run = 0.f;
        const unsigned qo = hq0 + (unsigned)cidx * 131072u;
#pragma unroll
        for (int r = 0; r < 16; ++r) { const float qraw = bf2f(pq[r]), fraw = bf2f(pf[r]);
            const float ef = __expf(-fraw); const float sg = frcp_(1.0f + ef); const float ft = lb + (1.0f - lb) * sg; run += __logf(ft); gl[r] = run;
            kv[r] = (1.0f - lb) * ef * sg; qv[r] = siluf_(qraw) * 0.08838834764831845f; }
        { const int itn = it + (int)gridDim.x; if (itn < NITEM) HG_LOADS(itn); }
        if (it_prev >= 0) { const int r = tid >> 3, c8 = tid & 7;
            *(u32x4*)((char*)AQK + ((unsigned)it_prev * 8192u + (unsigned)((r * 64 + c8 * 8) * 2))) = *(const LAS u32x4*)(AQT + r * 72 + c8 * 8); }
        TOT[s * 128 + d] = run;
        LBAR();
        const float t0 = TOT[d], t1 = TOT[128 + d], t2 = TOT[256 + d], t3 = TOT[384 + d];
        const float gb = (s > 0 ? t0 : 0.f) + (s > 1 ? t1 : 0.f) + (s > 2 ? t2 : 0.f); const float glast = (t0 + t1) + (t2 + t3);
        const float egb = __expf(gb), ekd = __expf(glast - gb);
#pragma unroll
        for (int r = 0; r < 16; ++r) { const float ep = __expf(gl[r]); gl[r] = frcp_(ep); qv[r] *= ep; kv[r] *= gl[r]; }
#pragma unroll
        for (int r = 0; r < 16; r += 2) { const unsigned w = pk2(qv[r] * egb, qv[r + 1] * egb); *(bf16_t*)((char*)P + (qo + 2048u * r)) = (bf16_t)w; *(bf16_t*)((char*)P + (qo + 2048u * (r + 1))) = (bf16_t)(w >> 16); }
        { u32x4 o0, o1; o0.x = pk2(kv[0] * ekd, kv[1] * ekd); o0.y = pk2(kv[2] * ekd, kv[3] * ekd); o0.z = pk2(kv[4] * ekd, kv[5] * ekd); o0.w = pk2(kv[6] * ekd, kv[7] * ekd);
          o1.x = pk2(kv[8] * ekd, kv[9] * ekd); o1.y = pk2(kv[10] * ekd, kv[11] * ekd); o1.z = pk2(kv[12] * ekd, kv[13] * ekd); o1.w = pk2(kv[14] * ekd, kv[15] * ekd);
          bf16_t* kd = (bf16_t*)((char*)P + (PLB + (unsigned)cidx * 131072u + (unsigned)((((d >> 1)) * 1024 + h * 128 + ((d & 1) << 6) + s * 16) * 2)));
          *(u32x4*)kd = o0; *(u32x4*)(kd + 8) = o1; }
        if (s == 0) DEC[(size_t)it * 128 + d] = __expf(glast);
#pragma unroll
        for (int r = 0; r < 16; r += 2) { const unsigned w = pk2(qv[r], qv[r + 1]); QH[(s * 16 + r) * 136 + d] = (bf16_t)w; QH[(s * 16 + r + 1) * 136 + d] = (bf16_t)(w >> 16); }
#pragma unroll
        for (int st = 0; st < 4; ++st) {
            if (st >= s) {
                float off = 0.f;
                if (st > s) { if (s <= 0 && 0 < st) off += t0; if (s <= 1 && 1 < st) off += t1; if (s <= 2 && 2 < st) off += t2; }
                const float eo = __expf(off); const int pidx = st * (st + 1) / 2 + s;
#pragma unroll
                for (int r = 0; r < 16; r += 2) { const unsigned w = pk2(kv[r] * eo, kv[r + 1] * eo); KH[(pidx * 16 + r) * 136 + d] = (bf16_t)w; KH[(pidx * 16 + r + 1) * 136 + d] = (bf16_t)(w >> 16); }
            }
        }
        LBAR();
        for (int tile = wave; tile < 16; tile += 8) {
            const int st = tile >> 2, sj = tile & 3; f32x4 acc = (f32x4){0.f, 0.f, 0.f, 0.f};
            if (sj <= st) acc = mm_tile<128>(QH + st * 16 * 136, 136, KH + (st * (st + 1) / 2 + sj) * 16 * 136, 136, acc, lane);
            const int jc = sj * 16 + (lane & 15);
#pragma unroll
            for (int jj = 0; jj < 4; jj += 2) { const int i = st * 16 + (lane >> 4) * 4 + jj;
                const unsigned w = pk2((sj <= st && jc <= i) ? acc[jj] : 0.f, (sj <= st && jc <= i + 1) ? acc[jj + 1] : 0.f);
                AQT[i * 72 + jc] = (bf16_t)w; AQT[(i + 1) * 72 + jc] = (bf16_t)(w >> 16); }
        }
        LBAR();
        it_prev = it;
    }
    if (it_prev >= 0) { const int r = tid >> 3, c8 = tid & 7; *(u32x4*)((char*)AQK + ((unsigned)it_prev * 8192u + (unsigned)((r * 64 + c8 * 8) * 2))) = *(const LAS u32x4*)(AQT + r * 72 + c8 * 8); }
#undef HG_LOADS
}

__device__ __forceinline__ void scan_phase(LAS unsigned char* lds, int tid, bool gdn, bf16_t* P, const bf16_t* Wpl, const bf16_t* AQK, const float* DEC, const float* nw, float* ss_o
#ifdef PROBE_SEL
                                           , unsigned& tacc, unsigned& tprev
#endif
                                           ) {
    if (blockIdx.x >= 128) return;
    asm volatile("" : "+v"(tid));
    const int lane = tid & 63, wave = __builtin_amdgcn_readfirstlane(tid >> 6);
    const int b = blockIdx.x >> 3, h = blockIdx.x & 7;
    LAS bf16_t* ST = (LAS bf16_t*)lds; LAS bf16_t* VNT = (LAS bf16_t*)(lds + 34816); LAS bf16_t* WB = (LAS bf16_t*)(lds + 53248); LAS bf16_t* QD = (LAS bf16_t*)(lds + 70656);
    LAS bf16_t* AQ = (LAS bf16_t*)(lds + 88064); LAS bf16_t* KDT = (LAS bf16_t*)(lds + 97280); LAS float* DECV = (LAS float*)(lds + 115712); LAS float* SSQ = (LAS float*)(lds + 116224);
    const f32x4 Z4 = (f32x4){0.f, 0.f, 0.f, 0.f};
    f32x4 Sacc[8];
#pragma unroll
    for (int nt = 0; nt < 8; ++nt) Sacc[nt] = Z4;
    for (int i = tid; i < 128 * 136 / 2; i += NTHREADS) ((LAS unsigned*)ST)[i] = 0u;
    const int l15 = lane & 15, lq = lane >> 4, mrow = wave * 16 + lq * 4;
    const f32x4 nwv = *(const f32x4*)(nw + (gdn ? 0 : h * 128) + mrow);
    const LAS bf16_t* stf = ST + (wave * 16 + l15) * 136 + lq * 8; const LAS bf16_t* vnf = VNT + (wave * 16 + l15) * 72 + lq * 8;
    const LAS bf16_t* wbf = WB + l15 * 136 + lq * 8; const LAS bf16_t* qdf = QD + l15 * 136 + lq * 8; const LAS bf16_t* aqf = AQ + l15 * 72 + lq * 8; const LAS bf16_t* kdf = KDT + l15 * 72 + lq * 8;
    const int sr0 = tid >> 4, sc8 = tid & 15, ar = tid >> 3, ac8 = tid & 7;
    u32x4 pw[2], pq[2], pk[2], pa; u32x2 pu[4], cu[4], cgt[4]; float pdec = 0.f;
    pw[0] = pw[1] = (u32x4){0u, 0u, 0u, 0u};
    const char* Pb = (const char*)P; const char* Wb = (const char*)Wpl; const char* Ab = (const char*)AQK; const char* Db = (const char*)DEC;
    const unsigned PLB = (unsigned)(PLANE * 2);
    const unsigned go0 = (unsigned)(((b * 32 * 64 + sr0) * 1024 + h * 128 + sc8 * 8) * 2);
    const unsigned gu0 = (unsigned)(((b * 32 * 64 + l15) * 1024 + h * 128 + mrow) * 2);
    const unsigned ga0 = (unsigned)((((b * 32) * 8 + h) * 4096 + ar * 64 + ac8 * 8) * 2);
    const unsigned gd0 = (unsigned)((((b * 32) * 8 + h) * 128 + (tid & 127)) * 4);
#define SCAN_ISSUE(nn) do { const unsigned go_ = go0 + (unsigned)(nn) * 131072u, gu_ = gu0 + (unsigned)(nn) * 131072u; \
        _Pragma("unroll") for (int i_ = 0; i_ < 2; ++i_) { \
            if (gdn) pw[i_] = *(const u32x4*)(Wb + (go_ + 65536u * i_)); pq[i_] = *(const u32x4*)(Pb + (go_ + 65536u * i_)); pk[i_] = *(const u32x4*)(Pb + (PLB + go_ + 65536u * i_)); } \
        pa = *(const u32x4*)(Ab + (ga0 + (unsigned)(nn) * 65536u)); \
        _Pragma("unroll") for (int nt_ = 0; nt_ < 4; ++nt_) pu[nt_] = *(const u32x2*)(Pb + (2u * PLB + gu_ + 32768u * nt_)); \
        if (tid < 128) pdec = *(const float*)(Db + (gd0 + (unsigned)(nn) * 4096u)); } while (0)
#define SCAN_COMMIT() do { \
        _Pragma("unroll") for (int i_ = 0; i_ < 2; ++i_) { const int r_ = sr0 + 32 * i_; \
            if (gdn) *(LAS u32x4*)(WB + r_ * 136 + sc8 * 8) = pw[i_]; *(LAS u32x4*)(QD + r_ * 136 + sc8 * 8) = pq[i_]; \
            *(LAS u32x4*)(KDT + (r_ * 2 + (sc8 >> 3)) * 72 + (sc8 & 7) * 8) = pk[i_]; } \
        *(LAS u32x4*)(AQ + ar * 72 + ac8 * 8) = pa; if (tid < 128) DECV[tid] = pdec; \
        _Pragma("unroll") for (int nt_ = 0; nt_ < 4; ++nt_) { cu[nt_] = pu[nt_]; } } while (0)
    SCAN_ISSUE(0);
    SCAN_COMMIT();
    __syncthreads();
    for (int n = 0; n < 32; ++n) {
        const size_t row0 = (size_t)(b * 32 + n) * 64;
        if (n < 31) SCAN_ISSUE(n + 1);
#pragma unroll
        for (int nt = 0; nt < 4; ++nt) cgt[nt] = *(const u32x2*)(Pb + (3u * PLB + gu0 + (unsigned)n * 131072u + 32768u * nt));
        bf16x8 sf[4];
#pragma unroll
        for (int k = 0; k < 4; ++k) sf[k] = *(const LAS bf16x8*)(stf + k * 32);
#define SCAN_SB() __builtin_amdgcn_sched_barrier(0)
        __builtin_amdgcn_s_setprio(1);
        f32x4 vn[4];
#pragma unroll
        for (int nt = 0; nt < 4; ++nt) vn[nt] = (f32x4){bflo(cu[nt].x), bfhi(cu[nt].x), bflo(cu[nt].y), bfhi(cu[nt].y)};
        if (gdn) {
#pragma unroll
            for (int hh = 0; hh < 2; ++hh) {
                bf16x8 wf[2][4];
#pragma unroll
                for (int nt = 0; nt < 2; ++nt)
#pragma unroll
                    for (int k = 0; k < 4; ++k) wf[nt][k] = *(const LAS bf16x8*)(wbf + (hh * 2 + nt) * 16 * 136 + k * 32);
                f32x4 acc[2] = {Z4, Z4};
#pragma unroll
                for (int k = 0; k < 4; ++k)
#pragma unroll
                    for (int nt = 0; nt < 2; ++nt) acc[nt] = __builtin_amdgcn_mfma_f32_16x16x32_bf16(sf[k], wf[nt][k], acc[nt], 0, 0, 0);
#pragma unroll
                for (int nt = 0; nt < 2; ++nt) vn[hh * 2 + nt] = vn[hh * 2 + nt] - acc[nt];
                SCAN_SB();
            }
        }
        SCAN_SB();
        bf16x8 qf[2][4];
#pragma unroll
        for (int nt = 0; nt < 2; ++nt)
#pragma unroll
            for (int k = 0; k < 4; ++k) qf[nt][k] = *(const LAS bf16x8*)(qdf + nt * 16 * 136 + k * 32);
#pragma unroll
        for (int nt = 0; nt < 4; ++nt)
#pragma unroll
            for (int jj = 0; jj < 4; jj += 2) { const unsigned w = pk2(vn[nt][jj], vn[nt][jj + 1]); VNT[(mrow + jj) * 72 + nt * 16 + l15] = (bf16_t)w; VNT[(mrow + jj + 1) * 72 + nt * 16 + l15] = (bf16_t)(w >> 16); }
        f32x4 o[4] = {Z4, Z4, Z4, Z4};
#pragma unroll
        for (int k = 0; k < 4; ++k)
#pragma unroll
            for (int nt = 0; nt < 2; ++nt) o[nt] = __builtin_amdgcn_mfma_f32_16x16x32_bf16(sf[k], qf[nt][k], o[nt], 0, 0, 0);
        SCAN_SB();
#pragma unroll
        for (int nt = 0; nt < 2; ++nt)
#pragma unroll
            for (int k = 0; k < 4; ++k) qf[nt][k] = *(const LAS bf16x8*)(qdf + (nt + 2) * 16 * 136 + k * 32);
#pragma unroll
        for (int k = 0; k < 4; ++k)
#pragma unroll
            for (int nt = 0; nt < 2; ++nt) o[nt + 2] = __builtin_amdgcn_mfma_f32_16x16x32_bf16(sf[k], qf[nt][k], o[nt + 2], 0, 0, 0);
        SCAN_SB();
        bf16x8 af[4][2], kf0[4][2]; float dcy[8];
#pragma unroll
        for (int nt = 0; nt < 4; ++nt)
#pragma unroll
            for (int k = 0; k < 2; ++k) { af[nt][k] = *(const LAS bf16x8*)(aqf + nt * 16 * 72 + k * 32); kf0[nt][k] = *(const LAS bf16x8*)(kdf + nt * 16 * 72 + k * 32); }
        LDS_WAIT();
        bf16x8 vf[2];
#pragma unroll
        for (int k = 0; k < 2; ++k) vf[k] = *(const LAS bf16x8*)(vnf + k * 32);
#pragma unroll
        for (int nt = 0; nt < 8; ++nt) { dcy[nt] = DECV[nt * 16 + l15]; Sacc[nt] = Sacc[nt] * dcy[nt]; }
#pragma unroll
        for (int k = 0; k < 2; ++k)
#pragma unroll
            for (int nt = 0; nt < 4; ++nt) { if (k == 0 || nt >= 2) o[nt] = __builtin_amdgcn_mfma_f32_16x16x32_bf16(vf[k], af[nt][k], o[nt], 0, 0, 0);
                Sacc[nt] = __builtin_amdgcn_mfma_f32_16x16x32_bf16(vf[k], kf0[nt][k], Sacc[nt], 0, 0, 0); }
        SCAN_SB();
        {   bf16x8 kf1[4][2];
#pragma unroll
            for (int nt = 0; nt < 4; ++nt)
#pragma unroll
                for (int k = 0; k < 2; ++k) kf1[nt][k] = *(const LAS bf16x8*)(kdf + (nt + 4) * 16 * 72 + k * 32);
#pragma unroll
            for (int k = 0; k < 2; ++k)
#pragma unroll
                for (int nt = 0; nt < 4; ++nt) Sacc[nt + 4] = __builtin_amdgcn_mfma_f32_16x16x32_bf16(vf[k], kf1[nt][k], Sacc[nt + 4], 0, 0, 0); }
#undef SCAN_SB
        __builtin_amdgcn_s_setprio(0);
#pragma unroll
        for (int nt = 0; nt < 4; ++nt) { float q = (o[nt][0] * o[nt][0] + o[nt][1] * o[nt][1]) + (o[nt][2] * o[nt][2] + o[nt][3] * o[nt][3]);
            { const auto r16 = __builtin_amdgcn_permlane16_swap(__float_as_uint(q), __float_as_uint(q), false, false); q = __uint_as_float(r16[0]) + __uint_as_float(r16[1]); }
            { const auto r32 = __builtin_amdgcn_permlane32_swap(__float_as_uint(q), __float_as_uint(q), false, false); q = __uint_as_float(r32[0]) + __uint_as_float(r32[1]); }
            if (lq == 0) SSQ[(nt * 16 + l15) * 8 + wave] = q; }
        LBAR(); PSTAMP(30);
#pragma unroll
        for (int nt = 0; nt < 8; ++nt)
#pragma unroll
            for (int jj = 0; jj < 4; jj += 2) { const unsigned w = pk2(Sacc[nt][jj], Sacc[nt][jj + 1]); ST[(mrow + jj) * 136 + nt * 16 + l15] = (bf16_t)w; ST[(mrow + jj + 1) * 136 + nt * 16 + l15] = (bf16_t)(w >> 16); }
        if (n < 31) SCAN_COMMIT();
#pragma unroll
        for (int nt = 0; nt < 4; ++nt) { const int tok = nt * 16 + l15; float tot = 0.f;
#pragma unroll
            for (int w4 = 0; w4 < 2; ++w4) { const f32x4 pz = *(const LAS f32x4*)(SSQ + tok * 8 + w4 * 4); tot += (pz[0] + pz[1]) + (pz[2] + pz[3]); }
            const float rs = gdn ? rsqrtf(tot * (1.0f / 128.0f) + EPS) : 1.0f;
            const float g0 = bflo(cgt[nt].x), g1 = bfhi(cgt[nt].x), g2 = bflo(cgt[nt].y), g3 = bfhi(cgt[nt].y);
            u32x2 ow; ow.x = pk2(o[nt][0] * rs * nwv[0] * g0, o[nt][1] * rs * nwv[1] * g1); ow.y = pk2(o[nt][2] * rs * nwv[2] * g2, o[nt][3] * rs * nwv[3] * g3);
            *(u32x2*)((char*)P + (3u * PLB + gu0 + (unsigned)n * 131072u + 32768u * nt)) = ow;
            if (!gdn && wave == 0 && lq == 0) ss_o[(row0 + tok) * 8 + h] = tot; }
        LBAR(); PSTAMP(31);
    }
#undef SCAN_ISSUE
#undef SCAN_COMMIT
}

__device__ __forceinline__ void scan_hgrn_split(LAS unsigned char* lds, int tid, bf16_t* P, const bf16_t* AQK, const float* DEC, const float* nw, float* ss_o) {
    asm volatile("" : "+v"(tid));
    const int lane = tid & 63, wave = __builtin_amdgcn_readfirstlane(tid >> 6);
    const int xcd_ = blockIdx.x & 7, kk_ = blockIdx.x >> 3;
    const int chain = (kk_ >> 1) * 8 + xcd_, half = kk_ & 1, b = chain >> 3, h = chain & 7, dv0 = half * 64;
    const int dt = wave & 3, ch = wave >> 2;
    LAS bf16_t* ST = (LAS bf16_t*)lds; LAS bf16_t* VNT = (LAS bf16_t*)(lds + 17408); LAS bf16_t* QD = (LAS bf16_t*)(lds + 35840);
    LAS bf16_t* AQ = (LAS bf16_t*)(lds + 53248); LAS bf16_t* KDT = (LAS bf16_t*)(lds + 62464); LAS float* DECV = (LAS float*)(lds + 80896); LAS float* SSQ = (LAS float*)(lds + 81408);
    LAS float* NWL = (LAS float*)(lds + 82432);
    const f32x4 Z4 = (f32x4){0.f, 0.f, 0.f, 0.f};
    f32x4 Sacc[4];
#pragma unroll
    for (int n4 = 0; n4 < 4; ++n4) Sacc[n4] = Z4;
    for (int i = tid; i < 64 * 136 / 2; i += NTHREADS) ((LAS unsigned*)ST)[i] = 0u;
    if (tid < 64) NWL[tid] = nw[h * 128 + dv0 + tid];
    const int l15 = lane & 15, lq = lane >> 4, mrow = dt * 16 + lq * 4;
    const LAS bf16_t* stf = ST + (dt * 16 + l15) * 136 + lq * 8; const LAS bf16_t* vnf = VNT + (wave * 16 + l15) * 72 + lq * 8;
    const LAS bf16_t* qdf = QD + l15 * 136 + lq * 8; const LAS bf16_t* aqf = AQ + l15 * 72 + lq * 8; const LAS bf16_t* kdf = KDT + l15 * 72 + lq * 8;
    const int sr0 = tid >> 4, sc8 = tid & 15, ar = tid >> 3, ac8 = tid & 7;
    u32x4 pq[2], pk[2], pa; u32x2 pu[4], cu[4], cgt[2]; float pdec = 0.f;
    const char* Pb = (const char*)P; const char* Ab = (const char*)AQK; const char* Db = (const char*)DEC;
    const unsigned PLB = (unsigned)(PLANE * 2);
    const unsigned go0 = (unsigned)(((b * 32 * 64 + sr0) * 1024 + h * 128 + sc8 * 8) * 2);
    const unsigned gu0 = (unsigned)(((b * 32 * 64 + l15) * 1024 + h * 128 + dv0 + mrow) * 2);
    const unsigned ga0 = (unsigned)((((b * 32) * 8 + h) * 4096 + ar * 64 + ac8 * 8) * 2);
    const unsigned gd0 = (unsigned)((((b * 32) * 8 + h) * 128 + (tid & 127)) * 4);
#define HS_ISSUE(nn) do { const unsigned go_ = go0 + (unsigned)(nn) * 131072u, gu_ = gu0 + (unsigned)(nn) * 131072u; \
        _Pragma("unroll") for (int i_ = 0; i_ < 2; ++i_) { pq[i_] = *(const u32x4*)(Pb + (go_ + 65536u * i_)); pk[i_] = *(const u32x4*)(Pb + (PLB + go_ + 65536u * i_)); } \
        pa = *(const u32x4*)(Ab + (ga0 + (unsigned)(nn) * 65536u)); \
        _Pragma("unroll") for (int nt_ = 0; nt_ < 4; ++nt_) pu[nt_] = *(const u32x2*)(Pb + (2u * PLB + gu_ + 32768u * nt_)); \
        if (tid < 128) pdec = *(const float*)(Db + (gd0 + (unsigned)(nn) * 4096u)); } while (0)
#define HS_COMMIT() do { \
        _Pragma("unroll") for (int i_ = 0; i_ < 2; ++i_) { const int r_ = sr0 + 32 * i_; \
            *(LAS u32x4*)(QD + r_ * 136 + sc8 * 8) = pq[i_]; *(LAS u32x4*)(KDT + (r_ * 2 + (sc8 >> 3)) * 72 + (sc8 & 7) * 8) = pk[i_]; } \
        *(LAS u32x4*)(AQ + ar * 72 + ac8 * 8) = pa; if (tid < 128) DECV[tid] = pdec; \
        _Pragma("unroll") for (int nt_ = 0; nt_ < 4; ++nt_) { cu[nt_] = pu[nt_]; } } while (0)
    HS_ISSUE(0);
    HS_COMMIT();
    __syncthreads();
    for (int n = 0; n < 32; ++n) {
        if (n < 31) HS_ISSUE(n + 1);
#pragma unroll
        for (int t2 = 0; t2 < 2; ++t2) cgt[t2] = *(const u32x2*)(Pb + (3u * PLB + gu0 + (unsigned)n * 131072u + 32768u * (ch * 2 + t2)));
        bf16x8 sf[4];
#pragma unroll
        for (int k = 0; k < 4; ++k) sf[k] = *(const LAS bf16x8*)(stf + k * 32);
#pragma unroll
        for (int nt = 0; nt < 4; ++nt) { VNT[(wave * 16 + lq * 4 + 0) * 72 + nt * 16 + l15] = (bf16_t)cu[nt].x; VNT[(wave * 16 + lq * 4 + 1) * 72 + nt * 16 + l15] = (bf16_t)(cu[nt].x >> 16);
            VNT[(wave * 16 + lq * 4 + 2) * 72 + nt * 16 + l15] = (bf16_t)cu[nt].y; VNT[(wave * 16 + lq * 4 + 3) * 72 + nt * 16 + l15] = (bf16_t)(cu[nt].y >> 16); }
        __builtin_amdgcn_s_setprio(1);
        bf16x8 qf[2][4];
#pragma unroll
        for (int t2 = 0; t2 < 2; ++t2)
#pragma unroll
            for (int k = 0; k < 4; ++k) qf[t2][k] = *(const LAS bf16x8*)(qdf + (ch * 2 + t2) * 16 * 136 + k * 32);
        f32x4 o[2] = {Z4, Z4};
#pragma unroll
        for (int k = 0; k < 4; ++k)
#pragma unroll
            for (int t2 = 0; t2 < 2; ++t2) o[t2] = __builtin_amdgcn_mfma_f32_16x16x32_bf16(sf[k], qf[t2][k], o[t2], 0, 0, 0);
        bf16x8 af[2][2], kf[4][2];
#pragma unroll
        for (int k = 0; k < 2; ++k) {
#pragma unroll
            for (int t2 = 0; t2 < 2; ++t2) af[t2][k] = *(const LAS bf16x8*)(aqf + (ch * 2 + t2) * 16 * 72 + k * 32);
#pragma unroll
            for (int n4 = 0; n4 < 4; ++n4) kf[n4][k] = *(const LAS bf16x8*)(kdf + (ch * 4 + n4) * 16 * 72 + k * 32); }
        LDS_WAIT();
        bf16x8 vf[2];
#pragma unroll
        for (int k = 0; k < 2; ++k) vf[k] = *(const LAS bf16x8*)(vnf + k * 32);
#pragma unroll
        for (int n4 = 0; n4 < 4; ++n4) Sacc[n4] = Sacc[n4] * DECV[(ch * 4 + n4) * 16 + l15];
#pragma unroll
        for (int k = 0; k < 2; ++k) {
#pragma unroll
            for (int t2 = 0; t2 < 2; ++t2) { if (k == 0 || ch == 1) o[t2] = __builtin_amdgcn_mfma_f32_16x16x32_bf16(vf[k], af[t2][k], o[t2], 0, 0, 0); }
#pragma unroll
            for (int n4 = 0; n4 < 4; ++n4) Sacc[n4] = __builtin_amdgcn_mfma_f32_16x16x32_bf16(vf[k], kf[n4][k], Sacc[n4], 0, 0, 0); }
        __builtin_amdgcn_s_setprio(0);
#pragma unroll
        for (int t2 = 0; t2 < 2; ++t2) { float q = (o[t2][0] * o[t2][0] + o[t2][1] * o[t2][1]) + (o[t2][2] * o[t2][2] + o[t2][3] * o[t2][3]);
            { const auto r16 = __builtin_amdgcn_permlane16_swap(__float_as_uint(q), __float_as_uint(q), false, false); q = __uint_as_float(r16[0]) + __uint_as_float(r16[1]); }
            { const auto r32 = __builtin_amdgcn_permlane32_swap(__float_as_uint(q), __float_as_uint(q), false, false); q = __uint_as_float(r32[0]) + __uint_as_float(r32[1]); }
            if (lq == 0) SSQ[((ch * 2 + t2) * 16 + l15) * 4 + dt] = q; }
        LBAR();
#pragma unroll
        for (int n4 = 0; n4 < 4; ++n4)
#pragma unroll
            for (int jj = 0; jj < 4; jj += 2) { const unsigned w = pk2(Sacc[n4][jj], Sacc[n4][jj + 1]); ST[(mrow + jj) * 136 + (ch * 4 + n4) * 16 + l15] = (bf16_t)w; ST[(mrow + jj + 1) * 136 + (ch * 4 + n4) * 16 + l15] = (bf16_t)(w >> 16); }
        if (n < 31) HS_COMMIT();
        const f32x4 nwv = *(const LAS f32x4*)(NWL + mrow);
#pragma unroll
        for (int t2 = 0; t2 < 2; ++t2) { const int tok = (ch * 2 + t2) * 16 + l15;
            const float g0 = bflo(cgt[t2].x), g1 = bfhi(cgt[t2].x), g2 = bflo(cgt[t2].y), g3 = bfhi(cgt[t2].y);
            u32x2 ow; ow.x = pk2(o[t2][0] * nwv[0] * g0, o[t2][1] * nwv[1] * g1); ow.y = pk2(o[t2][2] * nwv[2] * g2, o[t2][3] * nwv[3] * g3);
            *(u32x2*)((char*)P + (3u * PLB + gu0 + (unsigned)n * 131072u + 32768u * (ch * 2 + t2))) = ow;
            if (dt == 0 && lq == 0) { const f32x4 pz = *(const LAS f32x4*)(SSQ + tok * 4); ss_o[((size_t)(b * 32 + n) * 64 + tok) * 16 + h * 2 + half] = (pz[0] + pz[1]) + (pz[2] + pz[3]); } }
        LBAR();
    }
#undef HS_ISSUE
#undef HS_COMMIT
}

#define BUILD_RSTD_TABLE(S_, ssp_, pm_a_, pm_b_) do { \
        pm_a_ = -1; pm_b_ = -1; \
        for (int i_ = 0; i_ < 64; ++i_) { pg8::Unit u_; if (!(S_).next(i_, u_)) break; if (pm_a_ < 0) pm_a_ = u_.pm; else if (u_.pm != pm_a_ && pm_b_ < 0) pm_b_ = u_.pm; } \
        int t_ = tid; asm volatile("" : "+v"(t_)); \
        { const int k_ = t_ >> 8, r_ = t_ & 255; const int pm_ = k_ ? pm_b_ : pm_a_; ((LAS float*)(lds + 131072))[t_] = (pm_ >= 0) ? pg8::row_rstd16(ssp_, pm_ * 256 + r_) : 0.f; } \
        __syncthreads(); } while (0)
#define BUILD_RSTD8_TABLE(S_, ssp_, pm_a_, pm_b_) do { \
        pm_a_ = -1; pm_b_ = -1; \
        for (int i_ = 0; i_ < 64; ++i_) { pg8::Unit u_; if (!(S_).next(i_, u_)) break; if (pm_a_ < 0) pm_a_ = u_.pm; else if (u_.pm != pm_a_ && pm_b_ < 0) pm_b_ = u_.pm; } \
        int t_ = tid; asm volatile("" : "+v"(t_)); \
        { const int k_ = t_ >> 8, r_ = t_ & 255; const int pm_ = k_ ? pm_b_ : pm_a_; ((LAS float*)(lds + 131072))[t_] = (pm_ >= 0) ? pg8::row_rstd16(ssp_, pm_ * 256 + r_) : 0.f; } \
        __syncthreads(); } while (0)

__global__ void __launch_bounds__(NTHREADS, 2) mega_fwd(Args a) {
    extern __shared__ __attribute__((aligned(16))) unsigned char lds_raw[];
    LAS unsigned char* lds = (LAS unsigned char*)lds_raw;
    cg::grid_group grid = cg::this_grid();
    const int tid = threadIdx.x;
    unsigned char* ws = a.ws;
    float* SSA = (float*)(ws + WS_SSA); float* SSB = (float*)(ws + WS_SSB); float* SSO = (float*)(ws + WS_SSO); bf16_t* P = (bf16_t*)(ws + WS_PROJ); bf16_t* HB = (bf16_t*)(ws + WS_HB); bf16_t* AQK = (bf16_t*)(ws + WS_AQK);
    bf16_t* HALO = (bf16_t*)(ws + WS_HALO); float* AB = (float*)(ws + WS_AB); float* DEC = (float*)(ws + WS_DEC);
    const float* x = a.in[0]; float* out = a.out;
    const int G = gridDim.x;

    volatile LAS unsigned* misc = (volatile LAS unsigned*)(lds + LDS_BYTES - 16);
    if (tid < 4) misc[tid] = 0u;
    __syncthreads();
    const XcdBarrier bar = xcd_barrier_post((unsigned*)ws, misc);
#define GRID_BAR() do { XcdBarrier b2_ = bar; asm volatile("" : "+s"(b2_.x), "+s"(b2_.bar)); xcd_barrier(b2_); } while (0)
#ifdef PROBE_SEL
    unsigned tacc = 0u, tprev = (unsigned)__builtin_amdgcn_s_memrealtime();
#define STAMP(k) do { const unsigned t_ = (unsigned)__builtin_amdgcn_s_memrealtime(); if ((k) == PROBE_SEL) tacc += t_ - tprev; tprev = t_; } while (0)
#else
#define STAMP(k) do {} while (0)
#endif

    prologue(a, lds, tid);
    if (a.out == nullptr) grid.sync();
    GRID_BAR(); STAMP(0);

    for (int i = 0; i < 4; ++i) {
        const int j = i >> 1; const bool gdn = (i & 1) == 0;
        {
            const bf16_t* Bt = gdn ? (const bf16_t*)(ws + WS_WGI) + (size_t)j * GDN_NPAD * 1024 : (const bf16_t*)(ws + WS_WHI) + (size_t)j * 4096 * 1024;
            pg8::Gemm g{HB, Bt, M_TOK, 4096, 1024}; pg8::StaticOrder S; S.init(M_TOK, 4096, G, (int)blockIdx.x);
            int pm_a, pm_b; BUILD_RSTD_TABLE(S, SSB, pm_a, pm_b);
            pg8::EpiProj E{P, PLANE, SSB, gdn ? AB : nullptr, gdn ? HALO : nullptr, (const LAS float*)(lds + 131072), pm_a, pm_b};
            pg8::gemm_phase<pg8::EpiProj, pg8::StaticOrder, true, true>(lds, g, S, E);
            if (gdn) {
                int t2 = tid; asm volatile("" : "+v"(t2));
                const int lane = t2 & 63, l15 = lane & 15, lq = lane >> 4;
                for (int rt = (int)blockIdx.x * NWAVES + (t2 >> 6); rt < M_TOK / 16; rt += G * NWAVES) {
                    const bf16_t* ap = HB + (size_t)(rt * 16 + l15) * 1024 + lq * 8; const bf16_t* bp = Bt + (size_t)(4096 + l15) * 1024 + lq * 8;
                    f32x4 acc = (f32x4){0.f, 0.f, 0.f, 0.f};
#pragma unroll 8
                    for (int k0 = 0; k0 < 1024; k0 += 32) acc = __builtin_amdgcn_mfma_f32_16x16x32_bf16(*(const bf16x8*)(ap + k0), *(const bf16x8*)(bp + k0), acc, 0, 0, 0);
#pragma unroll
                    for (int jj = 0; jj < 4; ++jj) { const int row = rt * 16 + lq * 4 + jj; AB[(size_t)row * 16 + l15] = acc[jj] * pg8::row_rstd16(SSB, row); }
                }
            }
        }
        GRID_BAR(); STAMP(1);
        if (gdn) gdn_prep(lds, tid, P, (bf16_t*)out, AQK, HALO, AB, DEC, a.in[2] + (size_t)j * 4 * 3072, a.in[3] + j * 8, a.in[4] + j * 8
#ifdef PROBE_SEL
                          , tacc, tprev
#endif
                          );
        else hgrn_prep(lds, tid, P, AQK, DEC, (const float*)(ws + WS_LB) + j * 1024);
        GRID_BAR(); if (gdn) STAMP(2); else STAMP(3);
        if (!gdn) scan_hgrn_split(lds, tid, P, AQK, DEC, a.in[9] + j * 1024, SSO);
        else {
        if (blockIdx.x >= 128) { for (int ii = i; ii < i + 2; ++ii) convert_layer_weights(a, lds, tid, ii, (G - 128) * NWAVES); }
        scan_phase(lds, tid, gdn, P, (const bf16_t*)out, AQK, DEC, gdn ? a.in[5] + j * 128 : a.in[9] + j * 1024, SSO
#ifdef PROBE_SEL
                   , tacc, tprev
#endif
                   );
        }
        GRID_BAR(); if (gdn) STAMP(4); else STAMP(5);
        {
            const bf16_t* Bt = gdn ? (const bf16_t*)(ws + WS_WGO) + (size_t)j * 1024 * 1024 : (const bf16_t*)(ws + WS_WHO) + (size_t)j * 1024 * 1024;
            pg8::Gemm g{P + 3 * PLANE, Bt, M_TOK, 1024, 1024}; pg8::StaticOrder S; S.init(M_TOK, 1024, G, (int)blockIdx.x);
            int pm_a = -1, pm_b = -1; if (!gdn) BUILD_RSTD8_TABLE(S, SSO, pm_a, pm_b);
            pg8::EpiRes E{HB, SSA, gdn ? nullptr : SSO, (const LAS float*)(lds + 131072), pm_a, pm_b};
            pg8::gemm_phase<pg8::EpiRes, pg8::StaticOrder, true, true>(lds, g, S, E);
        }
        GRID_BAR(); STAMP(6);
        {
            pg8::Gemm g{HB, (const bf16_t*)(ws + WS_WUP) + (size_t)i * 4096 * 1024, M_TOK, 4096, 1024}; pg8::StaticOrder S; S.init(M_TOK, 4096, G, (int)blockIdx.x);
            int pm_a, pm_b; BUILD_RSTD_TABLE(S, SSA, pm_a, pm_b);
            pg8::EpiUp E{P, SSA, (const LAS float*)(lds + 131072), pm_a, pm_b};
            pg8::gemm_phase<pg8::EpiUp, pg8::StaticOrder, true, true>(lds, g, S, E);
        }
        GRID_BAR(); STAMP(7);
        {
            pg8::Gemm g{P, (const bf16_t*)(ws + WS_WDN) + (size_t)i * 1024 * 4096, M_TOK, 1024, 4096}; pg8::StaticOrder S; S.init(M_TOK, 1024, G, (int)blockIdx.x);
            pg8::EpiRes E{HB, SSB, nullptr, (const LAS float*)(lds + 131072), -1, -1};
            pg8::gemm_phase<pg8::EpiRes, pg8::StaticOrder, true, true>(lds, g, S, E);
        }
        GRID_BAR(); STAMP(8);
    }
    {
        int t3 = tid; asm volatile("" : "+v"(t3));
        const int lane = t3 & 63, wave = t3 >> 6; const int gw = blockIdx.x * NWAVES + wave, NGW = G * NWAVES;
        const f32x4* nf = (const f32x4*)a.in[15] + 2 * lane;
        f32x4 wv[4];
#pragma unroll
        for (int jx = 0; jx < 2; ++jx) { wv[2 * jx] = nf[128 * jx]; wv[2 * jx + 1] = nf[128 * jx + 1]; }
        for (int m = gw; m < M_TOK; m += NGW) {
            const float rs = pg8::row_rstd16(SSB, m); const u32x4* hr = (const u32x4*)(HB + (size_t)m * DMODEL) + lane; f32x4* o = (f32x4*)(out + (size_t)m * DMODEL) + 2 * lane;
#pragma unroll
            for (int jx = 0; jx < 2; ++jx) { const u32x4 hw = hr[64 * jx];
                const f32x4 h0 = (f32x4){bflo(hw.x), bfhi(hw.x), bflo(hw.y), bfhi(hw.y)}, h1 = (f32x4){bflo(hw.z), bfhi(hw.z), bflo(hw.w), bfhi(hw.w)};
                o[128 * jx] = h0 * rs * wv[2 * jx]; o[128 * jx + 1] = h1 * rs * wv[2 * jx + 1]; }
        }
    }
#ifdef PROBE_SEL
    STAMP(9);
    __syncthreads();
    if (blockIdx.x == 0 && tid == 0) { __builtin_amdgcn_s_waitcnt(0); out[0] += 0.02f * rintf((float)tacc * 0.001f); }
#endif
}

extern "C" void kernel_launch(void* const* d_in, const int* in_sizes, int n_in, void* d_out, int out_size, void* d_ws, size_t ws_size, hipStream_t stream) {
    static int grid = 0;
    if (grid == 0) {
        if (n_in != 16 || out_size != M_TOK * DMODEL || ws_size < WS_END) { fprintf(stderr, "kernel_launch: unexpected shapes (n_in %d, out %d, ws %zu; need ws >= %zu)\n", n_in, out_size, ws_size, (size_t)WS_END); grid = -1; return; }
        int dev = 0, cus = 0, per_cu = 0;
        (void)hipGetDevice(&dev); (void)hipDeviceGetAttribute(&cus, hipDeviceAttributeMultiprocessorCount, dev);
        (void)hipFuncSetAttribute((const void*)mega_fwd, hipFuncAttributeMaxDynamicSharedMemorySize, LDS_BYTES);
        if (hipOccupancyMaxActiveBlocksPerMultiprocessor(&per_cu, (const void*)mega_fwd, NTHREADS, LDS_BYTES) != hipSuccess || per_cu < 1) per_cu = 1;
        (void)hipGetLastError();
        grid = cus * (per_cu > 1 ? 1 : per_cu);
        if (grid <= 0) grid = 256;
    }
    if (grid < 0) return;
    Args a{};
    for (int i = 0; i < 16; ++i) a.in[i] = (const float*)d_in[i];
    a.out = (float*)d_out; a.ws = (unsigned char*)d_ws;
    (void)hipMemsetAsync(d_ws, 0, 16384, stream);
    void* args[] = {&a};
    hipError_t e = hipLaunchCooperativeKernel((const void*)mega_fwd, dim3(grid), dim3(NTHREADS), args, LDS_BYTES, stream);
    if (e != hipSuccess) fprintf(stderr, "cooperative launch failed: %s (grid %d)\n", hipGetErrorString(e), grid);
}
```

```cpp
#include <hip/hip_runtime.h>
#include <hip/hip_cooperative_groups.h>
#include <cstdio>
#include <cstdint>
namespace cg = cooperative_groups;
namespace pg8 {
#define PG8_LAS __attribute__((address_space(3)))
typedef unsigned short bf16_t;
typedef short bf16x8 __attribute__((ext_vector_type(8)));
typedef float f32x4 __attribute__((ext_vector_type(4)));
typedef unsigned u32x4 __attribute__((ext_vector_type(4)));
constexpr int BM = 256, BK = 64, HALF = 128, HTB = HALF * BK * 2  , STAGE_BYTES = 8 * HTB, NXCD = 8, WGM = 8;

__host__ __device__ __forceinline__ int lds_byte(int r, int c) { const int st = (r >> 4) * 2 + (c >> 5), rr = r & 15, cc = c & 31, ob = rr * 64 + cc * 2; return st * 1024 + (ob ^ (((ob >> 9) & 1) << 5)); }
__host__ __device__ __forceinline__ void stage_rc(int b, int& R, int& C) { const int st = b / 1024, sb = b % 1024, swz = sb ^ (((sb >> 9) & 1) << 5); R = (st >> 1) * 16 + swz / 64; C = (st & 1) * 32 + (swz % 64) / 2; }
__host__ __device__ __forceinline__ int perm32(int rho) { const int n = rho >> 4, i = rho & 15; return 8 * (i >> 2) + 4 * n + (i & 3); }

struct Unit { int pm, pn; };
struct Gemm { const bf16_t* A; const bf16_t* Bt; int M, N, K; };

struct StaticOrder {
    int nM, nN, nwg, G, c;
    __host__ __device__ void init(int M, int N, int G_, int c_) { nM = M / BM; nN = N / BM; nwg = nM * nN; G = G_; c = c_; }
    __host__ __device__ bool next(int i, Unit& u) const {
        const long L = (long)i * G + c; if (L >= nwg) return false;
        int wgid = (int)L; { const int q = nwg / NXCD, r = nwg % NXCD, xcd = wgid % NXCD, off = wgid / NXCD; wgid = (xcd < r ? xcd * (q + 1) : r * (q + 1) + (xcd - r) * q) + off; }
        const int nig = WGM * nN, gid = wgid / nig, fm = gid * WGM, gsz = (nM - fm) < WGM ? (nM - fm) : WGM;
        u.pm = fm + ((wgid % nig) % gsz); u.pn = (wgid % nig) / gsz; return true;
    }
    __device__ __forceinline__ void a_ready(const Unit&) const {}
    __device__ __forceinline__ void done(const Unit&) const {}
};


__device__ __forceinline__ unsigned cvt_pk_bf16(float lo, float hi) { unsigned r; asm volatile("v_cvt_pk_bf16_f32 %0, %1, %2" : "=v"(r) : "v"(lo), "v"(hi)); return r; }
constexpr float RMS_EPS = 1e-6f;
__device__ __forceinline__ float row_rstd16(const float* ssp, int row) {
    const f32x4* p = (const f32x4*)(ssp + (size_t)row * 16); const f32x4 a = p[0], b = p[1], c = p[2], d = p[3];
    const float s = (((a[0] + a[1]) + (a[2] + a[3])) + ((b[0] + b[1]) + (b[2] + b[3]))) + (((c[0] + c[1]) + (c[2] + c[3])) + ((d[0] + d[1]) + (d[2] + d[3])));
    return rsqrtf(s * (1.0f / 1024.0f) + RMS_EPS);
}
__device__ __forceinline__ float row_rstd8(const float* ssp, int row) {
    const f32x4* p = (const f32x4*)(ssp + (size_t)row * 8); const f32x4 a = p[0], b = p[1];
    const float s = ((a[0] + a[1]) + (a[2] + a[3])) + ((b[0] + b[1]) + (b[2] + b[3]));
    return rsqrtf(s * (1.0f / 1024.0f) + RMS_EPS);
}

struct EpiProj {
    static constexpr bool PERM = true, AFTER_DRAIN = false;
    bf16_t* O; size_t plane_stride; const float* ss; float* AB; bf16_t* halo; const PG8_LAS float* rs_tab; int pm_a, pm_b;
    __device__ __forceinline__ void operator()(const f32x4 (&acc)[2][2][4][2], const Unit& u, int wr, int wc, int fr, int fq) const {
        const int tsel = (u.pm == pm_a) ? 0 : ((u.pm == pm_b) ? 256 : -1);
        const int row0 = u.pm * BM + wr * 64 + fr; const int colt = u.pn * BM;
        if (colt >= 4096) {
            if (wc == 0 && fq < 2) {
#pragma unroll
                for (int ai = 0; ai < 2; ++ai)
#pragma unroll
                    for (int m = 0; m < 4; ++m) { const int row = row0 + ai * HALF + m * 16; const float rs = row_rstd16(ss, row);
#pragma unroll
                        for (int n = 0; n < 2; ++n) { const f32x4 v = acc[ai][0][m][n] * rs; *(f32x4*)(AB + (size_t)row * 16 + 8 * fq + 4 * n) = v; } }
            }
            return;
        }
        const int plane = colt >> 10; bf16_t* base = O + (size_t)plane * plane_stride; const int col0 = (colt & 1023) + wc * 32 + 8 * fq;
#pragma unroll
        for (int ai = 0; ai < 2; ++ai)
#pragma unroll
            for (int m = 0; m < 4; ++m) { const int row = row0 + ai * HALF + m * 16; const float rs = (tsel >= 0) ? rs_tab[tsel + (row & 255)] : row_rstd16(ss, row);
                bf16_t* rowp = base + (size_t)row * 1024 + col0;
#pragma unroll
                for (int bj = 0; bj < 2; ++bj) { f32x4 v0 = acc[ai][bj][m][0] * rs, v1 = acc[ai][bj][m][1] * rs;
                    if (plane == 3) {
#pragma unroll
                        for (int e = 0; e < 4; ++e) { v0[e] = v0[e] * __builtin_amdgcn_rcpf(1.0f + __expf(-v0[e])); v1[e] = v1[e] * __builtin_amdgcn_rcpf(1.0f + __expf(-v1[e])); } }
                    u32x4 w; w.x = cvt_pk_bf16(v0[0], v0[1]); w.y = cvt_pk_bf16(v0[2], v0[3]); w.z = cvt_pk_bf16(v1[0], v1[1]); w.w = cvt_pk_bf16(v1[2], v1[3]);
                    *(u32x4*)(rowp + bj * HALF) = w;
                    if (halo != nullptr && plane < 3 && m == 3 && fr >= 13) *(u32x4*)(halo + ((size_t)(row >> 6) * 3 + (fr - 13)) * 3072 + plane * 1024 + col0 + bj * HALF) = w; } }
    }
};
struct EpiUp {
    static constexpr bool PERM = true, AFTER_DRAIN = false;
    bf16_t* O; const float* ss; const PG8_LAS float* rs_tab; int pm_a, pm_b;
    __device__ __forceinline__ void operator()(const f32x4 (&acc)[2][2][4][2], const Unit& u, int wr, int wc, int fr, int fq) const {
        const int tsel = (u.pm == pm_a) ? 0 : ((u.pm == pm_b) ? 256 : -1);
        const int row0 = u.pm * BM + wr * 64 + fr; const int col0 = u.pn * BM + wc * 32 + 8 * fq;
#pragma unroll
        for (int ai = 0; ai < 2; ++ai)
#pragma unroll
            for (int m = 0; m < 4; ++m) { const int row = row0 + ai * HALF + m * 16; const float rs = (tsel >= 0) ? rs_tab[tsel + (row & 255)] : row_rstd16(ss, row);
                bf16_t* rowp = O + (size_t)row * 4096 + col0;
#pragma unroll
                for (int bj = 0; bj < 2; ++bj) { f32x4 v0 = acc[ai][bj][m][0] * rs, v1 = acc[ai][bj][m][1] * rs;
#pragma unroll
                    for (int e = 0; e < 4; ++e) { const float a0 = fmaxf(v0[e], 0.f), a1 = fmaxf(v1[e], 0.f); v0[e] = a0 * a0; v1[e] = a1 * a1; }
                    u32x4 w; w.x = cvt_pk_bf16(v0[0], v0[1]); w.y = cvt_pk_bf16(v0[2], v0[3]); w.z = cvt_pk_bf16(v1[0], v1[1]); w.w = cvt_pk_bf16(v1[2], v1[3]);
                    *(u32x4*)(rowp + bj * HALF) = w; } }
    }
};
struct EpiRes {
    static constexpr bool PERM = true, AFTER_DRAIN = false;
    bf16_t* hb; float* ss_next; const float* rowss; const PG8_LAS float* rs_tab; int pm_a, pm_b;
    __device__ __forceinline__ void operator()(const f32x4 (&acc)[2][2][4][2], const Unit& u, int wr, int wc, int fr_, int fq_) const {
        int fr = fr_, fq = fq_; asm volatile("" : "+v"(fr), "+v"(fq));
        const int tsel = (u.pm == pm_a) ? 0 : ((u.pm == pm_b) ? 256 : -1);
        const int row0 = u.pm * BM + wr * 64 + fr; const int col0 = u.pn * BM + wc * 32 + 8 * fq;
        u32x4 hq[3][2];
#define EPIRES_LD(slot, g_) do { const size_t off_ = (size_t)(row0 + ((g_) >> 2) * HALF + ((g_) & 3) * 16) * 1024 + col0; hq[slot][0] = *(const u32x4*)(hb + off_); hq[slot][1] = *(const u32x4*)(hb + off_ + HALF); } while (0)
        EPIRES_LD(0, 0); EPIRES_LD(1, 1);
#pragma unroll
        for (int g = 0; g < 8; ++g) { const int ai = g >> 2, m = g & 3; const int row = row0 + ai * HALF + m * 16;
            if (g + 2 < 8) EPIRES_LD((g + 2) % 3, g + 2);
            const float sc = rowss ? ((tsel >= 0) ? rs_tab[tsel + (row & 255)] : row_rstd16(rowss, row)) : 1.0f;
            const size_t off = (size_t)row * 1024 + col0; float q = 0.f;
#pragma unroll
            for (int bj = 0; bj < 2; ++bj) { const u32x4 hw = hq[g % 3][bj];
                const f32x4 h0 = (f32x4){__uint_as_float(hw.x << 16), __uint_as_float(hw.x & 0xffff0000u), __uint_as_float(hw.y << 16), __uint_as_float(hw.y & 0xffff0000u)};
                const f32x4 h1 = (f32x4){__uint_as_float(hw.z << 16), __uint_as_float(hw.z & 0xffff0000u), __uint_as_float(hw.w << 16), __uint_as_float(hw.w & 0xffff0000u)};
                const f32x4 v0 = h0 + acc[ai][bj][m][0] * sc, v1 = h1 + acc[ai][bj][m][1] * sc;
                u32x4 w; w.x = cvt_pk_bf16(v0[0], v0[1]); w.y = cvt_pk_bf16(v0[2], v0[3]); w.z = cvt_pk_bf16(v1[0], v1[1]); w.w = cvt_pk_bf16(v1[2], v1[3]);
                *(u32x4*)(hb + off + bj * HALF) = w;
                q += (v0[0] * v0[0] + v0[1] * v0[1]) + (v0[2] * v0[2] + v0[3] * v0[3]) + (v1[0] * v1[0] + v1[1] * v1[1]) + (v1[2] * v1[2] + v1[3] * v1[3]); }
            q += __shfl_xor(q, 16); q += __shfl_xor(q, 32);
            if (fq == 0) ss_next[(size_t)row * 16 + u.pn * 4 + wc] = q;
            asm volatile("" ::: "memory"); }
#undef EPIRES_LD
    }
};

template <class Epi, class Sched, bool ALIGN_EPI = false, bool SP2 = false>
__device__ __forceinline__ void gemm_phase(PG8_LAS unsigned char* lds, const Gemm g, const Sched& S, const Epi& E) {
    int tid = threadIdx.x; asm volatile("" : "+v"(tid));
    const int wid = __builtin_amdgcn_readfirstlane(tid >> 6), lane = tid & 63, wr = wid >> 2, wc = wid & 3, fr = lane & 15, fq = lane >> 4;
    const int K = g.K, nt = K / BK;
    unsigned voffA[2], voffB[2];
#pragma unroll
    for (int i = 0; i < 2; ++i) { int R, C; stage_rc(tid * 16 + i * 8192, R, C); const int Rb = Epi::PERM ? ((R & ~31) + perm32(R & 31)) : R;
        voffA[i] = (unsigned)(R * K + C) * 2u; voffB[i] = (unsigned)(Rb * K + C) * 2u; }
    const size_t kstep = (size_t)(BK * 2);
    const size_t hstep = (size_t)HALF * K * 2;
    const size_t tstep = 2 * hstep;
    const unsigned ldsw = (unsigned)wid * 1024u;
    const int aoff = lds_byte(wr * 64 + fr, fq * 8), boff = lds_byte(wc * 32 + fr, fq * 8);
#define PG8_SA(b, h) (((b) * 2 + (h)) * HTB)
#define PG8_SB(b, h) ((4 + (b) * 2 + (h)) * HTB)
#define PG8_STAGE(bufoff, gbase, voff) do { _Pragma("unroll") for (int _i = 0; _i < 2; ++_i) \
        __builtin_amdgcn_global_load_lds((const unsigned*)((const char*)(gbase) + (voff)[_i]), (PG8_LAS unsigned*)(lds + (bufoff) + ldsw + _i * 8192), 16, 0, 0); } while (0)
#define PG8_LDA(dst, b, h) do { _Pragma("unroll") for (int m = 0; m < 4; ++m) _Pragma("unroll") for (int k = 0; k < 2; ++k) dst[m][k] = *(const PG8_LAS bf16x8*)(lds + PG8_SA(b, h) + aoff + m * 2048 + k * 1024); } while (0)
#define PG8_LDB(dst, b, h) do { _Pragma("unroll") for (int n = 0; n < 2; ++n) _Pragma("unroll") for (int k = 0; k < 2; ++k) dst[n][k] = *(const PG8_LAS bf16x8*)(lds + PG8_SB(b, h) + boff + n * 2048 + k * 1024); } while (0)
#define PG8_MMA(ai, bj, At, Bt) do { __builtin_amdgcn_s_setprio(1); _Pragma("unroll") for (int m = 0; m < 4; ++m) _Pragma("unroll") for (int n = 0; n < 2; ++n) _Pragma("unroll") for (int k = 0; k < 2; ++k) \
        acc[ai][bj][m][n] = __builtin_amdgcn_mfma_f32_16x16x32_bf16(Bt[n][k], At[m][k], acc[ai][bj][m][n], 0, 0, 0); __builtin_amdgcn_s_setprio(0); } while (0)
#define PG8_WAIT_V(n) asm volatile("s_waitcnt vmcnt(" #n ")" ::: "memory")
#define PG8_WAIT_L(n) asm volatile("s_waitcnt lgkmcnt(" #n ")" ::: "memory")
#define PG8_BAR __builtin_amdgcn_s_barrier()
#define PG8_SCHED __builtin_amdgcn_sched_barrier(0)
    Unit cur, nxt; int ui = 0;
    if (!S.next(0, cur)) return;
    f32x4 acc[2][2][4][2];
#pragma unroll
    for (int a = 0; a < 2; ++a)
#pragma unroll
        for (int b = 0; b < 2; ++b)
#pragma unroll
            for (int m = 0; m < 4; ++m)
#pragma unroll
                for (int n = 0; n < 2; ++n) acc[a][b][m][n] = (f32x4){0.f, 0.f, 0.f, 0.f};
    bf16x8 At[4][2], B0[2][2], B1[2][2];
    const char* cA = (const char*)g.A + (size_t)cur.pm * tstep; const char* cB = (const char*)g.Bt + (size_t)cur.pn * tstep;
    S.a_ready(cur);
    if constexpr (SP2) {
        PG8_STAGE(PG8_SB(0, 0), cB, voffB); PG8_STAGE(PG8_SB(0, 1), cB + hstep, voffB); PG8_STAGE(PG8_SA(0, 0), cA, voffA); PG8_STAGE(PG8_SA(0, 1), cA + hstep, voffA);
        if (wr == 1) PG8_BAR;
        PG8_WAIT_V(2); PG8_BAR;
        PG8_STAGE(PG8_SB(1, 0), cB + kstep, voffB); PG8_STAGE(PG8_SA(1, 0), cA + kstep, voffA); PG8_STAGE(PG8_SB(1, 1), cB + hstep + kstep, voffB);
        PG8_WAIT_V(6); PG8_BAR;
    } else {
        PG8_STAGE(PG8_SB(0, 0), cB, voffB); PG8_STAGE(PG8_SA(0, 0), cA, voffA); PG8_STAGE(PG8_SB(0, 1), cB + hstep, voffB); PG8_STAGE(PG8_SA(0, 1), cA + hstep, voffA);
        if (wr == 1) PG8_BAR;
        PG8_WAIT_V(4); PG8_BAR;
        PG8_STAGE(PG8_SB(1, 0), cB + kstep, voffB); PG8_STAGE(PG8_SA(1, 0), cA + kstep, voffA); PG8_STAGE(PG8_SB(1, 1), cB + hstep + kstep, voffB);
        PG8_WAIT_V(6); PG8_BAR;
    }
    for (;;) {
        const bool has_next = S.next(ui + 1, nxt);
        const char* nA = has_next ? (const char*)g.A + (size_t)nxt.pm * tstep : cA; const char* nB = has_next ? (const char*)g.Bt + (size_t)nxt.pn * tstep : cB;
        for (int t = 0; t < nt; t += 2) {
            const bool last = (t == nt - 2);
            const char* a1 = cA + (size_t)(t + 1) * kstep;
            const char* a2 = last ? nA : cA + (size_t)(t + 2) * kstep; const char* b2 = last ? nB : cB + (size_t)(t + 2) * kstep;
            const char* a3 = a2 + kstep; const char* b3 = b2 + kstep;
            if (last && has_next) S.a_ready(nxt);
            if constexpr (SP2) {
            PG8_LDB(B0, 0, 0); PG8_LDB(B1, 0, 1); PG8_SCHED; PG8_LDA(At, 0, 0); PG8_STAGE(PG8_SA(1, 1), a1 + hstep, voffA);
            PG8_WAIT_V(8); PG8_WAIT_L(0); PG8_BAR; PG8_MMA(0, 0, At, B0); PG8_MMA(0, 1, At, B1); PG8_BAR; PG8_SCHED;
            PG8_LDA(At, 0, 1); PG8_STAGE(PG8_SB(0, 0), b2, voffB); PG8_STAGE(PG8_SB(0, 1), b2 + hstep, voffB); PG8_STAGE(PG8_SA(0, 0), a2, voffA);
            PG8_WAIT_V(8); PG8_WAIT_L(0); PG8_BAR; PG8_MMA(1, 0, At, B0); PG8_MMA(1, 1, At, B1); PG8_BAR; PG8_SCHED;
            PG8_LDB(B0, 1, 0); PG8_LDB(B1, 1, 1); PG8_SCHED; PG8_LDA(At, 1, 0); PG8_STAGE(PG8_SA(0, 1), a2 + hstep, voffA);
            PG8_WAIT_V(8); PG8_WAIT_L(0); PG8_BAR; PG8_MMA(0, 0, At, B0); PG8_MMA(0, 1, At, B1); PG8_BAR; PG8_SCHED;
            PG8_LDA(At, 1, 1); PG8_STAGE(PG8_SB(1, 0), b3, voffB); PG8_STAGE(PG8_SB(1, 1), b3 + hstep, voffB); PG8_STAGE(PG8_SA(1, 0), a3, voffA);
            PG8_WAIT_V(8); PG8_WAIT_L(0); PG8_BAR; PG8_MMA(1, 0, At, B0); PG8_MMA(1, 1, At, B1); PG8_BAR; PG8_SCHED;
            } else {
            PG8_LDB(B0, 0, 0); PG8_SCHED; PG8_LDA(At, 0, 0); PG8_STAGE(PG8_SA(1, 1), a1 + hstep, voffA);
            PG8_WAIT_L(8); PG8_BAR; PG8_WAIT_L(0); PG8_MMA(0, 0, At, B0); PG8_BAR; PG8_SCHED;
            PG8_LDB(B1, 0, 1); PG8_STAGE(PG8_SB(0, 0), b2, voffB);
            PG8_BAR; PG8_WAIT_L(0); PG8_MMA(0, 1, At, B1); PG8_BAR;
            PG8_LDA(At, 0, 1); PG8_STAGE(PG8_SA(0, 0), a2, voffA);
            PG8_BAR; PG8_WAIT_L(0); PG8_MMA(1, 0, At, B0); PG8_BAR; PG8_SCHED;
            PG8_STAGE(PG8_SB(0, 1), b2 + hstep, voffB);
            PG8_WAIT_V(6); PG8_BAR; PG8_MMA(1, 1, At, B1); PG8_BAR;
            PG8_LDB(B0, 1, 0); PG8_SCHED; PG8_LDA(At, 1, 0); PG8_STAGE(PG8_SA(0, 1), a2 + hstep, voffA);
            PG8_WAIT_L(8); PG8_BAR; PG8_WAIT_L(0); PG8_MMA(0, 0, At, B0); PG8_BAR; PG8_SCHED;
            PG8_LDB(B1, 1, 1); PG8_STAGE(PG8_SB(1, 0), b3, voffB);
            PG8_BAR; PG8_WAIT_L(0); PG8_MMA(0, 1, At, B1); PG8_BAR;
            PG8_LDA(At, 1, 1); PG8_STAGE(PG8_SA(1, 0), a3, voffA);
            PG8_BAR; PG8_WAIT_L(0); PG8_MMA(1, 0, At, B0); PG8_BAR; PG8_SCHED;
            PG8_STAGE(PG8_SB(1, 1), b3 + hstep, voffB);
            PG8_WAIT_V(6); PG8_BAR; PG8_MMA(1, 1, At, B1); PG8_BAR;
            }
        }
        if constexpr (ALIGN_EPI) { if (wr == 0) PG8_BAR; }
        if constexpr (!Epi::AFTER_DRAIN) { E(acc, cur, wr, wc, fr, fq); S.done(cur); }
        if (!has_next) break;
#pragma unroll
        for (int a = 0; a < 2; ++a)
#pragma unroll
            for (int b = 0; b < 2; ++b)
#pragma unroll
                for (int m = 0; m < 4; ++m)
#pragma unroll
                    for (int n = 0; n < 2; ++n) acc[a][b][m][n] = (f32x4){0.f, 0.f, 0.f, 0.f};
        cur = nxt; cA = nA; cB = nB; ++ui;
        if constexpr (ALIGN_EPI) { if (wr == 1) PG8_BAR; }
    }
    PG8_WAIT_V(0);
    if constexpr (!ALIGN_EPI) { if (wr == 0) PG8_BAR; }
    PG8_BAR;
    if constexpr (Epi::AFTER_DRAIN) { E.fused(acc, cur, wr, wc, fr, fq, lds, wid, lane); S.done(cur); }
#undef PG8_SA
#undef PG8_SB
#undef PG8_STAGE
#undef PG8_LDA
#undef PG8_LDB
#undef PG8_MMA
#undef PG8_WAIT_V
#undef PG8_WAIT_L
#undef PG8_BAR
#undef PG8_SCHED
}
}

#define LAS __attribute__((address_space(3)))
typedef unsigned short bf16_t;
typedef short bf16x8 __attribute__((ext_vector_type(8)));
typedef float f32x4 __attribute__((ext_vector_type(4)));
typedef unsigned u32x4 __attribute__((ext_vector_type(4)));
typedef unsigned u32x2 __attribute__((ext_vector_type(2)));
constexpr int NWAVES = 8, NTHREADS = 512;
constexpr int M_TOK = 32768, DMODEL = 1024, NCH = 512  , NITEM = 4096  ;
constexpr float EPS = 1e-6f;
constexpr size_t MiB = 1u << 20;
constexpr size_t PLANE = (size_t)M_TOK * 1024;
constexpr size_t WS_BAR = 0;
constexpr size_t WS_LB = 1536 * 1024;
constexpr size_t WS_WGI = 2 * MiB, WS_WGO = 19 * MiB, WS_WHI = 23 * MiB, WS_WHO = 39 * MiB, WS_WUP = 43 * MiB, WS_WDN = 75 * MiB;
constexpr size_t WS_PROJ = 108 * MiB;
constexpr size_t WS_HB = 364 * MiB;
constexpr size_t WS_AQK = 428 * MiB;
constexpr size_t WS_HALO = 460 * MiB;
constexpr size_t WS_AB = 470 * MiB;
constexpr size_t WS_DEC = 472 * MiB;
constexpr size_t WS_SSA = 474 * MiB, WS_SSB = 476 * MiB;
constexpr size_t WS_SSO = 478 * MiB;
constexpr size_t WS_END = 480 * MiB;
constexpr int GDN_NPAD = 4352;
constexpr int LDS_BYTES = 147456;

__device__ __forceinline__ float bf2f(unsigned v) { return __uint_as_float(v << 16); }
__device__ __forceinline__ float bflo(unsigned w) { return __uint_as_float(w << 16); }
__device__ __forceinline__ float bfhi(unsigned w) { return __uint_as_float(w & 0xffff0000u); }
__device__ __forceinline__ unsigned f2bf(float f) { unsigned u = __float_as_uint(f); return (u + 0x7fffu + ((u >> 16) & 1u)) >> 16; }
__device__ __forceinline__ unsigned pk2(float lo, float hi) { return pg8::cvt_pk_bf16(lo, hi); }
__device__ __forceinline__ float frcp_(float x) { return __builtin_amdgcn_rcpf(x); }
__device__ __forceinline__ float sigmoidf_(float x) { return frcp_(1.0f + __expf(-x)); }
__device__ __forceinline__ float siluf_(float x) { return x * frcp_(1.0f + __expf(-x)); }
__device__ __forceinline__ float row16_sum(float v);
__device__ __forceinline__ float wave_sum(float v) {
    v = row16_sum(v);
    { const auto r16 = __builtin_amdgcn_permlane16_swap(__float_as_uint(v), __float_as_uint(v), false, false); v = __uint_as_float(r16[0]) + __uint_as_float(r16[1]); }
    { const auto r32 = __builtin_amdgcn_permlane32_swap(__float_as_uint(v), __float_as_uint(v), false, false); v = __uint_as_float(r32[0]) + __uint_as_float(r32[1]); }
    return v;
}
#define LDS_WAIT() asm volatile("s_waitcnt lgkmcnt(0)" ::: "memory")
__device__ __forceinline__ float row16_sum(float v) {
    v += __builtin_bit_cast(float, __builtin_amdgcn_update_dpp(0, __builtin_bit_cast(int, v), 0xB1, 0xF, 0xF, false));
    v += __builtin_bit_cast(float, __builtin_amdgcn_update_dpp(0, __builtin_bit_cast(int, v), 0x4E, 0xF, 0xF, false));
    v += __builtin_bit_cast(float, __builtin_amdgcn_update_dpp(0, __builtin_bit_cast(int, v), 0x141, 0xF, 0xF, false));
    v += __builtin_bit_cast(float, __builtin_amdgcn_update_dpp(0, __builtin_bit_cast(int, v), 0x140, 0xF, 0xF, false));
    return v;
}
#define LBAR() do { asm volatile("s_waitcnt lgkmcnt(0)" ::: "memory"); __builtin_amdgcn_s_barrier(); asm volatile("" ::: "memory"); } while (0)

template <int K> __device__ __forceinline__ f32x4 mm_tile(const LAS bf16_t* A1, int s1, const LAS bf16_t* A2, int s2, f32x4 acc, int lane) {
    const LAS bf16_t* p1 = A1 + (lane & 15) * s1 + (lane >> 4) * 8;
    const LAS bf16_t* p2 = A2 + (lane & 15) * s2 + (lane >> 4) * 8;
#pragma unroll
    for (int k0 = 0; k0 < K; k0 += 32) {
        const bf16x8 a = *(const LAS bf16x8*)(p1 + k0); const bf16x8 b = *(const LAS bf16x8*)(p2 + k0);
        acc = __builtin_amdgcn_mfma_f32_16x16x32_bf16(a, b, acc, 0, 0, 0);
    }
    return acc;
}

#define XB_TMO      128
#define XB_XCNT(j)  (256  + 64 * (j))
#define XB_XSUB(j)  (1280 + 64 * (j))
#define XB_XGEN(j)  (2304 + 64 * (j))
#define XB_TOP      3328
#define XB_TOPGEN   3392
#define XCD_BAR_WORDS 3456
#define XB_SPIN_CAP (1u << 18)

__device__ __forceinline__ unsigned xb_ld(unsigned* p)              { return __hip_atomic_load(p, __ATOMIC_RELAXED, __HIP_MEMORY_SCOPE_AGENT); }
__device__ __forceinline__ unsigned xb_add(unsigned* p, unsigned v) { return __hip_atomic_fetch_add(p, v, __ATOMIC_RELAXED, __HIP_MEMORY_SCOPE_AGENT); }
__device__ __forceinline__ unsigned xb_xcc_id() { return (unsigned)__builtin_amdgcn_s_getreg((3 << 11) | 20) & 0xFu; }
#define XB_SPIN(cond, bar) do { unsigned _sp = 0; while (cond) { __builtin_amdgcn_s_sleep(6); \
    if ((++_sp & 255u) == 0u) { if (xb_ld(&(bar)[XB_TMO])) break; if (_sp > XB_SPIN_CAP) { atomicAdd(&(bar)[XB_TMO], 1u); break; } } } } while (0)

struct XcdBarrier {
    unsigned* bar; unsigned x;
    volatile LAS unsigned* st;
};

__device__ __forceinline__ XcdBarrier xcd_barrier_post(unsigned* bar, volatile LAS unsigned* st) {
    XcdBarrier b; b.bar = bar; b.x = xb_xcc_id(); b.st = st;
    if (threadIdx.x == 0) (void)xb_add(&bar[XB_XCNT(b.x)], 1u);
    return b;
}
__device__ __forceinline__ void xcd_barrier_complete(unsigned* bar, unsigned x, unsigned& nloc, unsigned& nx) {
    const unsigned G = gridDim.x * gridDim.y * gridDim.z;
    unsigned sum, cnt, mine, sp = 0u;
    for (;;) {
        sum = 0u; cnt = 0u; mine = 0u;
#pragma unroll
        for (unsigned j = 0; j < 16; ++j) { const unsigned c = xb_ld(&bar[XB_XCNT(j)]); sum += c; cnt += (c > 0u) ? 1u : 0u; mine = (j == x) ? c : mine; }
        if (sum == G) break;
        __builtin_amdgcn_s_sleep(1);
        if ((++sp & 255u) == 0u) { if (xb_ld(&bar[XB_TMO])) break; if (sp > XB_SPIN_CAP) { atomicAdd(&bar[XB_TMO], 1u); break; } }
    }
    nloc = mine > 0u ? mine : 1u; nx = cnt > 0u ? cnt : 1u;
}

__device__ __forceinline__ void xcd_barrier(const XcdBarrier& b) {
    asm volatile("s_waitcnt vmcnt(0)" ::: "memory");
    __syncthreads();
    if (threadIdx.x == 0) {
        unsigned* bar = b.bar;
        __builtin_amdgcn_s_waitcnt(0);
        unsigned nloc = b.st[0], nx = b.st[1];
        if (nloc == 0u) { xcd_barrier_complete(bar, b.x, nloc, nx); b.st[0] = nloc; b.st[1] = nx; }
        const unsigned old = xb_add(&bar[XB_XSUB(b.x)], 1u);
        const unsigned gen = old / nloc;
        if (old + 1u == (gen + 1u) * nloc) {
            __builtin_amdgcn_fence(__ATOMIC_RELEASE, "agent");
            asm volatile("s_waitcnt vmcnt(0)" ::: "memory");
            const unsigned og = xb_add(&bar[XB_TOP], 1u);
            const unsigned tg = og / nx;
            if (og + 1u == (tg + 1u) * nx) xb_add(&bar[XB_TOPGEN], 1u);
            else XB_SPIN(xb_ld(&bar[XB_TOPGEN]) == tg, bar);
            __builtin_amdgcn_fence(__ATOMIC_ACQUIRE, "agent");
            xb_add(&bar[XB_XGEN(b.x)], 1u);
            asm volatile("s_waitcnt vmcnt(0)" ::: "memory");
        } else {
            XB_SPIN(xb_ld(&bar[XB_XGEN(b.x)]) == gen, bar);
            __builtin_amdgcn_fence(__ATOMIC_ACQUIRE, "agent");
            asm volatile("s_waitcnt vmcnt(0)" ::: "memory");
        }
    }
    __syncthreads();
}
__device__ __forceinline__ void transpose_item(const float* W, int K, int Nsrc, int Npad, const float* nw, bf16_t* WT, LAS float* scr, int item, int lane) {
    const int nblk = Npad / 32, kb = item / nblk, nb = item % nblk, k0 = 64 * kb, n0 = 32 * nb;
    { const int c4 = lane & 7, n = n0 + c4 * 4; f32x4 v[8];
#pragma unroll
      for (int i = 0; i < 8; ++i) { const int kk = 8 * i + (lane >> 3); v[i] = (n < Nsrc) ? *(const f32x4*)(W + (size_t)(k0 + kk) * Nsrc + n) : (f32x4){0.f, 0.f, 0.f, 0.f}; }
#pragma unroll
      for (int i = 0; i < 8; ++i) { const int kk = 8 * i + (lane >> 3); const float sc = nw ? nw[k0 + kk] : 1.0f;
          scr[kk * 33 + c4 * 4 + 0] = v[i][0] * sc; scr[kk * 33 + c4 * 4 + 1] = v[i][1] * sc; scr[kk * 33 + c4 * 4 + 2] = v[i][2] * sc; scr[kk * 33 + c4 * 4 + 3] = v[i][3] * sc; } }
    LDS_WAIT(); asm volatile("" ::: "memory");
    const int c = lane & 7;
#pragma unroll
    for (int j = 0; j < 4; ++j) { const int n = (lane >> 3) + 8 * j; const LAS float* s = scr + (8 * c) * 33 + n;
        u32x4 o; o.x = pk2(s[0 * 33], s[1 * 33]); o.y = pk2(s[2 * 33], s[3 * 33]); o.z = pk2(s[4 * 33], s[5 * 33]); o.w = pk2(s[6 * 33], s[7 * 33]);
        *(u32x4*)(WT + (size_t)(n0 + n) * K + k0 + 8 * c) = o; }
    LDS_WAIT(); asm volatile("" ::: "memory");
}

struct Args { const float* in[16]; float* out; unsigned char* ws; };

__device__ __forceinline__ void convert_layer_weights(const Args& a, LAS unsigned char* lds, int tid, int i, int nworkers) {
    asm volatile("" : "+v"(tid));
    const int worker = ((int)blockIdx.x - 128) * NWAVES + (tid >> 6);
    const int lane = tid & 63, wave = __builtin_amdgcn_readfirstlane(tid >> 6); unsigned char* ws = a.ws; LAS float* scr = (LAS float*)(lds + wave * 16384);
    const int j = i >> 1; const bool gdn = (i & 1) == 0;
    constexpr int I_GI = 16 * (GDN_NPAD / 32), I_SQ = 16 * 32, I_HI = 16 * 128, I_UP = 16 * 128, I_DN = 64 * 32;
    const int n_next = (i == 3) ? 0 : (gdn ? I_HI : I_GI);
    const int total = I_SQ + I_UP + I_DN + n_next;
    for (int it = worker; it < total; it += nworkers) {
        int r = it; const float* W; const float* nw = nullptr; bf16_t* WT; int K = 1024, Nsrc = 1024, Npad = 1024;
        if (r < I_SQ) { W = (gdn ? a.in[6] : a.in[10]) + (size_t)j * 1024 * 1024; WT = (bf16_t*)(ws + (gdn ? WS_WGO : WS_WHO)) + (size_t)j * 1024 * 1024; }
        else if (r < I_SQ + I_UP) { r -= I_SQ; W = a.in[13] + (size_t)i * 1024 * 4096; Nsrc = 4096; Npad = 4096; nw = a.in[12] + i * 1024; WT = (bf16_t*)(ws + WS_WUP) + (size_t)i * 4096 * 1024; }
        else if (r < I_SQ + I_UP + I_DN) { r -= I_SQ + I_UP; W = a.in[14] + (size_t)i * 4096 * 1024; K = 4096; WT = (bf16_t*)(ws + WS_WDN) + (size_t)i * 1024 * 4096; }
        else { r -= I_SQ + I_UP + I_DN; nw = a.in[11] + (size_t)(i + 1) * 1024;
            if (gdn) { W = a.in[7] + (size_t)j * 1024 * 4096; Nsrc = 4096; Npad = 4096; WT = (bf16_t*)(ws + WS_WHI) + (size_t)j * 4096 * 1024; }
            else { W = a.in[1] + (size_t)(j + 1) * 1024 * 4112; Nsrc = 4112; Npad = GDN_NPAD; WT = (bf16_t*)(ws + WS_WGI) + (size_t)(j + 1) * GDN_NPAD * 1024; } }
        transpose_item(W, K, Nsrc, Npad, nw, WT, scr, r, lane);
    }
}

__device__ __forceinline__ void prologue(const Args& a, LAS unsigned char* lds, int tid) {
    asm volatile("" : "+v"(tid));
    const int lane = tid & 63, wave = __builtin_amdgcn_readfirstlane(tid >> 6);
    unsigned char* ws = a.ws;
    LAS float* scr = (LAS float*)(lds + wave * 16384);
    const int gw = blockIdx.x * NWAVES + wave, NGW = gridDim.x * NWAVES;
    const float* gdn_w_in = a.in[1]; const float* norm_mix = a.in[11];
    constexpr int I_GI = 16 * (GDN_NPAD / 32);
    for (int it = gw; it < I_GI; it += NGW) transpose_item(gdn_w_in, 1024, 4112, GDN_NPAD, norm_mix, (bf16_t*)(ws + WS_WGI), scr, it, lane);
    float* SSB = (float*)(ws + WS_SSB); bf16_t* HB = (bf16_t*)(ws + WS_HB); const float* x = a.in[0];
    for (int m = gw; m < M_TOK; m += NGW) {
        const f32x4* xr = (const f32x4*)(x + (size_t)m * DMODEL) + lane; float s = 0.f; f32x4 v[4];
#pragma unroll
        for (int j = 0; j < 4; ++j) { v[j] = xr[64 * j]; s += (v[j][0] * v[j][0] + v[j][1] * v[j][1]) + (v[j][2] * v[j][2] + v[j][3] * v[j][3]); }
        s = wave_sum(s);
        u32x2* o8 = (u32x2*)(HB + (size_t)m * DMODEL) + lane;
#pragma unroll
        for (int j = 0; j < 4; ++j) { u32x2 w; w.x = pk2(v[j][0], v[j][1]); w.y = pk2(v[j][2], v[j][3]); o8[64 * j] = w; }
        if (lane < 16) SSB[(size_t)m * 16 + lane] = (lane == 0) ? s : 0.f;
    }
    if (blockIdx.x == 0) {
        const float* lg = a.in[8]; float* LB = (float*)(ws + WS_LB);
        for (int c = tid; c < 1024; c += NTHREADS) {
            const float l0 = lg[c], l1 = lg[1024 + c], l2 = lg[2048 + c], l3 = lg[3072 + c];
            const float mx = fmaxf(fmaxf(l0, l1), fmaxf(l2, l3));
            const float e0 = expf(l0 - mx), e1 = expf(l1 - mx), e2 = expf(l2 - mx), e3 = expf(l3 - mx); const float inv = 1.0f / (e0 + e1 + e2 + e3);
            LB[c] = e1 * inv; LB[1024 + c] = (e1 + e2 + e3) * inv;
        }
    }
}

__device__ __forceinline__ void gdn_prep(LAS unsigned char* lds, int tid, bf16_t* P, bf16_t* Wpl, bf16_t* AQK, const bf16_t* HALO, const float* AB, float* DEC,
                                         const float* conv_w, const float* a_log, const float* dt_bias
#ifdef PROBE_SEL
                                         , unsigned& tacc, unsigned& tprev
#endif
                                         ) {
#ifdef PROBE_SEL
#define PSTAMP(k) do { const unsigned t_ = (unsigned)__builtin_amdgcn_s_memrealtime(); if ((k) == PROBE_SEL) tacc += t_ - tprev; tprev = t_; } while (0)
#else
#define PSTAMP(k) do {} while (0)
#endif
    asm volatile("" : "+v"(tid));
    const int lane = tid & 63, wave = __builtin_amdgcn_readfirstlane(tid >> 6);
    LAS bf16_t* QB = (LAS bf16_t*)lds; LAS bf16_t* KB = QB + 64 * 136; LAS bf16_t* VB = KB + 64 * 136;
    LAS float* LM = (LAS float*)(lds + 52224);
    LAS float* GC = (LAS float*)(lds + 69632); LAS float* BETA = GC + 64; LAS float* EG = BETA + 64; LAS float* BEG = EG + 64;
    LAS bf16_t* LBh = (LAS bf16_t*)(lds + 70656);
    LAS bf16_t* SOLT = (LAS bf16_t*)(lds + 79872);
    LAS float* XU = (LAS float*)(lds + 116736);
    LAS bf16_t* AQT = (LAS bf16_t*)(lds + 116736);
    LAS float* CW = (LAS float*)(lds + 133376);
    for (int i = tid; i < 256 * 72 / 2; i += NTHREADS) ((LAS unsigned*)SOLT)[i] = 0u;
    const int h = blockIdx.x & 7;
    for (int i = tid; i < 3 * 4 * 128; i += NTHREADS) { const int pp = i >> 9, kk = (i >> 7) & 3, c = i & 127; CW[i] = conv_w[kk * 3072 + pp * 1024 + h * 128 + c]; }
    __syncthreads();
    const float ealog_h = expf(a_log[h]), dtb_h = dt_bias[h];
    u32x4 xa[7], xb[5]; float pav = 0.f, pbv = 0.f; bool za = false; int zb = 0;
#pragma unroll
    for (int r = 0; r < 7; ++r) xa[r] = (u32x4){0u, 0u, 0u, 0u};
#pragma unroll
    for (int r = 0; r < 5; ++r) xb[r] = (u32x4){0u, 0u, 0u, 0u};
#define GDN_LOADS(itx) do { const int cidx_ = (itx) >> 3, n_ = cidx_ & 31; const unsigned cb_ = (unsigned)cidx_ * 131072u; const unsigned PL2_ = (unsigned)(PLANE * 2); \
        const bf16_t* hal_ = HALO + (size_t)(n_ > 0 ? cidx_ - 1 : cidx_) * 3 * 3072 + ch;     \
        _Pragma("unroll") for (int r_ = 0; r_ < 7; ++r_) { const int t_ = segA * 4 - 3 + r_; const bf16_t* q_ = (const bf16_t*)((const char*)P + ((unsigned)pA * PL2_ + cb_ + (unsigned)(((t_ < 0 ? 0 : t_) * 1024 + ch) * 2))); \
            const bf16_t* a_ = (r_ < 3 && t_ < 0) ? hal_ + (size_t)(t_ + 3) * 3072 + pA * 1024 : q_; xa[r_] = *(const u32x4*)a_; } \
        _Pragma("unroll") for (int r_ = 0; r_ < 5; ++r_) { const int t_ = segB * 2 - 3 + r_; const bf16_t* q_ = (const bf16_t*)((const char*)P + (2u * PL2_ + cb_ + (unsigned)(((t_ < 0 ? 0 : t_) * 1024 + ch) * 2))); \
            const bf16_t* a_ = (r_ < 3 && t_ < 0) ? hal_ + (size_t)(t_ + 3) * 3072 + 2 * 1024 : q_; xb[r_] = *(const u32x4*)a_; } \
        za = (n_ == 0 && segA == 0); zb = (n_ == 0) ? (3 - segB * 2) : 0; \
        if (tid >= 448) { pav = AB[((size_t)cidx_ * 64 + lane) * 16 + h]; pbv = AB[((size_t)cidx_ * 64 + lane) * 16 + 8 + h]; } } while (0)
    const int tid_in = tid;
    if ((int)blockIdx.x < NITEM) { const int pA = tid >> 8, segA = (tid >> 4) & 15, segB = tid >> 4, cg8 = tid & 15; const int ch = h * 128 + cg8 * 8; GDN_LOADS((int)blockIdx.x); }
    for (int it = blockIdx.x; it < NITEM; it += gridDim.x) {
        int tid = tid_in; asm volatile("" : "+v"(tid));
        const int lane = tid & 63;
        const int pA = tid >> 8, segA = (tid >> 4) & 15, segB = tid >> 4, cg8 = tid & 15; const int ch = h * 128 + cg8 * 8;
        const int cidx = it >> 3; const size_t row0 = (size_t)cidx * 64;
        {
            typedef float f32x2 __attribute__((ext_vector_type(2)));
#define GDN_CONV_TOKEN(xf_, tt_, y_) do { \
                _Pragma("unroll") for (int e_ = 0; e_ < 4; ++e_) y_[e_] = cw[0][e_] * xf_[(tt_)][e_]; \
                _Pragma("unroll") for (int kk_ = 1; kk_ < 4; ++kk_) _Pragma("unroll") for (int e_ = 0; e_ < 4; ++e_) y_[e_] = cw[kk_][e_] * xf_[(tt_) + kk_][e_] + y_[e_]; \
                _Pragma("unroll") for (int e_ = 0; e_ < 4; ++e_) { f32x2 ex_; ex_.x = __expf(-y_[e_].x); ex_.y = __expf(-y_[e_].y); ex_ = ex_ + 1.0f; f32x2 rc_; rc_.x = frcp_(ex_.x); rc_.y = frcp_(ex_.y); y_[e_] = y_[e_] * rc_; } } while (0)
            f32x2 cw[4][4];
            {
#pragma unroll
                for (int kk = 0; kk < 4; ++kk) { const f32x4 c0 = *(const LAS f32x4*)(CW + (pA * 4 + kk) * 128 + cg8 * 8), c1 = *(const LAS f32x4*)(CW + (pA * 4 + kk) * 128 + cg8 * 8 + 4);
                    cw[kk][0] = (f32x2){c0[0], c0[1]}; cw[kk][1] = (f32x2){c0[2], c0[3]}; cw[kk][2] = (f32x2){c1[0], c1[1]}; cw[kk][3] = (f32x2){c1[2], c1[3]}; }
                f32x2 xf[7][4];
#pragma unroll
                for (int r = 0; r < 7; ++r) { const u32x4 w = (r < 3 && za) ? (u32x4){0u, 0u, 0u, 0u} : xa[r]; xf[r][0] = (f32x2){bflo(w.x), bfhi(w.x)}; xf[r][1] = (f32x2){bflo(w.y), bfhi(w.y)}; xf[r][2] = (f32x2){bflo(w.z), bfhi(w.z)}; xf[r][3] = (f32x2){bflo(w.w), bfhi(w.w)}; }
                LAS bf16_t* dstb = QB + pA * 64 * 136 + cg8 * 8;
#pragma unroll
                for (int tt = 0; tt < 4; ++tt) {
                    f32x2 y[4]; GDN_CONV_TOKEN(xf, tt, y);
                    f32x2 sq = (f32x2){0.f, 0.f};
#pragma unroll
                    for (int e = 0; e < 4; ++e) sq = y[e] * y[e] + sq;
                    const float ssq = row16_sum(sq.x + sq.y);
                    const float rn = rsqrtf(ssq + EPS) * (pA == 0 ? 0.08838834764831845f : 1.0f);
#pragma unroll
                    for (int e = 0; e < 4; ++e) y[e] = y[e] * rn;
                    u32x4 o; o.x = pk2(y[0].x, y[0].y); o.y = pk2(y[1].x, y[1].y); o.z = pk2(y[2].x, y[2].y); o.w = pk2(y[3].x, y[3].y);
                    *(LAS u32x4*)(dstb + (segA * 4 + tt) * 136) = o;
                }
            }
            {
#pragma unroll
                for (int kk = 0; kk < 4; ++kk) { const f32x4 c0 = *(const LAS f32x4*)(CW + (2 * 4 + kk) * 128 + cg8 * 8), c1 = *(const LAS f32x4*)(CW + (2 * 4 + kk) * 128 + cg8 * 8 + 4);
                    cw[kk][0] = (f32x2){c0[0], c0[1]}; cw[kk][1] = (f32x2){c0[2], c0[3]}; cw[kk][2] = (f32x2){c1[0], c1[1]}; cw[kk][3] = (f32x2){c1[2], c1[3]}; }
                f32x2 xf[5][4];
#pragma unroll
                for (int r = 0; r < 5; ++r) { const u32x4 w = (r < 3 && r < zb) ? (u32x4){0u, 0u, 0u, 0u} : xb[r]; xf[r][0] = (f32x2){bflo(w.x), bfhi(w.x)}; xf[r][1] = (f32x2){bflo(w.y), bfhi(w.y)}; xf[r][2] = (f32x2){bflo(w.z), bfhi(w.z)}; xf[r][3] = (f32x2){bflo(w.w), bfhi(w.w)}; }
                LAS bf16_t* dstb = VB + cg8 * 8;
#pragma unroll
                for (int tt = 0; tt < 2; ++tt) {
                    f32x2 y[4]; GDN_CONV_TOKEN(xf, tt, y);
                    u32x4 o; o.x = pk2(y[0].x, y[0].y); o.y = pk2(y[1].x, y[1].y); o.z = pk2(y[2].x, y[2].y); o.w = pk2(y[3].x, y[3].y);
                    *(LAS u32x4*)(dstb + (segB * 2 + tt) * 136) = o;
                }
            }
#undef GDN_CONV_TOKEN
        }
        if (tid >= 448) {
            const float beta = sigmoidf_(pbv); const float xx = pav + dtb_h;
            const float sp = fmaxf(xx, 0.f) + __logf(1.0f + __expf(-fabsf(xx)));
            float g = -ealog_h * sp;
#pragma unroll
            for (int o = 1; o < 64; o <<= 1) { const float v = __shfl_up(g, o); if (lane >= o) g += v; }
            GC[lane] = g; BETA[lane] = beta; { const float eg = __expf(g); EG[lane] = eg; BEG[lane] = beta * eg; }
        }
        { const int itn = it + (int)gridDim.x; if (itn < NITEM) GDN_LOADS(itn); }
        LBAR(); PSTAMP(20);
#pragma unroll
        for (int q4 = 0; q4 < 4; ++q4) {
            const int tt = wave * 4 + q4, sel = tt >> 4, mi = (tt & 15) >> 2, nj = tt & 3;
            f32x4 acc = (f32x4){0.f, 0.f, 0.f, 0.f};
            if (nj <= mi) acc = mm_tile<128>((sel ? QB : KB) + mi * 16 * 136, 136, KB + nj * 16 * 136, 136, acc, lane);
            const int jc = nj * 16 + (lane & 15); const float gj = GC[jc];
#pragma unroll
            for (int jj = 0; jj < 4; ++jj) { const int i = mi * 16 + (lane >> 4) * 4 + jj;
                if (sel == 0) { float val = 0.f; if (jc < i) val = BETA[i] * acc[jj] * __expf(GC[i] - gj); LM[i * 68 + jc] = val; LBh[i * 72 + jc] = (bf16_t)f2bf(nj < mi ? val : 0.f); }
                else { float val = 0.f; if (jc <= i) val = acc[jj] * __expf(GC[i] - gj); AQT[i * 72 + jc] = (bf16_t)f2bf(val); } }
        }
        LBAR(); PSTAMP(21);
#pragma unroll
        for (int i2 = 0; i2 < 2; ++i2) { const int idx = tid + NTHREADS * i2, i = idx >> 4, c8 = idx & 15; const float e = EG[i];
            const u32x4 w = *(const LAS u32x4*)(QB + i * 136 + c8 * 8); u32x4 o;
            o.x = pk2(bflo(w.x) * e, bfhi(w.x) * e); o.y = pk2(bflo(w.y) * e, bfhi(w.y) * e); o.z = pk2(bflo(w.z) * e, bfhi(w.z) * e); o.w = pk2(bflo(w.w) * e, bfhi(w.w) * e);
            *(u32x4*)((char*)P + ((unsigned)cidx * 131072u + (unsigned)((i * 1024 + h * 128 + c8 * 8) * 2))) = o; }
        { const int dk = tid >> 2, cb = (tid & 3) * 16; const float gl = GC[63];
#pragma unroll
          for (int v = 0; v < 2; ++v) { float t[8];
#pragma unroll
              for (int e = 0; e < 8; ++e) { const int c = cb + v * 8 + e; t[e] = bf2f(KB[c * 136 + dk]) * __expf(gl - GC[c]); }
              u32x4 o; o.x = pk2(t[0], t[1]); o.y = pk2(t[2], t[3]); o.z = pk2(t[4], t[5]); o.w = pk2(t[6], t[7]);
              *(u32x4*)((char*)P + ((unsigned)(PLANE * 2) + (unsigned)cidx * 131072u + (unsigned)((((dk >> 1)) * 1024 + h * 128 + ((dk & 1) << 6) + cb + v * 8) * 2))) = o; } }
        { const int r = tid >> 3, c8 = tid & 7; *(u32x4*)((char*)AQK + ((unsigned)it * 8192u + (unsigned)((r * 64 + c8 * 8) * 2))) = *(const LAS u32x4*)(AQT + r * 72 + c8 * 8); }
        if (tid < 128) DEC[(size_t)it * 128 + tid] = EG[63];
        const bool solver = tid < 256; const bool isu = tid < 128;
        unsigned a_lm = (unsigned)(size_t)LM, a_xu = (unsigned)(size_t)(XU + (tid & 255)), a_nat = (unsigned)(size_t)((isu ? QB : KB) + (tid & 127));
        unsigned a_src = (unsigned)(size_t)(isu ? (VB + (tid & 127)) : (KB + (tid & 127))), a_fac = (unsigned)(size_t)(isu ? BETA : BEG);
        asm volatile("" : "+v"(a_src), "+v"(a_fac), "+v"(a_lm), "+v"(a_xu), "+v"(a_nat));
        LBAR(); PSTAMP(22);
#define GDN_SOLVE_BLOCK(bi) do { float sol_[16]; \
            _Pragma("unroll") for (int r_ = 0; r_ < 16; ++r_) { const int i_ = (bi) * 16 + r_; \
                float v_ = bf2f(*(const LAS bf16_t*)(size_t)(a_src + i_ * 272)) * *(const LAS float*)(size_t)(a_fac + i_ * 4); \
                if ((bi) > 0) v_ -= *(const LAS float*)(size_t)(a_xu + r_ * 1040); \
                _Pragma("unroll") for (int j4_ = 0; j4_ * 4 < r_; ++j4_) { const f32x4 l_ = *(const LAS f32x4*)(size_t)(a_lm + (i_ * 68 + (bi) * 16 + j4_ * 4) * 4); \
                    v_ -= l_[0] * sol_[j4_ * 4]; if (j4_ * 4 + 1 < r_) v_ -= l_[1] * sol_[j4_ * 4 + 1]; if (j4_ * 4 + 2 < r_) v_ -= l_[2] * sol_[j4_ * 4 + 2]; if (j4_ * 4 + 3 < r_) v_ -= l_[3] * sol_[j4_ * 4 + 3]; } \
                sol_[r_] = v_; if ((r_ & 3) == 3) asm volatile("" ::: "memory"); } \
            u32x4 s0_, s1_; s0_.x = pk2(sol_[0], sol_[1]); s0_.y = pk2(sol_[2], sol_[3]); s0_.z = pk2(sol_[4], sol_[5]); s0_.w = pk2(sol_[6], sol_[7]); \
            s1_.x = pk2(sol_[8], sol_[9]); s1_.y = pk2(sol_[10], sol_[11]); s1_.z = pk2(sol_[12], sol_[13]); s1_.w = pk2(sol_[14], sol_[15]); \
            *(LAS u32x4*)(SOLT + tid * 72 + (bi) * 16) = s0_; *(LAS u32x4*)(SOLT + tid * 72 + (bi) * 16 + 8) = s1_; \
            const unsigned w_[8] = {s0_.x, s0_.y, s0_.z, s0_.w, s1_.x, s1_.y, s1_.z, s1_.w}; \
            _Pragma("unroll") for (int r_ = 0; r_ < 16; r_ += 2) { *(LAS bf16_t*)(size_t)(a_nat + ((bi) * 16 + r_) * 272) = (bf16_t)w_[r_ >> 1]; *(LAS bf16_t*)(size_t)(a_nat + ((bi) * 16 + r_ + 1) * 272) = (bf16_t)(w_[r_ >> 1] >> 16); } } while (0)
#define GDN_UPDATE_BLOCK(bi, KK) do { \
            _Pragma("unroll") for (int q2_ = 0; q2_ < 2; ++q2_) { const int nt_ = wave * 2 + q2_; \
                const f32x4 d_ = mm_tile<KK>(LBh + (bi) * 16 * 72, 72, SOLT + nt_ * 16 * 72, 72, (f32x4){0.f, 0.f, 0.f, 0.f}, lane); \
                _Pragma("unroll") for (int jj_ = 0; jj_ < 4; ++jj_) XU[((lane >> 4) * 4 + jj_) * 260 + nt_ * 16 + (lane & 15)] = d_[jj_]; } } while (0)
        if (solver) { GDN_SOLVE_BLOCK(0); }
        LBAR(); PSTAMP(23);
        GDN_UPDATE_BLOCK(1, 32); LBAR(); if (solver) { GDN_SOLVE_BLOCK(1); } LBAR();
        GDN_UPDATE_BLOCK(2, 32); LBAR(); if (solver) { GDN_SOLVE_BLOCK(2); } LBAR();
        GDN_UPDATE_BLOCK(3, 64); LBAR(); if (solver) { GDN_SOLVE_BLOCK(3); } LBAR(); PSTAMP(24);
#undef GDN_SOLVE_BLOCK
#undef GDN_UPDATE_BLOCK
#pragma unroll
        for (int i4 = 0; i4 < 4; ++i4) { const int idx = tid + NTHREADS * i4, arr = idx >> 10, r = (idx >> 4) & 63, c8 = idx & 15;
            const u32x4 w = *(const LAS u32x4*)((arr ? KB : QB) + r * 136 + c8 * 8);
            *(u32x4*)((char*)(arr ? Wpl : (P + 2 * PLANE)) + ((unsigned)cidx * 131072u + (unsigned)((r * 1024 + h * 128 + c8 * 8) * 2))) = w; }
        LBAR(); PSTAMP(25);
    }
#undef GDN_LOADS
}

__device__ __forceinline__ void hgrn_prep(LAS unsigned char* lds, int tid, bf16_t* P, bf16_t* AQK, float* DEC, const float* LBv) {
    asm volatile("" : "+v"(tid));
    const int lane = tid & 63, wave = __builtin_amdgcn_readfirstlane(tid >> 6);
    LAS bf16_t* QH = (LAS bf16_t*)lds; LAS bf16_t* KH = QH + 4 * 16 * 136; LAS float* TOT = (LAS float*)(lds + 14 * 16 * 136 * 2);
    LAS bf16_t* AQT = (LAS bf16_t*)(lds + 14 * 16 * 136 * 2 + 2048);
    const int d = tid & 127, s = tid >> 7;
    const int h = blockIdx.x & 7;
    const float lb = LBv[h * 128 + d];
    bf16_t pq[16], pf[16];
    const char* Pb = (const char*)P; const unsigned PLB = (unsigned)(PLANE * 2);
    const unsigned hq0 = (unsigned)(((s * 16) * 1024 + h * 128 + d) * 2);
#define HG_LOADS(itx) do { const unsigned o_ = hq0 + (unsigned)((itx) >> 3) * 131072u; \
        _Pragma("unroll") for (int r_ = 0; r_ < 16; ++r_) { pq[r_] = *(const bf16_t*)(Pb + (o_ + 2048u * r_)); pf[r_] = *(const bf16_t*)(Pb + (PLB + o_ + 2048u * r_)); } } while (0)
    if ((int)blockIdx.x < NITEM) HG_LOADS((int)blockIdx.x);
    int it_prev = -1;
    for (int it = blockIdx.x; it < NITEM; it += gridDim.x) {
        const int cidx = it >> 3; const size_t row0 = (size_t)cidx * 64;
        float qv[16], kv[16], gl[16]; float run = 0.f;
        const unsigned qo = hq0 + (unsigned)cidx * 131072u;
#pragma unroll
        for (int r = 0; r < 16; ++r) { const float qraw = bf2f(pq[r]), fraw = bf2f(pf[r]);
            const float ef = __expf(-fraw); const float sg = frcp_(1.0f + ef); const float ft = lb + (1.0f - lb) * sg; run += __logf(ft); gl[r] = run;
            kv[r] = (1.0f - lb) * ef * sg; qv[r] = siluf_(qraw) * 0.08838834764831845f; }
        { const int itn = it + (int)gridDim.x; if (itn < NITEM) HG_LOADS(itn); }
        if (it_prev >= 0) { const int r = tid >> 3, c8 = tid & 7;
            *(u32x4*)((char*)AQK + ((unsigned)it_prev * 8192u + (unsigned)((r * 64 + c8 * 8) * 2))) = *(const LAS u32x4*)(AQT + r * 72 + c8 * 8); }
        TOT[s * 128 + d] = run;
        LBAR();
        const float t0 = TOT[d], t1 = TOT[128 + d], t2 = TOT[256 + d], t3 = TOT[384 + d];
        const float gb = (s > 0 ? t0 : 0.f) + (s > 1 ? t1 : 0.f) + (s > 2 ? t2 : 0.f); const float glast = (t0 + t1) + (t2 + t3);
        const float egb = __expf(gb), ekd = __expf(glast - gb);
#pragma unroll
        for (int r = 0; r < 16; ++r) { const float ep = __expf(gl[r]); gl[r] = frcp_(ep); qv[r] *= ep; kv[r] *= gl[r]; }
#pragma unroll
        for (int r = 0; r < 16; r += 2) { const unsigned w = pk2(qv[r] * egb, qv[r + 1] * egb); *(bf16_t*)((char*)P + (qo + 2048u * r)) = (bf16_t)w; *(bf16_t*)((char*)P + (qo + 2048u * (r + 1))) = (bf16_t)(w >> 16); }
        { u32x4 o0, o1; o0.x = pk2(kv[0] * ekd, kv[1] * ekd); o0.y = pk2(kv[2] * ekd, kv[3] * ekd); o0.z = pk2(kv[4] * ekd, kv[5] * ekd); o0.w = pk2(kv[6] * ekd, kv[7] * ekd);
          o1.x = pk2(kv[8] * ekd, kv[9] * ekd); o1.y = pk2(kv[10] * ekd, kv[11] * ekd); o1.z = pk2(kv[12] * ekd, kv[13] * ekd); o1.w = pk2(kv[14] * ekd, kv[15] * ekd);
          bf16_t* kd = (bf16_t*)((char*)P + (PLB + (unsigned)cidx * 131072u + (unsigned)((((d >> 1)) * 1024 + h * 128 + ((d & 1) << 6) + s * 16) * 2)));
          *(u32x4*)kd = o0; *(u32x4*)(kd + 8) = o1; }
        if (s == 0) DEC[(size_t)it * 128 + d] = __expf(glast);
#pragma unroll
        for (int r = 0; r < 16; r += 2) { const unsigned w = pk2(qv[r], qv[r + 1]); QH[(s * 16 + r) * 136 + d] = (bf16_t)w; QH[(s * 16 + r + 1) * 136 + d] = (bf16_t)(w >> 16); }
#pragma unroll
        for (int st = 0; st < 4; ++st) {
            if (st >= s) {
                float off = 0.f;
                if (st > s) { if (s <= 0 && 0 < st) off += t0; if (s <= 1 && 1 < st) off += t1; if (s <= 2 && 2 < st) off += t2; }
                const float eo = __expf(off); const int pidx = st * (st + 1) / 2 + s;
#pragma unroll
                for (int r = 0; r < 16; r += 2) { const unsigned w = pk2(kv[r] * eo, kv[r + 1] * eo); KH[(pidx * 16 + r) * 136 + d] = (bf16_t)w; KH[(pidx * 16 + r + 1) * 136 + d] = (bf16_t)(w >> 16); }
            }
        }
        LBAR();
        for (int tile = wave; tile < 16; tile += 8) {
            const int st = tile >> 2, sj = tile & 3; f32x4 acc = (f32x4){0.f, 0.f, 0.f, 0.f};
            if (sj <= st) acc = mm_tile<128>(QH + st * 16 * 136, 136, KH + (st * (st + 1) / 2 + sj) * 16 * 136, 136, acc, lane);
            const int jc = sj * 16 + (lane & 15);
#pragma unroll
            for (int jj = 0; jj < 4; jj += 2) { const int i = st * 16 + (lane >> 4) * 4 + jj;
                const unsigned w = pk2((sj <= st && jc <= i) ? acc[jj] : 0.f, (sj <= st && jc <= i + 1) ? acc[jj + 1] : 0.f);
                AQT[i * 72 + jc] = (bf16_t)w; AQT[(i + 1) * 72 + jc] = (bf16_t)(w >> 16); }
        }
        LBAR();
        it_prev = it;
    }
    if (it_prev >= 0) { const int r = tid >> 3, c8 = tid & 7; *(u32x4*)((char*)AQK + ((unsigned)it_prev * 8192u + (unsigned)((r * 64 + c8 * 8) * 2))) = *(const LAS u32x4*)(AQT + r * 72 + c8 * 8); }
#undef HG_LOADS
}

__device__ __forceinline__ void scan_phase(LAS unsigned char* lds, int tid, bool gdn, bf16_t* P, const bf16_t* Wpl, const bf16_t* AQK, const float* DEC, const float* nw, float* ss_o
#ifdef PROBE_SEL
                                           , unsigned& tacc, unsigned& tprev
#endif
                                           ) {
    if (blockIdx.x >= 128) return;
    asm volatile("" : "+v"(tid));
    const int lane = tid & 63, wave = __builtin_amdgcn_readfirstlane(tid >> 6);
    const int b = blockIdx.x >> 3, h = blockIdx.x & 7;
    LAS bf16_t* ST = (LAS bf16_t*)lds; LAS bf16_t* VNT = (LAS bf16_t*)(lds + 34816); LAS bf16_t* WB = (LAS bf16_t*)(lds + 53248); LAS bf16_t* QD = (LAS bf16_t*)(lds + 70656);
    LAS bf16_t* AQ = (LAS bf16_t*)(lds + 88064); LAS bf16_t* KDT = (LAS bf16_t*)(lds + 97280); LAS float* DECV = (LAS float*)(lds + 115712); LAS float* SSQ = (LAS float*)(lds + 116224);
    const f32x4 Z4 = (f32x4){0.f, 0.f, 0.f, 0.f};
    f32x4 Sacc[8];
#pragma unroll
    for (int nt = 0; nt < 8; ++nt) Sacc[nt] = Z4;
    for (int i = tid; i < 128 * 136 / 2; i += NTHREADS) ((LAS unsigned*)ST)[i] = 0u;
    const int l15 = lane & 15, lq = lane >> 4, mrow = wave * 16 + lq * 4;
    const f32x4 nwv = *(const f32x4*)(nw + (gdn ? 0 : h * 128) + mrow);
    const LAS bf16_t* stf = ST + (wave * 16 + l15) * 136 + lq * 8; const LAS bf16_t* vnf = VNT + (wave * 16 + l15) * 72 + lq * 8;
    const LAS bf16_t* wbf = WB + l15 * 136 + lq * 8; const LAS bf16_t* qdf = QD + l15 * 136 + lq * 8; const LAS bf16_t* aqf = AQ + l15 * 72 + lq * 8; const LAS bf16_t* kdf = KDT + l15 * 72 + lq * 8;
    const int sr0 = tid >> 4, sc8 = tid & 15, ar = tid >> 3, ac8 = tid & 7;
    u32x4 pw[2], pq[2], pk[2], pa; u32x2 pu[4], cu[4], cgt[4]; float pdec = 0.f;
    pw[0] = pw[1] = (u32x4){0u, 0u, 0u, 0u};
    const char* Pb = (const char*)P; const char* Wb = (const char*)Wpl; const char* Ab = (const char*)AQK; const char* Db = (const char*)DEC;
    const unsigned PLB = (unsigned)(PLANE * 2);
    const unsigned go0 = (unsigned)(((b * 32 * 64 + sr0) * 1024 + h * 128 + sc8 * 8) * 2);
    const unsigned gu0 = (unsigned)(((b * 32 * 64 + l15) * 1024 + h * 128 + mrow) * 2);
    const unsigned ga0 = (unsigned)((((b * 32) * 8 + h) * 4096 + ar * 64 + ac8 * 8) * 2);
    const unsigned gd0 = (unsigned)((((b * 32) * 8 + h) * 128 + (tid & 127)) * 4);
#define SCAN_ISSUE(nn) do { const unsigned go_ = go0 + (unsigned)(nn) * 131072u, gu_ = gu0 + (unsigned)(nn) * 131072u; \
        _Pragma("unroll") for (int i_ = 0; i_ < 2; ++i_) { \
            if (gdn) pw[i_] = *(const u32x4*)(Wb + (go_ + 65536u * i_)); pq[i_] = *(const u32x4*)(Pb + (go_ + 65536u * i_)); pk[i_] = *(const u32x4*)(Pb + (PLB + go_ + 65536u * i_)); } \
        pa = *(const u32x4*)(Ab + (ga0 + (unsigned)(nn) * 65536u)); \
        _Pragma("unroll") for (int nt_ = 0; nt_ < 4; ++nt_) pu[nt_] = *(const u32x2*)(Pb + (2u * PLB + gu_ + 32768u * nt_)); \
        if (tid < 128) pdec = *(const float*)(Db + (gd0 + (unsigned)(nn) * 4096u)); } while (0)
#define SCAN_COMMIT() do { \
        _Pragma("unroll") for (int i_ = 0; i_ < 2; ++i_) { const int r_ = sr0 + 32 * i_; \
            if (gdn) *(LAS u32x4*)(WB + r_ * 136 + sc8 * 8) = pw[i_]; *(LAS u32x4*)(QD + r_ * 136 + sc8 * 8) = pq[i_]; \
            *(LAS u32x4*)(KDT + (r_ * 2 + (sc8 >> 3)) * 72 + (sc8 & 7) * 8) = pk[i_]; } \
        *(LAS u32x4*)(AQ + ar * 72 + ac8 * 8) = pa; if (tid < 128) DECV[tid] = pdec; \
        _Pragma("unroll") for (int nt_ = 0; nt_ < 4; ++nt_) { cu[nt_] = pu[nt_]; } } while (0)
    SCAN_ISSUE(0);
    SCAN_COMMIT();
    __syncthreads();
    for (int n = 0; n < 32; ++n) {
        const size_t row0 = (size_t)(b * 32 + n) * 64;
        if (n < 31) SCAN_ISSUE(n + 1);
#pragma unroll
        for (int nt = 0; nt < 4; ++nt) cgt[nt] = *(const u32x2*)(Pb + (3u * PLB + gu0 + (unsigned)n * 131072u + 32768u * nt));
        bf16x8 sf[4];
#pragma unroll
        for (int k = 0; k < 4; ++k) sf[k] = *(const LAS bf16x8*)(stf + k * 32);
#define SCAN_SB() __builtin_amdgcn_sched_barrier(0)
        __builtin_amdgcn_s_setprio(1);
        f32x4 vn[4];
#pragma unroll
        for (int nt = 0; nt < 4; ++nt) vn[nt] = (f32x4){bflo(cu[nt].x), bfhi(cu[nt].x), bflo(cu[nt].y), bfhi(cu[nt].y)};
        if (gdn) {
#pragma unroll
            for (int hh = 0; hh < 2; ++hh) {
                bf16x8 wf[2][4];
#pragma unroll
                for (int nt = 0; nt < 2; ++nt)
#pragma unroll
                    for (int k = 0; k < 4; ++k) wf[nt][k] = *(const LAS bf16x8*)(wbf + (hh * 2 + nt) * 16 * 136 + k * 32);
                f32x4 acc[2] = {Z4, Z4};
#pragma unroll
                for (int k = 0; k < 4; ++k)
#pragma unroll
                    for (int nt = 0; nt < 2; ++nt) acc[nt] = __builtin_amdgcn_mfma_f32_16x16x32_bf16(sf[k], wf[nt][k], acc[nt], 0, 0, 0);
#pragma unroll
                for (int nt = 0; nt < 2; ++nt) vn[hh * 2 + nt] = vn[hh * 2 + nt] - acc[nt];
                SCAN_SB();
            }
        }
        SCAN_SB();
        bf16x8 qf[2][4];
#pragma unroll
        for (int nt = 0; nt < 2; ++nt)
#pragma unroll
            for (int k = 0; k < 4; ++k) qf[nt][k] = *(const LAS bf16x8*)(qdf + nt * 16 * 136 + k * 32);
#pragma unroll
        for (int nt = 0; nt < 4; ++nt)
#pragma unroll
            for (int jj = 0; jj < 4; jj += 2) { const unsigned w = pk2(vn[nt][jj], vn[nt][jj + 1]); VNT[(mrow + jj) * 72 + nt * 16 + l15] = (bf16_t)w; VNT[(mrow + jj + 1) * 72 + nt * 16 + l15] = (bf16_t)(w >> 16); }
        f32x4 o[4] = {Z4, Z4, Z4, Z4};
#pragma unroll
        for (int k = 0; k < 4; ++k)
#pragma unroll
            for (int nt = 0; nt < 2; ++nt) o[nt] = __builtin_amdgcn_mfma_f32_16x16x32_bf16(sf[k], qf[nt][k], o[nt], 0, 0, 0);
        SCAN_SB();
#pragma unroll
        for (int nt = 0; nt < 2; ++nt)
#pragma unroll
            for (int k = 0; k < 4; ++k) qf[nt][k] = *(const LAS bf16x8*)(qdf + (nt + 2) * 16 * 136 + k * 32);
#pragma unroll
        for (int k = 0; k < 4; ++k)
#pragma unroll
            for (int nt = 0; nt < 2; ++nt) o[nt + 2] = __builtin_amdgcn_mfma_f32_16x16x32_bf16(sf[k], qf[nt][k], o[nt + 2], 0, 0, 0);
        SCAN_SB();
        bf16x8 af[4][2], kf0[4][2]; float dcy[8];
#pragma unroll
        for (int nt = 0; nt < 4; ++nt)
#pragma unroll
            for (int k = 0; k < 2; ++k) { af[nt][k] = *(const LAS bf16x8*)(aqf + nt * 16 * 72 + k * 32); kf0[nt][k] = *(const LAS bf16x8*)(kdf + nt * 16 * 72 + k * 32); }
        LDS_WAIT();
        bf16x8 vf[2];
#pragma unroll
        for (int k = 0; k < 2; ++k) vf[k] = *(const LAS bf16x8*)(vnf + k * 32);
#pragma unroll
        for (int nt = 0; nt < 8; ++nt) { dcy[nt] = DECV[nt * 16 + l15]; Sacc[nt] = Sacc[nt] * dcy[nt]; }
#pragma unroll
        for (int k = 0; k < 2; ++k)
#pragma unroll
            for (int nt = 0; nt < 4; ++nt) { if (k == 0 || nt >= 2) o[nt] = __builtin_amdgcn_mfma_f32_16x16x32_bf16(vf[k], af[nt][k], o[nt], 0, 0, 0);
                Sacc[nt] = __builtin_amdgcn_mfma_f32_16x16x32_bf16(vf[k], kf0[nt][k], Sacc[nt], 0, 0, 0); }
        SCAN_SB();
        {   bf16x8 kf1[4][2];
#pragma unroll
            for (int nt = 0; nt < 4; ++nt)
#pragma unroll
                for (int k = 0; k < 2; ++k) kf1[nt][k] = *(const LAS bf16x8*)(kdf + (nt + 4) * 16 * 72 + k * 32);
#pragma unroll
            for (int k = 0; k < 2; ++k)
#pragma unroll
                for (int nt = 0; nt < 4; ++nt) Sacc[nt + 4] = __builtin_amdgcn_mfma_f32_16x16x32_bf16(vf[k], kf1[nt][k], Sacc[nt + 4], 0, 0, 0); }
#undef SCAN_SB
        __builtin_amdgcn_s_setprio(0);
#pragma unroll
        for (int nt = 0; nt < 4; ++nt) { float q = (o[nt][0] * o[nt][0] + o[nt][1] * o[nt][1]) + (o[nt][2] * o[nt][2] + o[nt][3] * o[nt][3]);
            { const auto r16 = __builtin_amdgcn_permlane16_swap(__float_as_uint(q), __float_as_uint(q), false, false); q = __uint_as_float(r16[0]) + __uint_as_float(r16[1]); }
            { const auto r32 = __builtin_amdgcn_permlane32_swap(__float_as_uint(q), __float_as_uint(q), false, false); q = __uint_as_float(r32[0]) + __uint_as_float(r32[1]); }
            if (lq == 0) SSQ[(nt * 16 + l15) * 8 + wave] = q; }
        LBAR(); PSTAMP(30);
#pragma unroll
        for (int nt = 0; nt < 8; ++nt)
#pragma unroll
            for (int jj = 0; jj < 4; jj += 2) { const unsigned w = pk2(Sacc[nt][jj], Sacc[nt][jj + 1]); ST[(mrow + jj) * 136 + nt * 16 + l15] = (bf16_t)w; ST[(mrow + jj + 1) * 136 + nt * 16 + l15] = (bf16_t)(w >> 16); }
        if (n < 31) SCAN_COMMIT();
#pragma unroll
        for (int nt = 0; nt < 4; ++nt) { const int tok = nt * 16 + l15; float tot = 0.f;
#pragma unroll
            for (int w4 = 0; w4 < 2; ++w4) { const f32x4 pz = *(const LAS f32x4*)(SSQ + tok * 8 + w4 * 4); tot += (pz[0] + pz[1]) + (pz[2] + pz[3]); }
            const float rs = gdn ? rsqrtf(tot * (1.0f / 128.0f) + EPS) : 1.0f;
            const float g0 = bflo(cgt[nt].x), g1 = bfhi(cgt[nt].x), g2 = bflo(cgt[nt].y), g3 = bfhi(cgt[nt].y);
            u32x2 ow; ow.x = pk2(o[nt][0] * rs * nwv[0] * g0, o[nt][1] * rs * nwv[1] * g1); ow.y = pk2(o[nt][2] * rs * nwv[2] * g2, o[nt][3] * rs * nwv[3] * g3);
            *(u32x2*)((char*)P + (3u * PLB + gu0 + (unsigned)n * 131072u + 32768u * nt)) = ow;
            if (!gdn && wave == 0 && lq == 0) ss_o[(row0 + tok) * 8 + h] = tot; }
        LBAR(); PSTAMP(31);
    }
#undef SCAN_ISSUE
#undef SCAN_COMMIT
}

__device__ __forceinline__ void scan_hgrn_split(LAS unsigned char* lds, int tid, bf16_t* P, const bf16_t* AQK, const float* DEC, const float* nw, float* ss_o) {
    asm volatile("" : "+v"(tid));
    const int lane = tid & 63, wave = __builtin_amdgcn_readfirstlane(tid >> 6);
    const int xcd_ = blockIdx.x & 7, kk_ = blockIdx.x >> 3;
    const int chain = (kk_ >> 1) * 8 + xcd_, half = kk_ & 1, b = chain >> 3, h = chain & 7, dv0 = half * 64;
    const int dt = wave & 3, ch = wave >> 2;
    LAS bf16_t* ST = (LAS bf16_t*)lds; LAS bf16_t* VNT = (LAS bf16_t*)(lds + 17408); LAS bf16_t* QD = (LAS bf16_t*)(lds + 35840);
    LAS bf16_t* AQ = (LAS bf16_t*)(lds + 53248); LAS bf16_t* KDT = (LAS bf16_t*)(lds + 62464); LAS float* DECV = (LAS float*)(lds + 80896); LAS float* SSQ = (LAS float*)(lds + 81408);
    LAS float* NWL = (LAS float*)(lds + 82432);
    const f32x4 Z4 = (f32x4){0.f, 0.f, 0.f, 0.f};
    f32x4 Sacc[4];
#pragma unroll
    for (int n4 = 0; n4 < 4; ++n4) Sacc[n4] = Z4;
    for (int i = tid; i < 64 * 136 / 2; i += NTHREADS) ((LAS unsigned*)ST)[i] = 0u;
    if (tid < 64) NWL[tid] = nw[h * 128 + dv0 + tid];
    const int l15 = lane & 15, lq = lane >> 4, mrow = dt * 16 + lq * 4;
    const LAS bf16_t* stf = ST + (dt * 16 + l15) * 136 + lq * 8; const LAS bf16_t* vnf = VNT + (wave * 16 + l15) * 72 + lq * 8;
    const LAS bf16_t* qdf = QD + l15 * 136 + lq * 8; const LAS bf16_t* aqf = AQ + l15 * 72 + lq * 8; const LAS bf16_t* kdf = KDT + l15 * 72 + lq * 8;
    const int sr0 = tid >> 4, sc8 = tid & 15, ar = tid >> 3, ac8 = tid & 7;
    u32x4 pq[2], pk[2], pa; u32x2 pu[4], cu[4], cgt[2]; float pdec = 0.f;
    const char* Pb = (const char*)P; const char* Ab = (const char*)AQK; const char* Db = (const char*)DEC;
    const unsigned PLB = (unsigned)(PLANE * 2);
    const unsigned go0 = (unsigned)(((b * 32 * 64 + sr0) * 1024 + h * 128 + sc8 * 8) * 2);
    const unsigned gu0 = (unsigned)(((b * 32 * 64 + l15) * 1024 + h * 128 + dv0 + mrow) * 2);
    const unsigned ga0 = (unsigned)((((b * 32) * 8 + h) * 4096 + ar * 64 + ac8 * 8) * 2);
    const unsigned gd0 = (unsigned)((((b * 32) * 8 + h) * 128 + (tid & 127)) * 4);
#define HS_ISSUE(nn) do { const unsigned go_ = go0 + (unsigned)(nn) * 131072u, gu_ = gu0 + (unsigned)(nn) * 131072u; \
        _Pragma("unroll") for (int i_ = 0; i_ < 2; ++i_) { pq[i_] = *(const u32x4*)(Pb + (go_ + 65536u * i_)); pk[i_] = *(const u32x4*)(Pb + (PLB + go_ + 65536u * i_)); } \
        pa = *(const u32x4*)(Ab + (ga0 + (unsigned)(nn) * 65536u)); \
        _Pragma("unroll") for (int nt_ = 0; nt_ < 4; ++nt_) pu[nt_] = *(const u32x2*)(Pb + (2u * PLB + gu_ + 32768u * nt_)); \
        if (tid < 128) pdec = *(const float*)(Db + (gd0 + (unsigned)(nn) * 4096u)); } while (0)
#define HS_COMMIT() do { \
        _Pragma("unroll") for (int i_ = 0; i_ < 2; ++i_) { const int r_ = sr0 + 32 * i_; \
            *(LAS u32x4*)(QD + r_ * 136 + sc8 * 8) = pq[i_]; *(LAS u32x4*)(KDT + (r_ * 2 + (sc8 >> 3)) * 72 + (sc8 & 7) * 8) = pk[i_]; } \
        *(LAS u32x4*)(AQ + ar * 72 + ac8 * 8) = pa; if (tid < 128) DECV[tid] = pdec; \
        _Pragma("unroll") for (int nt_ = 0; nt_ < 4; ++nt_) { cu[nt_] = pu[nt_]; } } while (0)
    HS_ISSUE(0);
    HS_COMMIT();
    __syncthreads();
    for (int n = 0; n < 32; ++n) {
        if (n < 31) HS_ISSUE(n + 1);
#pragma unroll
        for (int t2 = 0; t2 < 2; ++t2) cgt[t2] = *(const u32x2*)(Pb + (3u * PLB + gu0 + (unsigned)n * 131072u + 32768u * (ch * 2 + t2)));
        bf16x8 sf[4];
#pragma unroll
        for (int k = 0; k < 4; ++k) sf[k] = *(const LAS bf16x8*)(stf + k * 32);
#pragma unroll
        for (int nt = 0; nt < 4; ++nt) { VNT[(wave * 16 + lq * 4 + 0) * 72 + nt * 16 + l15] = (bf16_t)cu[nt].x; VNT[(wave * 16 + lq * 4 + 1) * 72 + nt * 16 + l15] = (bf16_t)(cu[nt].x >> 16);
            VNT[(wave * 16 + lq * 4 + 2) * 72 + nt * 16 + l15] = (bf16_t)cu[nt].y; VNT[(wave * 16 + lq * 4 + 3) * 72 + nt * 16 + l15] = (bf16_t)(cu[nt].y >> 16); }
        __builtin_amdgcn_s_setprio(1);
        bf16x8 qf[2][4];
#pragma unroll
        for (int t2 = 0; t2 < 2; ++t2)
#pragma unroll
            for (int k = 0; k < 4; ++k) qf[t2][k] = *(const LAS bf16x8*)(qdf + (ch * 2 + t2) * 16 * 136 + k * 32);
        f32x4 o[2] = {Z4, Z4};
#pragma unroll
        for (int k = 0; k < 4; ++k)
#pragma unroll
            for (int t2 = 0; t2 < 2; ++t2) o[t2] = __builtin_amdgcn_mfma_f32_16x16x32_bf16(sf[k], qf[t2][k], o[t2], 0, 0, 0);
        bf16x8 af[2][2], kf[4][2];
#pragma unroll
        for (int k = 0; k < 2; ++k) {
#pragma unroll
            for (int t2 = 0; t2 < 2; ++t2) af[t2][k] = *(const LAS bf16x8*)(aqf + (ch * 2 + t2) * 16 * 72 + k * 32);
#pragma unroll
            for (int n4 = 0; n4 < 4; ++n4) kf[n4][k] = *(const LAS bf16x8*)(kdf + (ch * 4 + n4) * 16 * 72 + k * 32); }
        LDS_WAIT();
        bf16x8 vf[2];
#pragma unroll
        for (int k = 0; k < 2; ++k) vf[k] = *(const LAS bf16x8*)(vnf + k * 32);
#pragma unroll
        for (int n4 = 0; n4 < 4; ++n4) Sacc[n4] = Sacc[n4] * DECV[(ch * 4 + n4) * 16 + l15];
#pragma unroll
        for (int k = 0; k < 2; ++k) {
#pragma unroll
            for (int t2 = 0; t2 < 2; ++t2) { if (k == 0 || ch == 1) o[t2] = __builtin_amdgcn_mfma_f32_16x16x32_bf16(vf[k], af[t2][k], o[t2], 0, 0, 0); }
#pragma unroll
            for (int n4 = 0; n4 < 4; ++n4) Sacc[n4] = __builtin_amdgcn_mfma_f32_16x16x32_bf16(vf[k], kf[n4][k], Sacc[n4], 0, 0, 0); }
        __builtin_amdgcn_s_setprio(0);
#pragma unroll
        for (int t2 = 0; t2 < 2; ++t2) { float q = (o[t2][0] * o[t2][0] + o[t2][1] * o[t2][1]) + (o[t2][2] * o[t2][2] + o[t2][3] * o[t2][3]);
            { const auto r16 = __builtin_amdgcn_permlane16_swap(__float_as_uint(q), __float_as_uint(q), false, false); q = __uint_as_float(r16[0]) + __uint_as_float(r16[1]); }
            { const auto r32 = __builtin_amdgcn_permlane32_swap(__float_as_uint(q), __float_as_uint(q), false, false); q = __uint_as_float(r32[0]) + __uint_as_float(r32[1]); }
            if (lq == 0) SSQ[((ch * 2 + t2) * 16 + l15) * 4 + dt] = q; }
        LBAR();
#pragma unroll
        for (int n4 = 0; n4 < 4; ++n4)
#pragma unroll
            for (int jj = 0; jj < 4; jj += 2) { const unsigned w = pk2(Sacc[n4][jj], Sacc[n4][jj + 1]); ST[(mrow + jj) * 136 + (ch * 4 + n4) * 16 + l15] = (bf16_t)w; ST[(mrow + jj + 1) * 136 + (ch * 4 + n4) * 16 + l15] = (bf16_t)(w >> 16); }
        if (n < 31) HS_COMMIT();
        const f32x4 nwv = *(const LAS f32x4*)(NWL + mrow);
#pragma unroll
        for (int t2 = 0; t2 < 2; ++t2) { const int tok = (ch * 2 + t2) * 16 + l15;
            const float g0 = bflo(cgt[t2].x), g1 = bfhi(cgt[t2].x), g2 = bflo(cgt[t2].y), g3 = bfhi(cgt[t2].y);
            u32x2 ow; ow.x = pk2(o[t2][0] * nwv[0] * g0, o[t2][1] * nwv[1] * g1); ow.y = pk2(o[t2][2] * nwv[2] * g2, o[t2][3] * nwv[3] * g3);
            *(u32x2*)((char*)P + (3u * PLB + gu0 + (unsigned)n * 131072u + 32768u * (ch * 2 + t2))) = ow;
            if (dt == 0 && lq == 0) { const f32x4 pz = *(const LAS f32x4*)(SSQ + tok * 4); ss_o[((size_t)(b * 32 + n) * 64 + tok) * 16 + h * 2 + half] = (pz[0] + pz[1]) + (pz[2] + pz[3]); } }
        LBAR();
    }
#undef HS_ISSUE
#undef HS_COMMIT
}

#define BUILD_RSTD_TABLE(S_, ssp_, pm_a_, pm_b_) do { \
        pm_a_ = -1; pm_b_ = -1; \
        for (int i_ = 0; i_ < 64; ++i_) { pg8::Unit u_; if (!(S_).next(i_, u_)) break; if (pm_a_ < 0) pm_a_ = u_.pm; else if (u_.pm != pm_a_ && pm_b_ < 0) pm_b_ = u_.pm; } \
        int t_ = tid; asm volatile("" : "+v"(t_)); \
        { const int k_ = t_ >> 8, r_ = t_ & 255; const int pm_ = k_ ? pm_b_ : pm_a_; ((LAS float*)(lds + 131072))[t_] = (pm_ >= 0) ? pg8::row_rstd16(ssp_, pm_ * 256 + r_) : 0.f; } \
        __syncthreads(); } while (0)
#define BUILD_RSTD8_TABLE(S_, ssp_, pm_a_, pm_b_) do { \
        pm_a_ = -1; pm_b_ = -1; \
        for (int i_ = 0; i_ < 64; ++i_) { pg8::Unit u_; if (!(S_).next(i_, u_)) break; if (pm_a_ < 0) pm_a_ = u_.pm; else if (u_.pm != pm_a_ && pm_b_ < 0) pm_b_ = u_.pm; } \
        int t_ = tid; asm volatile("" : "+v"(t_)); \
        { const int k_ = t_ >> 8, r_ = t_ & 255; const int pm_ = k_ ? pm_b_ : pm_a_; ((LAS float*)(lds + 131072))[t_] = (pm_ >= 0) ? pg8::row_rstd16(ssp_, pm_ * 256 + r_) : 0.f; } \
        __syncthreads(); } while (0)

__global__ void __launch_bounds__(NTHREADS, 2) mega_fwd(Args a) {
    extern __shared__ __attribute__((aligned(16))) unsigned char lds_raw[];
    LAS unsigned char* lds = (LAS unsigned char*)lds_raw;
    cg::grid_group grid = cg::this_grid();
    const int tid = threadIdx.x;
    unsigned char* ws = a.ws;
    float* SSA = (float*)(ws + WS_SSA); float* SSB = (float*)(ws + WS_SSB); float* SSO = (float*)(ws + WS_SSO); bf16_t* P = (bf16_t*)(ws + WS_PROJ); bf16_t* HB = (bf16_t*)(ws + WS_HB); bf16_t* AQK = (bf16_t*)(ws + WS_AQK);
    bf16_t* HALO = (bf16_t*)(ws + WS_HALO); float* AB = (float*)(ws + WS_AB); float* DEC = (float*)(ws + WS_DEC);
    const float* x = a.in[0]; float* out = a.out;
    const int G = gridDim.x;

    volatile LAS unsigned* misc = (volatile LAS unsigned*)(lds + LDS_BYTES - 16);
    if (tid < 4) misc[tid] = 0u;
    __syncthreads();
    const XcdBarrier bar = xcd_barrier_post((unsigned*)ws, misc);
#define GRID_BAR() do { XcdBarrier b2_ = bar; asm volatile("" : "+s"(b2_.x), "+s"(b2_.bar)); xcd_barrier(b2_); } while (0)
#ifdef PROBE_SEL
    unsigned tacc = 0u, tprev = (unsigned)__builtin_amdgcn_s_memrealtime();
#define STAMP(k) do { const unsigned t_ = (unsigned)__builtin_amdgcn_s_memrealtime(); if ((k) == PROBE_SEL) tacc += t_ - tprev; tprev = t_; } while (0)
#else
#define STAMP(k) do {} while (0)
#endif

    prologue(a, lds, tid);
    if (a.out == nullptr) grid.sync();
    GRID_BAR(); STAMP(0);

    for (int i = 0; i < 4; ++i) {
        const int j = i >> 1; const bool gdn = (i & 1) == 0;
        {
            const bf16_t* Bt = gdn ? (const bf16_t*)(ws + WS_WGI) + (size_t)j * GDN_NPAD * 1024 : (const bf16_t*)(ws + WS_WHI) + (size_t)j * 4096 * 1024;
            pg8::Gemm g{HB, Bt, M_TOK, 4096, 1024}; pg8::StaticOrder S; S.init(M_TOK, 4096, G, (int)blockIdx.x);
            int pm_a, pm_b; BUILD_RSTD_TABLE(S, SSB, pm_a, pm_b);
            pg8::EpiProj E{P, PLANE, SSB, gdn ? AB : nullptr, gdn ? HALO : nullptr, (const LAS float*)(lds + 131072), pm_a, pm_b};
            pg8::gemm_phase<pg8::EpiProj, pg8::StaticOrder, true, true>(lds, g, S, E);
            if (gdn) {
                int t2 = tid; asm volatile("" : "+v"(t2));
                const int lane = t2 & 63, l15 = lane & 15, lq = lane >> 4;
                for (int rt = (int)blockIdx.x * NWAVES + (t2 >> 6); rt < M_TOK / 16; rt += G * NWAVES) {
                    const bf16_t* ap = HB + (size_t)(rt * 16 + l15) * 1024 + lq * 8; const bf16_t* bp = Bt + (size_t)(4096 + l15) * 1024 + lq * 8;
                    f32x4 acc = (f32x4){0.f, 0.f, 0.f, 0.f};
#pragma unroll 8
                    for (int k0 = 0; k0 < 1024; k0 += 32) acc = __builtin_amdgcn_mfma_f32_16x16x32_bf16(*(const bf16x8*)(ap + k0), *(const bf16x8*)(bp + k0), acc, 0, 0, 0);
#pragma unroll
                    for (int jj = 0; jj < 4; ++jj) { const int row = rt * 16 + lq * 4 + jj; AB[(size_t)row * 16 + l15] = acc[jj] * pg8::row_rstd16(SSB, row); }
                }
            }
        }
        GRID_BAR(); STAMP(1);
        if (gdn) gdn_prep(lds, tid, P, (bf16_t*)out, AQK, HALO, AB, DEC, a.in[2] + (size_t)j * 4 * 3072, a.in[3] + j * 8, a.in[4] + j * 8
#ifdef PROBE_SEL
                          , tacc, tprev
#endif
                          );
        else hgrn_prep(lds, tid, P, AQK, DEC, (const float*)(ws + WS_LB) + j * 1024);
        GRID_BAR(); if (gdn) STAMP(2); else STAMP(3);
        if (!gdn) scan_hgrn_split(lds, tid, P, AQK, DEC, a.in[9] + j * 1024, SSO);
        else {
        if (blockIdx.x >= 128) { for (int ii = i; ii < i + 2; ++ii) convert_layer_weights(a, lds, tid, ii, (G - 128) * NWAVES); }
        scan_phase(lds, tid, gdn, P, (const bf16_t*)out, AQK, DEC, gdn ? a.in[5] + j * 128 : a.in[9] + j * 1024, SSO
#ifdef PROBE_SEL
                   , tacc, tprev
#endif
                   );
        }
        GRID_BAR(); if (gdn) STAMP(4); else STAMP(5);
        {
            const bf16_t* Bt = gdn ? (const bf16_t*)(ws + WS_WGO) + (size_t)j * 1024 * 1024 : (const bf16_t*)(ws + WS_WHO) + (size_t)j * 1024 * 1024;
            pg8::Gemm g{P + 3 * PLANE, Bt, M_TOK, 1024, 1024}; pg8::StaticOrder S; S.init(M_TOK, 1024, G, (int)blockIdx.x);
            int pm_a = -1, pm_b = -1; if (!gdn) BUILD_RSTD8_TABLE(S, SSO, pm_a, pm_b);
            pg8::EpiRes E{HB, SSA, gdn ? nullptr : SSO, (const LAS float*)(lds + 131072), pm_a, pm_b};
            pg8::gemm_phase<pg8::EpiRes, pg8::StaticOrder, true, true>(lds, g, S, E);
        }
        GRID_BAR(); STAMP(6);
        {
            pg8::Gemm g{HB, (const bf16_t*)(ws + WS_WUP) + (size_t)i * 4096 * 1024, M_TOK, 4096, 1024}; pg8::StaticOrder S; S.init(M_TOK, 4096, G, (int)blockIdx.x);
            int pm_a, pm_b; BUILD_RSTD_TABLE(S, SSA, pm_a, pm_b);
            pg8::EpiUp E{P, SSA, (const LAS float*)(lds + 131072), pm_a, pm_b};
            pg8::gemm_phase<pg8::EpiUp, pg8::StaticOrder, true, true>(lds, g, S, E);
        }
        GRID_BAR(); STAMP(7);
        {
            pg8::Gemm g{P, (const bf16_t*)(ws + WS_WDN) + (size_t)i * 1024 * 4096, M_TOK, 1024, 4096}; pg8::StaticOrder S; S.init(M_TOK, 1024, G, (int)blockIdx.x);
            pg8::EpiRes E{HB, SSB, nullptr, (const LAS float*)(lds + 131072), -1, -1};
            pg8::gemm_phase<pg8::EpiRes, pg8::StaticOrder, true, true>(lds, g, S, E);
        }
        GRID_BAR(); STAMP(8);
    }
    {
        int t3 = tid; asm volatile("" : "+v"(t3));
        const int lane = t3 & 63, wave = t3 >> 6; const int gw = blockIdx.x * NWAVES + wave, NGW = G * NWAVES;
        const f32x4* nf = (const f32x4*)a.in[15] + 2 * lane;
        f32x4 wv[4];
#pragma unroll
        for (int jx = 0; jx < 2; ++jx) { wv[2 * jx] = nf[128 * jx]; wv[2 * jx + 1] = nf[128 * jx + 1]; }
        for (int m = gw; m < M_TOK; m += NGW) {
            const float rs = pg8::row_rstd16(SSB, m); const u32x4* hr = (const u32x4*)(HB + (size_t)m * DMODEL) + lane; f32x4* o = (f32x4*)(out + (size_t)m * DMODEL) + 2 * lane;
#pragma unroll
            for (int jx = 0; jx < 2; ++jx) { const u32x4 hw = hr[64 * jx];
                const f32x4 h0 = (f32x4){bflo(hw.x), bfhi(hw.x), bflo(hw.y), bfhi(hw.y)}, h1 = (f32x4){bflo(hw.z), bfhi(hw.z), bflo(hw.w), bfhi(hw.w)};
                o[128 * jx] = h0 * rs * wv[2 * jx]; o[128 * jx + 1] = h1 * rs * wv[2 * jx + 1]; }
        }
    }
#ifdef PROBE_SEL
    STAMP(9);
    __syncthreads();
    if (blockIdx.x == 0 && tid == 0) { __builtin_amdgcn_s_waitcnt(0); out[0] += 0.02f * rintf((float)tacc * 0.001f); }
#endif
}

extern "C" void kernel_launch(void* const* d_in, const int* in_sizes, int n_in, void* d_out, int out_size, void* d_ws, size_t ws_size, hipStream_t stream) {
    static int grid = 0;
    if (grid == 0) {
        if (n_in != 16 || out_size != M_TOK * DMODEL || ws_size < WS_END) { fprintf(stderr, "kernel_launch: unexpected shapes (n_in %d, out %d, ws %zu; need ws >= %zu)\n", n_in, out_size, ws_size, (size_t)WS_END); grid = -1; return; }
        int dev = 0, cus = 0, per_cu = 0;
        (void)hipGetDevice(&dev); (void)hipDeviceGetAttribute(&cus, hipDeviceAttributeMultiprocessorCount, dev);
        (void)hipFuncSetAttribute((const void*)mega_fwd, hipFuncAttributeMaxDynamicSharedMemorySize, LDS_BYTES);
        if (hipOccupancyMaxActiveBlocksPerMultiprocessor(&per_cu, (const void*)mega_fwd, NTHREADS, LDS_BYTES) != hipSuccess || per_cu < 1) per_cu = 1;
        (void)hipGetLastError();
        grid = cus * (per_cu > 1 ? 1 : per_cu);
        if (grid <= 0) grid = 256;
    }
    if (grid < 0) return;
    Args a{};
    for (int i = 0; i < 16; ++i) a.in[i] = (const float*)d_in[i];
    a.out = (float*)d_out; a.ws = (unsigned char*)d_ws;
    (void)hipMemsetAsync(d_ws, 0, 16384, stream);
    void* args[] = {&a};
    hipError_t e = hipLaunchCooperativeKernel((const void*)mega_fwd, dim3(grid), dim3(NTHREADS), args, LDS_BYTES, stream);
    if (e != hipSuccess) fprintf(stderr, "cooperative launch failed: %s (grid %d)\n", hipGetErrorString(e), grid);
}
```

```cpp
#include <hip/hip_runtime.h>
#include <hip/hip_cooperative_groups.h>
#include <cstdio>
#include <cstdint>
namespace cg = cooperative_groups;
namespace pg8 {
#define PG8_LAS __attribute__((address_space(3)))
typedef unsigned short bf16_t;
typedef short bf16x8 __attribute__((ext_vector_type(8)));
typedef float f32x4 __attribute__((ext_vector_type(4)));
typedef unsigned u32x4 __attribute__((ext_vector_type(4)));
constexpr int BM = 256, BK = 64, HALF = 128, HTB = HALF * BK * 2  , STAGE_BYTES = 8 * HTB, NXCD = 8, WGM = 8;

__host__ __device__ __forceinline__ int lds_byte(int r, int c) { const int st = (r >> 4) * 2 + (c >> 5), rr = r & 15, cc = c & 31, ob = rr * 64 + cc * 2; return st * 1024 + (ob ^ (((ob >> 9) & 1) << 5)); }
__host__ __device__ __forceinline__ void stage_rc(int b, int& R, int& C) { const int st = b / 1024, sb = b % 1024, swz = sb ^ (((sb >> 9) & 1) << 5); R = (st >> 1) * 16 + swz / 64; C = (st & 1) * 32 + (swz % 64) / 2; }
__host__ __device__ __forceinline__ int perm32(int rho) { const int n = rho >> 4, i = rho & 15; return 8 * (i >> 2) + 4 * n + (i & 3); }

struct Unit { int pm, pn; };
struct Gemm { const bf16_t* A; const bf16_t* Bt; int M, N, K; };

struct StaticOrder {
    int nM, nN, nwg, G, c;
    __host__ __device__ void init(int M, int N, int G_, int c_) { nM = M / BM; nN = N / BM; nwg = nM * nN; G = G_; c = c_; }
    __host__ __device__ bool next(int i, Unit& u) const {
        const long L = (long)i * G + c; if (L >= nwg) return false;
        int wgid = (int)L; { const int q = nwg / NXCD, r = nwg % NXCD, xcd = wgid % NXCD, off = wgid / NXCD; wgid = (xcd < r ? xcd * (q + 1) : r * (q + 1) + (xcd - r) * q) + off; }
        const int nig = WGM * nN, gid = wgid / nig, fm = gid * WGM, gsz = (nM - fm) < WGM ? (nM - fm) : WGM;
        u.pm = fm + ((wgid % nig) % gsz); u.pn = (wgid % nig) / gsz; return true;
    }
    __device__ __forceinline__ void a_ready(const Unit&) const {}
    __device__ __forceinline__ void done(const Unit&) const {}
};


__device__ __forceinline__ unsigned cvt_pk_bf16(float lo, float hi) { unsigned r; asm volatile("v_cvt_pk_bf16_f32 %0, %1, %2" : "=v"(r) : "v"(lo), "v"(hi)); return r; }
constexpr float RMS_EPS = 1e-6f;
__device__ __forceinline__ float row_rstd16(const float* ssp, int row) {
    const f32x4* p = (const f32x4*)(ssp + (size_t)row * 16); const f32x4 a = p[0], b = p[1], c = p[2], d = p[3];
    const float s = (((a[0] + a[1]) + (a[2] + a[3])) + ((b[0] + b[1]) + (b[2] + b[3]))) + (((c[0] + c[1]) + (c[2] + c[3])) + ((d[0] + d[1]) + (d[2] + d[3])));
    return rsqrtf(s * (1.0f / 1024.0f) + RMS_EPS);
}
__device__ __forceinline__ float row_rstd8(const float* ssp, int row) {
    const f32x4* p = (const f32x4*)(ssp + (size_t)row * 8); const f32x4 a = p[0], b = p[1];
    const float s = ((a[0] + a[1]) + (a[2] + a[3])) + ((b[0] + b[1]) + (b[2] + b[3]));
    return rsqrtf(s * (1.0f / 1024.0f) + RMS_EPS);
}

struct EpiProj {
    static constexpr bool PERM = true, AFTER_DRAIN = false;
    bf16_t* O; size_t plane_stride; const float* ss; float* AB; bf16_t* halo; const PG8_LAS float* rs_tab; int pm_a, pm_b;
    __device__ __forceinline__ void operator()(const f32x4 (&acc)[2][2][4][2], const Unit& u, int wr, int wc, int fr, int fq) const {
        const int tsel = (u.pm == pm_a) ? 0 : ((u.pm == pm_b) ? 256 : -1);
        const int row0 = u.pm * BM + wr * 64 + fr; const int colt = u.pn * BM;
        if (colt >= 4096) {
            if (wc == 0 && fq < 2) {
#pragma unroll
                for (int ai = 0; ai < 2; ++ai)
#pragma unroll
                    for (int m = 0; m < 4; ++m) { const int row = row0 + ai * HALF + m * 16; const float rs = row_rstd16(ss, row);
#pragma unroll
                        for (int n = 0; n < 2; ++n) { const f32x4 v = acc[ai][0][m][n] * rs; *(f32x4*)(AB + (size_t)row * 16 + 8 * fq + 4 * n) = v; } }
            }
            return;
        }
        const int plane = colt >> 10; bf16_t* base = O + (size_t)plane * plane_stride; const int col0 = (colt & 1023) + wc * 32 + 8 * fq;
#pragma unroll
        for (int ai = 0; ai < 2; ++ai)
#pragma unroll
            for (int m = 0; m < 4; ++m) { const int row = row0 + ai * HALF + m * 16; const float rs = (tsel >= 0) ? rs_tab[tsel + (row & 255)] : row_rstd16(ss, row);
                bf16_t* rowp = base + (size_t)row * 1024 + col0;
#pragma unroll
                for (int bj = 0; bj < 2; ++bj) { f32x4 v0 = acc[ai][bj][m][0] * rs, v1 = acc[ai][bj][m][1] * rs;
                    if (plane == 3) {
#pragma unroll
                        for (int e = 0; e < 4; ++e) { v0[e] = v0[e] * __builtin_amdgcn_rcpf(1.0f + __expf(-v0[e])); v1[e] = v1[e] * __builtin_amdgcn_rcpf(1.0f + __expf(-v1[e])); } }
                    u32x4 w; w.x = cvt_pk_bf16(v0[0], v0[1]); w.y = cvt_pk_bf16(v0[2], v0[3]); w.z = cvt_pk_bf16(v1[0], v1[1]); w.w = cvt_pk_bf16(v1[2], v1[3]);
                    *(u32x4*)(rowp + bj * HALF) = w;
                    if (halo != nullptr && plane < 3 && m == 3 && fr >= 13) *(u32x4*)(halo + ((size_t)(row >> 6) * 3 + (fr - 13)) * 3072 + plane * 1024 + col0 + bj * HALF) = w; } }
    }
};
struct EpiUp {
    static constexpr bool PERM = true, AFTER_DRAIN = false;
    bf16_t* O; const float* ss; const PG8_LAS float* rs_tab; int pm_a, pm_b;
    __device__ __forceinline__ void operator()(const f32x4 (&acc)[2][2][4][2], const Unit& u, int wr, int wc, int fr, int fq) const {
        const int tsel = (u.pm == pm_a) ? 0 : ((u.pm == pm_b) ? 256 : -1);
        const int row0 = u.pm * BM + wr * 64 + fr; const int col0 = u.pn * BM + wc * 32 + 8 * fq;
#pragma unroll
        for (int ai = 0; ai < 2; ++ai)
#pragma unroll
            for (int m = 0; m < 4; ++m) { const int row = row0 + ai * HALF + m * 16; const float rs = (tsel >= 0) ? rs_tab[tsel + (row & 255)] : row_rstd16(ss, row);
                bf16_t* rowp = O + (size_t)row * 4096 + col0;
#pragma unroll
                for (int bj = 0; bj < 2; ++bj) { f32x4 v0 = acc[ai][bj][m][0] * rs, v1 = acc[ai][bj][m][1] * rs;
#pragma unroll
                    for (int e = 0; e < 4; ++e) { const float a0 = fmaxf(v0[e], 0.f), a1 = fmaxf(v1[e], 0.f); v0[e] = a0 * a0; v1[e] = a1 * a1; }
                    u32x4 w; w.x = cvt_pk_bf16(v0[0], v0[1]); w.y = cvt_pk_bf16(v0[2], v0[3]); w.z = cvt_pk_bf16(v1[0], v1[1]); w.w = cvt_pk_bf16(v1[2], v1[3]);
                    *(u32x4*)(rowp + bj * HALF) = w; } }
    }
};
struct EpiRes {
    static constexpr bool PERM = true, AFTER_DRAIN = false;
    bf16_t* hb; float* ss_next; const float* rowss; const PG8_LAS float* rs_tab; int pm_a, pm_b;
    __device__ __forceinline__ void operator()(const f32x4 (&acc)[2][2][4][2], const Unit& u, int wr, int wc, int fr_, int fq_) const {
        int fr = fr_, fq = fq_; asm volatile("" : "+v"(fr), "+v"(fq));
        const int tsel = (u.pm == pm_a) ? 0 : ((u.pm == pm_b) ? 256 : -1);
        const int row0 = u.pm * BM + wr * 64 + fr; const int col0 = u.pn * BM + wc * 32 + 8 * fq;
        u32x4 hq[3][2];
#define EPIRES_LD(slot, g_) do { const size_t off_ = (size_t)(row0 + ((g_) >> 2) * HALF + ((g_) & 3) * 16) * 1024 + col0; hq[slot][0] = *(const u32x4*)(hb + off_); hq[slot][1] = *(const u32x4*)(hb + off_ + HALF); } while (0)
        EPIRES_LD(0, 0); EPIRES_LD(1, 1);
#pragma unroll
        for (int g = 0; g < 8; ++g) { const int ai = g >> 2, m = g & 3; const int row = row0 + ai * HALF + m * 16;
            if (g + 2 < 8) EPIRES_LD((g + 2) % 3, g + 2);
            const float sc = rowss ? ((tsel >= 0) ? rs_tab[tsel + (row & 255)] : row_rstd16(rowss, row)) : 1.0f;
            const size_t off = (size_t)row * 1024 + col0; float q = 0.f;
#pragma unroll
            for (int bj = 0; bj < 2; ++bj) { const u32x4 hw = hq[g % 3][bj];
                const f32x4 h0 = (f32x4){__uint_as_float(hw.x << 16), __uint_as_float(hw.x & 0xffff0000u), __uint_as_float(hw.y << 16), __uint_as_float(hw.y & 0xffff0000u)};
                const f32x4 h1 = (f32x4){__uint_as_float(hw.z << 16), __uint_as_float(hw.z & 0xffff0000u), __uint_as_float(hw.w << 16), __uint_as_float(hw.w & 0xffff0000u)};
                const f32x4 v0 = h0 + acc[ai][bj][m][0] * sc, v1 = h1 + acc[ai][bj][m][1] * sc;
                u32x4 w; w.x = cvt_pk_bf16(v0[0], v0[1]); w.y = cvt_pk_bf16(v0[2], v0[3]); w.z = cvt_pk_bf16(v1[0], v1[1]); w.w = cvt_pk_bf16(v1[2], v1[3]);
                *(u32x4*)(hb + off + bj * HALF) = w;
                q += (v0[0] * v0[0] + v0[1] * v0[1]) + (v0[2] * v0[2] + v0[3] * v0[3]) + (v1[0] * v1[0] + v1[1] * v1[1]) + (v1[2] * v1[2] + v1[3] * v1[3]); }
            q += __shfl_xor(q, 16); q += __shfl_xor(q, 32);
            if (fq == 0) ss_next[(size_t)row * 16 + u.pn * 4 + wc] = q;
            asm volatile("" ::: "memory"); }
#undef EPIRES_LD
    }
};

template <class Epi, class Sched, bool ALIGN_EPI = false, bool SP2 = false>
__device__ __forceinline__ void gemm_phase(PG8_LAS unsigned char* lds, const Gemm g, const Sched& S, const Epi& E) {
    int tid = threadIdx.x; asm volatile("" : "+v"(tid));
    const int wid = __builtin_amdgcn_readfirstlane(tid >> 6), lane = tid & 63, wr = wid >> 2, wc = wid & 3, fr = lane & 15, fq = lane >> 4;
    const int K = g.K, nt = K / BK;
    unsigned voffA[2], voffB[2];
#pragma unroll
    for (int i = 0; i < 2; ++i) { int R, C; stage_rc(tid * 16 + i * 8192, R, C); const int Rb = Epi::PERM ? ((R & ~31) + perm32(R & 31)) : R;
        voffA[i] = (unsigned)(R * K + C) * 2u; voffB[i] = (unsigned)(Rb * K + C) * 2u; }
    const size_t kstep = (size_t)(BK * 2);
    const size_t hstep = (size_t)HALF * K * 2;
    const size_t tstep = 2 * hstep;
    const unsigned ldsw = (unsigned)wid * 1024u;
    const int aoff = lds_byte(wr * 64 + fr, fq * 8), boff = lds_byte(wc * 32 + fr, fq * 8);
#define PG8_SA(b, h) (((b) * 2 + (h)) * HTB)
#define PG8_SB(b, h) ((4 + (b) * 2 + (h)) * HTB)
#define PG8_STAGE(bufoff, gbase, voff) do { _Pragma("unroll") for (int _i = 0; _i < 2; ++_i) \
        __builtin_amdgcn_global_load_lds((const unsigned*)((const char*)(gbase) + (voff)[_i]), (PG8_LAS unsigned*)(lds + (bufoff) + ldsw + _i * 8192), 16, 0, 0); } while (0)
#define PG8_LDA(dst, b, h) do { _Pragma("unroll") for (int m = 0; m < 4; ++m) _Pragma("unroll") for (int k = 0; k < 2; ++k) dst[m][k] = *(const PG8_LAS bf16x8*)(lds + PG8_SA(b, h) + aoff + m * 2048 + k * 1024); } while (0)
#define PG8_LDB(dst, b, h) do { _Pragma("unroll") for (int n = 0; n < 2; ++n) _Pragma("unroll") for (int k = 0; k < 2; ++k) dst[n][k] = *(const PG8_LAS bf16x8*)(lds + PG8_SB(b, h) + boff + n * 2048 + k * 1024); } while (0)
#define PG8_MMA(ai, bj, At, Bt) do { __builtin_amdgcn_s_setprio(1); _Pragma("unroll") for (int m = 0; m < 4; ++m) _Pragma("unroll") for (int n = 0; n < 2; ++n) _Pragma("unroll") for (int k = 0; k < 2; ++k) \
        acc[ai][bj][m][n] = __builtin_amdgcn_mfma_f32_16x16x32_bf16(Bt[n][k], At[m][k], acc[ai][bj][m][n], 0, 0, 0); __builtin_amdgcn_s_setprio(0); } while (0)
#define PG8_WAIT_V(n) asm volatile("s_waitcnt vmcnt(" #n ")" ::: "memory")
#define PG8_WAIT_L(n) asm volatile("s_waitcnt lgkmcnt(" #n ")" ::: "memory")
#define PG8_BAR __builtin_amdgcn_s_barrier()
#define PG8_SCHED __builtin_amdgcn_sched_barrier(0)
    Unit cur, nxt; int ui = 0;
    if (!S.next(0, cur)) return;
    f32x4 acc[2][2][4][2];
#pragma unroll
    for (int a = 0; a < 2; ++a)
#pragma unroll
        for (int b = 0; b < 2; ++b)
#pragma unroll
            for (int m = 0; m < 4; ++m)
#pragma unroll
                for (int n = 0; n < 2; ++n) acc[a][b][m][n] = (f32x4){0.f, 0.f, 0.f, 0.f};
    bf16x8 At[4][2], B0[2][2], B1[2][2];
    const char* cA = (const char*)g.A + (size_t)cur.pm * tstep; const char* cB = (const char*)g.Bt + (size_t)cur.pn * tstep;
    S.a_ready(cur);
    if constexpr (SP2) {
        PG8_STAGE(PG8_SB(0, 0), cB, voffB); PG8_STAGE(PG8_SB(0, 1), cB + hstep, voffB); PG8_STAGE(PG8_SA(0, 0), cA, voffA); PG8_STAGE(PG8_SA(0, 1), cA + hstep, voffA);
        if (wr == 1) PG8_BAR;
        PG8_WAIT_V(2); PG8_BAR;
        PG8_STAGE(PG8_SB(1, 0), cB + kstep, voffB); PG8_STAGE(PG8_SA(1, 0), cA + kstep, voffA); PG8_STAGE(PG8_SB(1, 1), cB + hstep + kstep, voffB);
        PG8_WAIT_V(6); PG8_BAR;
    } else {
        PG8_STAGE(PG8_SB(0, 0), cB, voffB); PG8_STAGE(PG8_SA(0, 0), cA, voffA); PG8_STAGE(PG8_SB(0, 1), cB + hstep, voffB); PG8_STAGE(PG8_SA(0, 1), cA + hstep, voffA);
        if (wr == 1) PG8_BAR;
        PG8_WAIT_V(4); PG8_BAR;
        PG8_STAGE(PG8_SB(1, 0), cB + kstep, voffB); PG8_STAGE(PG8_SA(1, 0), cA + kstep, voffA); PG8_STAGE(PG8_SB(1, 1), cB + hstep + kstep, voffB);
        PG8_WAIT_V(6); PG8_BAR;
    }
    for (;;) {
        const bool has_next = S.next(ui + 1, nxt);
        const char* nA = has_next ? (const char*)g.A + (size_t)nxt.pm * tstep : cA; const char* nB = has_next ? (const char*)g.Bt + (size_t)nxt.pn * tstep : cB;
        for (int t = 0; t < nt; t += 2) {
            const bool last = (t == nt - 2);
            const char* a1 = cA + (size_t)(t + 1) * kstep;
            const char* a2 = last ? nA : cA + (size_t)(t + 2) * kstep; const char* b2 = last ? nB : cB + (size_t)(t + 2) * kstep;
            const char* a3 = a2 + kstep; const char* b3 = b2 + kstep;
            if (last && has_next) S.a_ready(nxt);
            if constexpr (SP2) {
            PG8_LDB(B0, 0, 0); PG8_LDB(B1, 0, 1); PG8_SCHED; PG8_LDA(At, 0, 0); PG8_STAGE(PG8_SA(1, 1), a1 + hstep, voffA);
            PG8_WAIT_V(8); PG8_WAIT_L(0); PG8_BAR; PG8_MMA(0, 0, At, B0); PG8_MMA(0, 1, At, B1); PG8_BAR; PG8_SCHED;
            PG8_LDA(At, 0, 1); PG8_STAGE(PG8_SB(0, 0), b2, voffB); PG8_STAGE(PG8_SB(0, 1), b2 + hstep, voffB); PG8_STAGE(PG8_SA(0, 0), a2, voffA);
            PG8_WAIT_V(8); PG8_WAIT_L(0); PG8_BAR; PG8_MMA(1, 0, At, B0); PG8_MMA(1, 1, At, B1); PG8_BAR; PG8_SCHED;
            PG8_LDB(B0, 1, 0); PG8_LDB(B1, 1, 1); PG8_SCHED; PG8_LDA(At, 1, 0); PG8_STAGE(PG8_SA(0, 1), a2 + hstep, voffA);
            PG8_WAIT_V(8); PG8_WAIT_L(0); PG8_BAR; PG8_MMA(0, 0, At, B0); PG8_MMA(0, 1, At, B1); PG8_BAR; PG8_SCHED;
            PG8_LDA(At, 1, 1); PG8_STAGE(PG8_SB(1, 0), b3, voffB); PG8_STAGE(PG8_SB(1, 1), b3 + hstep, voffB); PG8_STAGE(PG8_SA(1, 0), a3, voffA);
            PG8_WAIT_V(8); PG8_WAIT_L(0); PG8_BAR; PG8_MMA(1, 0, At, B0); PG8_MMA(1, 1, At, B1); PG8_BAR; PG8_SCHED;
            } else {
            PG8_LDB(B0, 0, 0); PG8_SCHED; PG8_LDA(At, 0, 0); PG8_STAGE(PG8_SA(1, 1), a1 + hstep, voffA);
            PG8_WAIT_L(8); PG8_BAR; PG8_WAIT_L(0); PG8_MMA(0, 0, At, B0); PG8_BAR; PG8_SCHED;
            PG8_LDB(B1, 0, 1); PG8_STAGE(PG8_SB(0, 0), b2, voffB);
            PG8_BAR; PG8_WAIT_L(0); PG8_MMA(0, 1, At, B1); PG8_BAR;
            PG8_LDA(At, 0, 1); PG8_STAGE(PG8_SA(0, 0), a2, voffA);
            PG8_BAR; PG8_WAIT_L(0); PG8_MMA(1, 0, At, B0); PG8_BAR; PG8_SCHED;
            PG8_STAGE(PG8_SB(0, 1), b2 + hstep, voffB);
            PG8_WAIT_V(6); PG8_BAR; PG8_MMA(1, 1, At, B1); PG8_BAR;
            PG8_LDB(B0, 1, 0); PG8_SCHED; PG8_LDA(At, 1, 0); PG8_STAGE(PG8_SA(0, 1), a2 + hstep, voffA);
            PG8_WAIT_L(8); PG8_BAR; PG8_WAIT_L(0); PG8_MMA(0, 0, At, B0); PG8_BAR; PG8_SCHED;
            PG8_LDB(B1, 1, 1); PG8_STAGE(PG8_SB(1, 0), b3, voffB);
            PG8_BAR; PG8_WAIT_L(0); PG8_MMA(0, 1, At, B1); PG8_BAR;
            PG8_LDA(At, 1, 1); PG8_STAGE(PG8_SA(1, 0), a3, voffA);
            PG8_BAR; PG8_WAIT_L(0); PG8_MMA(1, 0, At, B0); PG8_BAR; PG8_SCHED;
            PG8_STAGE(PG8_SB(1, 1), b3 + hstep, voffB);
            PG8_WAIT_V(6); PG8_BAR; PG8_MMA(1, 1, At, B1); PG8_BAR;
            }
        }
        if constexpr (ALIGN_EPI) { if (wr == 0) PG8_BAR; }
        if constexpr (!Epi::AFTER_DRAIN) { E(acc, cur, wr, wc, fr, fq); S.done(cur); }
        if (!has_next) break;
#pragma unroll
        for (int a = 0; a < 2; ++a)
#pragma unroll
            for (int b = 0; b < 2; ++b)
#pragma unroll
                for (int m = 0; m < 4; ++m)
#pragma unroll
                    for (int n = 0; n < 2; ++n) acc[a][b][m][n] = (f32x4){0.f, 0.f, 0.f, 0.f};
        cur = nxt; cA = nA; cB = nB; ++ui;
        if constexpr (ALIGN_EPI) { if (wr == 1) PG8_BAR; }
    }
    PG8_WAIT_V(0);
    if constexpr (!ALIGN_EPI) { if (wr == 0) PG8_BAR; }
    PG8_BAR;
    if constexpr (Epi::AFTER_DRAIN) { E.fused(acc, cur, wr, wc, fr, fq, lds, wid, lane); S.done(cur); }
#undef PG8_SA
#undef PG8_SB
#undef PG8_STAGE
#undef PG8_LDA
#undef PG8_LDB
#undef PG8_MMA
#undef PG8_WAIT_V
#undef PG8_WAIT_L
#undef PG8_BAR
#undef PG8_SCHED
}
}

#define LAS __attribute__((address_space(3)))
typedef unsigned short bf16_t;
typedef short bf16x8 __attribute__((ext_vector_type(8)));
typedef float f32x4 __attribute__((ext_vector_type(4)));
typedef unsigned u32x4 __attribute__((ext_vector_type(4)));
typedef unsigned u32x2 __attribute__((ext_vector_type(2)));
constexpr int NWAVES = 8, NTHREADS = 512;
constexpr int M_TOK = 32768, DMODEL = 1024, NCH = 512  , NITEM = 4096  ;
constexpr float EPS = 1e-6f;
constexpr size_t MiB = 1u << 20;
constexpr size_t PLANE = (size_t)M_TOK * 1024;
constexpr size_t WS_BAR = 0;
constexpr size_t WS_LB = 1536 * 1024;
constexpr size_t WS_WGI = 2 * MiB, WS_WGO = 19 * MiB, WS_WHI = 23 * MiB, WS_WHO = 39 * MiB, WS_WUP = 43 * MiB, WS_WDN = 75 * MiB;
constexpr size_t WS_PROJ = 108 * MiB;
constexpr size_t WS_HB = 364 * MiB;
constexpr size_t WS_AQK = 428 * MiB;
constexpr size_t WS_HALO = 460 * MiB;
constexpr size_t WS_AB = 470 * MiB;
constexpr size_t WS_DEC = 472 * MiB;
constexpr size_t WS_SSA = 474 * MiB, WS_SSB = 476 * MiB;
constexpr size_t WS_SSO = 478 * MiB;
constexpr size_t WS_END = 480 * MiB;
constexpr int GDN_NPAD = 4352;
constexpr int LDS_BYTES = 147456;

__device__ __forceinline__ float bf2f(unsigned v) { return __uint_as_float(v << 16); }
__device__ __forceinline__ float bflo(unsigned w) { return __uint_as_float(w << 16); }
__device__ __forceinline__ float bfhi(unsigned w) { return __uint_as_float(w & 0xffff0000u); }
__device__ __forceinline__ unsigned f2bf(float f) { unsigned u = __float_as_uint(f); return (u + 0x7fffu + ((u >> 16) & 1u)) >> 16; }
__device__ __forceinline__ unsigned pk2(float lo, float hi) { return pg8::cvt_pk_bf16(lo, hi); }
__device__ __forceinline__ float frcp_(float x) { return __builtin_amdgcn_rcpf(x); }
__device__ __forceinline__ float sigmoidf_(float x) { return frcp_(1.0f + __expf(-x)); }
__device__ __forceinline__ float siluf_(float x) { return x * frcp_(1.0f + __expf(-x)); }
__device__ __forceinline__ float row16_sum(float v);
__device__ __forceinline__ float wave_sum(float v) {
    v = row16_sum(v);
    { const auto r16 = __builtin_amdgcn_permlane16_swap(__float_as_uint(v), __float_as_uint(v), false, false); v = __uint_as_float(r16[0]) + __uint_as_float(r16[1]); }
    { const auto r32 = __builtin_amdgcn_permlane32_swap(__float_as_uint(v), __float_as_uint(v), false, false); v = __uint_as_float(r32[0]) + __uint_as_float(r32[1]); }
    return v;
}
#define LDS_WAIT() asm volatile("s_waitcnt lgkmcnt(0)" ::: "memory")
__device__ __forceinline__ float row16_sum(float v) {
    v += __builtin_bit_cast(float, __builtin_amdgcn_update_dpp(0, __builtin_bit_cast(int, v), 0xB1, 0xF, 0xF, false));
    v += __builtin_bit_cast(float, __builtin_amdgcn_update_dpp(0, __builtin_bit_cast(int, v), 0x4E, 0xF, 0xF, false));
    v += __builtin_bit_cast(float, __builtin_amdgcn_update_dpp(0, __builtin_bit_cast(int, v), 0x141, 0xF, 0xF, false));
    v += __builtin_bit_cast(float, __builtin_amdgcn_update_dpp(0, __builtin_bit_cast(int, v), 0x140, 0xF, 0xF, false));
    return v;
}
#define LBAR() do { asm volatile("s_waitcnt lgkmcnt(0)" ::: "memory"); __builtin_amdgcn_s_barrier(); asm volatile("" ::: "memory"); } while (0)

template <int K> __device__ __forceinline__ f32x4 mm_tile(const LAS bf16_t* A1, int s1, const LAS bf16_t* A2, int s2, f32x4 acc, int lane) {
    const LAS bf16_t* p1 = A1 + (lane & 15) * s1 + (lane >> 4) * 8;
    const LAS bf16_t* p2 = A2 + (lane & 15) * s2 + (lane >> 4) * 8;
#pragma unroll
    for (int k0 = 0; k0 < K; k0 += 32) {
        const bf16x8 a = *(const LAS bf16x8*)(p1 + k0); const bf16x8 b = *(const LAS bf16x8*)(p2 + k0);
        acc = __builtin_amdgcn_mfma_f32_16x16x32_bf16(a, b, acc, 0, 0, 0);
    }
    return acc;
}

#define XB_TMO      128
#define XB_XCNT(j)  (256  + 64 * (j))
#define XB_XSUB(j)  (1280 + 64 * (j))
#define XB_XGEN(j)  (2304 + 64 * (j))
#define XB_TOP      3328
#define XB_TOPGEN   3392
#define XCD_BAR_WORDS 3456
#define XB_SPIN_CAP (1u << 18)

__device__ __forceinline__ unsigned xb_ld(unsigned* p)              { return __hip_atomic_load(p, __ATOMIC_RELAXED, __HIP_MEMORY_SCOPE_AGENT); }
__device__ __forceinline__ unsigned xb_add(unsigned* p, unsigned v) { return __hip_atomic_fetch_add(p, v, __ATOMIC_RELAXED, __HIP_MEMORY_SCOPE_AGENT); }
__device__ __forceinline__ unsigned xb_xcc_id() { return (unsigned)__builtin_amdgcn_s_getreg((3 << 11) | 20) & 0xFu; }
#define XB_SPIN(cond, bar) do { unsigned _sp = 0; while (cond) { __builtin_amdgcn_s_sleep(12); \
    if ((++_sp & 255u) == 0u) { if (xb_ld(&(bar)[XB_TMO])) break; if (_sp > XB_SPIN_CAP) { atomicAdd(&(bar)[XB_TMO], 1u); break; } } } } while (0)

struct XcdBarrier {
    unsigned* bar; unsigned x;
    volatile LAS unsigned* st;
};

__device__ __forceinline__ XcdBarrier xcd_barrier_post(unsigned* bar, volatile LAS unsigned* st) {
    XcdBarrier b; b.bar = bar; b.x = xb_xcc_id(); b.st = st;
    if (threadIdx.x == 0) (void)xb_add(&bar[XB_XCNT(b.x)], 1u);
    return b;
}
__device__ __forceinline__ void xcd_barrier_complete(unsigned* bar, unsigned x, unsigned& nloc, unsigned& nx) {
    const unsigned G = gridDim.x * gridDim.y * gridDim.z;
    unsigned sum, cnt, mine, sp = 0u;
    for (;;) {
        sum = 0u; cnt = 0u; mine = 0u;
#pragma unroll
        for (unsigned j = 0; j < 16; ++j) { const unsigned c = xb_ld(&bar[XB_XCNT(j)]); sum += c; cnt += (c > 0u) ? 1u : 0u; mine = (j == x) ? c : mine; }
        if (sum == G) break;
        __builtin_amdgcn_s_sleep(1);
        if ((++sp & 255u) == 0u) { if (xb_ld(&bar[XB_TMO])) break; if (sp > XB_SPIN_CAP) { atomicAdd(&bar[XB_TMO], 1u); break; } }
    }
    nloc = mine > 0u ? mine : 1u; nx = cnt > 0u ? cnt : 1u;
}

__device__ __forceinline__ void xcd_barrier(const XcdBarrier& b) {
    asm volatile("s_waitcnt vmcnt(0)" ::: "memory");
    __syncthreads();
    if (threadIdx.x == 0) {
        unsigned* bar = b.bar;
        __builtin_amdgcn_s_waitcnt(0);
        unsigned nloc = b.st[0], nx = b.st[1];
        if (nloc == 0u) { xcd_barrier_complete(bar, b.x, nloc, nx); b.st[0] = nloc; b.st[1] = nx; }
        const unsigned old = xb_add(&bar[XB_XSUB(b.x)], 1u);
        const unsigned gen = old / nloc;
        if (old + 1u == (gen + 1u) * nloc) {
            __builtin_amdgcn_fence(__ATOMIC_RELEASE, "agent");
            asm volatile("s_waitcnt vmcnt(0)" ::: "memory");
            const unsigned og = xb_add(&bar[XB_TOP], 1u);
            const unsigned tg = og / nx;
            if (og + 1u == (tg + 1u) * nx) xb_add(&bar[XB_TOPGEN], 1u);
            else XB_SPIN(xb_ld(&bar[XB_TOPGEN]) == tg, bar);
            __builtin_amdgcn_fence(__ATOMIC_ACQUIRE, "agent");
            xb_add(&bar[XB_XGEN(b.x)], 1u);
            asm volatile("s_waitcnt vmcnt(0)" ::: "memory");
        } else {
            XB_SPIN(xb_ld(&bar[XB_XGEN(b.x)]) == gen, bar);
            __builtin_amdgcn_fence(__ATOMIC_ACQUIRE, "agent");
            asm volatile("s_waitcnt vmcnt(0)" ::: "memory");
        }
    }
    __syncthreads();
}
__device__ __forceinline__ void transpose_item(const float* W, int K, int Nsrc, int Npad, const float* nw, bf16_t* WT, LAS float* scr, int item, int lane) {
    const int nblk = Npad / 32, kb = item / nblk, nb = item % nblk, k0 = 64 * kb, n0 = 32 * nb;
    { const int c4 = lane & 7, n = n0 + c4 * 4; f32x4 v[8];
#pragma unroll
      for (int i = 0; i < 8; ++i) { const int kk = 8 * i + (lane >> 3); v[i] = (n < Nsrc) ? *(const f32x4*)(W + (size_t)(k0 + kk) * Nsrc + n) : (f32x4){0.f, 0.f, 0.f, 0.f}; }
#pragma unroll
      for (int i = 0; i < 8; ++i) { const int kk = 8 * i + (lane >> 3); const float sc = nw ? nw[k0 + kk] : 1.0f;
          scr[kk * 33 + c4 * 4 + 0] = v[i][0] * sc; scr[kk * 33 + c4 * 4 + 1] = v[i][1] * sc; scr[kk * 33 + c4 * 4 + 2] = v[i][2] * sc; scr[kk * 33 + c4 * 4 + 3] = v[i][3] * sc; } }
    LDS_WAIT(); asm volatile("" ::: "memory");
    const int c = lane & 7;
#pragma unroll
    for (int j = 0; j < 4; ++j) { const int n = (lane >> 3) + 8 * j; const LAS float* s = scr + (8 * c) * 33 + n;
        u32x4 o; o.x = pk2(s[0 * 33], s[1 * 33]); o.y = pk2(s[2 * 33], s[3 * 33]); o.z = pk2(s[4 * 33], s[5 * 33]); o.w = pk2(s[6 * 33], s[7 * 33]);
        *(u32x4*)(WT + (size_t)(n0 + n) * K + k0 + 8 * c) = o; }
    LDS_WAIT(); asm volatile("" ::: "memory");
}

struct Args { const float* in[16]; float* out; unsigned char* ws; };

__device__ __forceinline__ void convert_layer_weights(const Args& a, LAS unsigned char* lds, int tid, int i, int nworkers) {
    asm volatile("" : "+v"(tid));
    const int worker = ((int)blockIdx.x - 128) * NWAVES + (tid >> 6);
    const int lane = tid & 63, wave = __builtin_amdgcn_readfirstlane(tid >> 6); unsigned char* ws = a.ws; LAS float* scr = (LAS float*)(lds + wave * 16384);
    const int j = i >> 1; const bool gdn = (i & 1) == 0;
    constexpr int I_GI = 16 * (GDN_NPAD / 32), I_SQ = 16 * 32, I_HI = 16 * 128, I_UP = 16 * 128, I_DN = 64 * 32;
    const int n_next = (i == 3) ? 0 : (gdn ? I_HI : I_GI);
    const int total = I_SQ + I_UP + I_DN + n_next;
    for (int it = worker; it < total; it += nworkers) {
        int r = it; const float* W; const float* nw = nullptr; bf16_t* WT; int K = 1024, Nsrc = 1024, Npad = 1024;
        if (r < I_SQ) { W = (gdn ? a.in[6] : a.in[10]) + (size_t)j * 1024 * 1024; WT = (bf16_t*)(ws + (gdn ? WS_WGO : WS_WHO)) + (size_t)j * 1024 * 1024; }
        else if (r < I_SQ + I_UP) { r -= I_SQ; W = a.in[13] + (size_t)i * 1024 * 4096; Nsrc = 4096; Npad = 4096; nw = a.in[12] + i * 1024; WT = (bf16_t*)(ws + WS_WUP) + (size_t)i * 4096 * 1024; }
        else if (r < I_SQ + I_UP + I_DN) { r -= I_SQ + I_UP; W = a.in[14] + (size_t)i * 4096 * 1024; K = 4096; WT = (bf16_t*)(ws + WS_WDN) + (size_t)i * 1024 * 4096; }
        else { r -= I_SQ + I_UP + I_DN; nw = a.in[11] + (size_t)(i + 1) * 1024;
            if (gdn) { W = a.in[7] + (size_t)j * 1024 * 4096; Nsrc = 4096; Npad = 4096; WT = (bf16_t*)(ws + WS_WHI) + (size_t)j * 4096 * 1024; }
            else { W = a.in[1] + (size_t)(j + 1) * 1024 * 4112; Nsrc = 4112; Npad = GDN_NPAD; WT = (bf16_t*)(ws + WS_WGI) + (size_t)(j + 1) * GDN_NPAD * 1024; } }
        transpose_item(W, K, Nsrc, Npad, nw, WT, scr, r, lane);
    }
}

__device__ __forceinline__ void prologue(const Args& a, LAS unsigned char* lds, int tid) {
    asm volatile("" : "+v"(tid));
    const int lane = tid & 63, wave = __builtin_amdgcn_readfirstlane(tid >> 6);
    unsigned char* ws = a.ws;
    LAS float* scr = (LAS float*)(lds + wave * 16384);
    const int gw = blockIdx.x * NWAVES + wave, NGW = gridDim.x * NWAVES;
    const float* gdn_w_in = a.in[1]; const float* norm_mix = a.in[11];
    constexpr int I_GI = 16 * (GDN_NPAD / 32);
    for (int it = gw; it < I_GI; it += NGW) transpose_item(gdn_w_in, 1024, 4112, GDN_NPAD, norm_mix, (bf16_t*)(ws + WS_WGI), scr, it, lane);
    float* SSB = (float*)(ws + WS_SSB); bf16_t* HB = (bf16_t*)(ws + WS_HB); const float* x = a.in[0];
    for (int m = gw; m < M_TOK; m += NGW) {
        const f32x4* xr = (const f32x4*)(x + (size_t)m * DMODEL) + lane; float s = 0.f; f32x4 v[4];
#pragma unroll
        for (int j = 0; j < 4; ++j) { v[j] = xr[64 * j]; s += (v[j][0] * v[j][0] + v[j][1] * v[j][1]) + (v[j][2] * v[j][2] + v[j][3] * v[j][3]); }
        s = wave_sum(s);
        u32x2* o8 = (u32x2*)(HB + (size_t)m * DMODEL) + lane;
#pragma unroll
        for (int j = 0; j < 4; ++j) { u32x2 w; w.x = pk2(v[j][0], v[j][1]); w.y = pk2(v[j][2], v[j][3]); o8[64 * j] = w; }
        if (lane < 16) SSB[(size_t)m * 16 + lane] = (lane == 0) ? s : 0.f;
    }
    if (blockIdx.x == 0) {
        const float* lg = a.in[8]; float* LB = (float*)(ws + WS_LB);
        for (int c = tid; c < 1024; c += NTHREADS) {
            const float l0 = lg[c], l1 = lg[1024 + c], l2 = lg[2048 + c], l3 = lg[3072 + c];
            const float mx = fmaxf(fmaxf(l0, l1), fmaxf(l2, l3));
            const float e0 = expf(l0 - mx), e1 = expf(l1 - mx), e2 = expf(l2 - mx), e3 = expf(l3 - mx); const float inv = 1.0f / (e0 + e1 + e2 + e3);
            LB[c] = e1 * inv; LB[1024 + c] = (e1 + e2 + e3) * inv;
        }
    }
}

__device__ __forceinline__ void gdn_prep(LAS unsigned char* lds, int tid, bf16_t* P, bf16_t* Wpl, bf16_t* AQK, const bf16_t* HALO, const float* AB, float* DEC,
                                         const float* conv_w, const float* a_log, const float* dt_bias
#ifdef PROBE_SEL
                                         , unsigned& tacc, unsigned& tprev
#endif
                                         ) {
#ifdef PROBE_SEL
#define PSTAMP(k) do { const unsigned t_ = (unsigned)__builtin_amdgcn_s_memrealtime(); if ((k) == PROBE_SEL) tacc += t_ - tprev; tprev = t_; } while (0)
#else
#define PSTAMP(k) do {} while (0)
#endif
    asm volatile("" : "+v"(tid));
    const int lane = tid & 63, wave = __builtin_amdgcn_readfirstlane(tid >> 6);
    LAS bf16_t* QB = (LAS bf16_t*)lds; LAS bf16_t* KB = QB + 64 * 136; LAS bf16_t* VB = KB + 64 * 136;
    LAS float* LM = (LAS float*)(lds + 52224);
    LAS float* GC = (LAS float*)(lds + 69632); LAS float* BETA = GC + 64; LAS float* EG = BETA + 64; LAS float* BEG = EG + 64;
    LAS bf16_t* LBh = (LAS bf16_t*)(lds + 70656);
    LAS bf16_t* SOLT = (LAS bf16_t*)(lds + 79872);
    LAS float* XU = (LAS float*)(lds + 116736);
    LAS bf16_t* AQT = (LAS bf16_t*)(lds + 116736);
    LAS float* CW = (LAS float*)(lds + 133376);
    for (int i = tid; i < 256 * 72 / 2; i += NTHREADS) ((LAS unsigned*)SOLT)[i] = 0u;
    const int h = blockIdx.x & 7;
    for (int i = tid; i < 3 * 4 * 128; i += NTHREADS) { const int pp = i >> 9, kk = (i >> 7) & 3, c = i & 127; CW[i] = conv_w[kk * 3072 + pp * 1024 + h * 128 + c]; }
    __syncthreads();
    const float ealog_h = expf(a_log[h]), dtb_h = dt_bias[h];
    u32x4 xa[7], xb[5]; float pav = 0.f, pbv = 0.f; bool za = false; int zb = 0;
#pragma unroll
    for (int r = 0; r < 7; ++r) xa[r] = (u32x4){0u, 0u, 0u, 0u};
#pragma unroll
    for (int r = 0; r < 5; ++r) xb[r] = (u32x4){0u, 0u, 0u, 0u};
#define GDN_LOADS(itx) do { const int cidx_ = (itx) >> 3, n_ = cidx_ & 31; const unsigned cb_ = (unsigned)cidx_ * 131072u; const unsigned PL2_ = (unsigned)(PLANE * 2); \
        const bf16_t* hal_ = HALO + (size_t)(n_ > 0 ? cidx_ - 1 : cidx_) * 3 * 3072 + ch;     \
        _Pragma("unroll") for (int r_ = 0; r_ < 7; ++r_) { const int t_ = segA * 4 - 3 + r_; const bf16_t* q_ = (const bf16_t*)((const char*)P + ((unsigned)pA * PL2_ + cb_ + (unsigned)(((t_ < 0 ? 0 : t_) * 1024 + ch) * 2))); \
            const bf16_t* a_ = (r_ < 3 && t_ < 0) ? hal_ + (size_t)(t_ + 3) * 3072 + pA * 1024 : q_; xa[r_] = *(const u32x4*)a_; } \
        _Pragma("unroll") for (int r_ = 0; r_ < 5; ++r_) { const int t_ = segB * 2 - 3 + r_; const bf16_t* q_ = (const bf16_t*)((const char*)P + (2u * PL2_ + cb_ + (unsigned)(((t_ < 0 ? 0 : t_) * 1024 + ch) * 2))); \
            const bf16_t* a_ = (r_ < 3 && t_ < 0) ? hal_ + (size_t)(t_ + 3) * 3072 + 2 * 1024 : q_; xb[r_] = *(const u32x4*)a_; } \
        za = (n_ == 0 && segA == 0); zb = (n_ == 0) ? (3 - segB * 2) : 0; \
        if (tid >= 448) { pav = AB[((size_t)cidx_ * 64 + lane) * 16 + h]; pbv = AB[((size_t)cidx_ * 64 + lane) * 16 + 8 + h]; } } while (0)
    const int tid_in = tid;
    if ((int)blockIdx.x < NITEM) { const int pA = tid >> 8, segA = (tid >> 4) & 15, segB = tid >> 4, cg8 = tid & 15; const int ch = h * 128 + cg8 * 8; GDN_LOADS((int)blockIdx.x); }
    for (int it = blockIdx.x; it < NITEM; it += gridDim.x) {
        int tid = tid_in; asm volatile("" : "+v"(tid));
        const int lane = tid & 63;
        const int pA = tid >> 8, segA = (tid >> 4) & 15, segB = tid >> 4, cg8 = tid & 15; const int ch = h * 128 + cg8 * 8;
        const int cidx = it >> 3; const size_t row0 = (size_t)cidx * 64;
        {
            typedef float f32x2 __attribute__((ext_vector_type(2)));
#define GDN_CONV_TOKEN(xf_, tt_, y_) do { \
                _Pragma("unroll") for (int e_ = 0; e_ < 4; ++e_) y_[e_] = cw[0][e_] * xf_[(tt_)][e_]; \
                _Pragma("unroll") for (int kk_ = 1; kk_ < 4; ++kk_) _Pragma("unroll") for (int e_ = 0; e_ < 4; ++e_) y_[e_] = cw[kk_][e_] * xf_[(tt_) + kk_][e_] + y_[e_]; \
                _Pragma("unroll") for (int e_ = 0; e_ < 4; ++e_) { f32x2 ex_; ex_.x = __expf(-y_[e_].x); ex_.y = __expf(-y_[e_].y); ex_ = ex_ + 1.0f; f32x2 rc_; rc_.x = frcp_(ex_.x); rc_.y = frcp_(ex_.y); y_[e_] = y_[e_] * rc_; } } while (0)
            f32x2 cw[4][4];
            {
#pragma unroll
                for (int kk = 0; kk < 4; ++kk) { const f32x4 c0 = *(const LAS f32x4*)(CW + (pA * 4 + kk) * 128 + cg8 * 8), c1 = *(const LAS f32x4*)(CW + (pA * 4 + kk) * 128 + cg8 * 8 + 4);
                    cw[kk][0] = (f32x2){c0[0], c0[1]}; cw[kk][1] = (f32x2){c0[2], c0[3]}; cw[kk][2] = (f32x2){c1[0], c1[1]}; cw[kk][3] = (f32x2){c1[2], c1[3]}; }
                f32x2 xf[7][4];
#pragma unroll
                for (int r = 0; r < 7; ++r) { const u32x4 w = (r < 3 && za) ? (u32x4){0u, 0u, 0u, 0u} : xa[r]; xf[r][0] = (f32x2){bflo(w.x), bfhi(w.x)}; xf[r][1] = (f32x2){bflo(w.y), bfhi(w.y)}; xf[r][2] = (f32x2){bflo(w.z), bfhi(w.z)}; xf[r][3] = (f32x2){bflo(w.w), bfhi(w.w)}; }
                LAS bf16_t* dstb = QB + pA * 64 * 136 + cg8 * 8;
#pragma unroll
                for (int tt = 0; tt < 4; ++tt) {
                    f32x2 y[4]; GDN_CONV_TOKEN(xf, tt, y);
                    f32x2 sq = (f32x2){0.f, 0.f};
#pragma unroll
                    for (int e = 0; e < 4; ++e) sq = y[e] * y[e] + sq;
                    const float ssq = row16_sum(sq.x + sq.y);
                    const float rn = rsqrtf(ssq + EPS) * (pA == 0 ? 0.08838834764831845f : 1.0f);
#pragma unroll
                    for (int e = 0; e < 4; ++e) y[e] = y[e] * rn;
                    u32x4 o; o.x = pk2(y[0].x, y[0].y); o.y = pk2(y[1].x, y[1].y); o.z = pk2(y[2].x, y[2].y); o.w = pk2(y[3].x, y[3].y);
                    *(LAS u32x4*)(dstb + (segA * 4 + tt) * 136) = o;
                }
            }
            {
#pragma unroll
                for (int kk = 0; kk < 4; ++kk) { const f32x4 c0 = *(const LAS f32x4*)(CW + (2 * 4 + kk) * 128 + cg8 * 8), c1 = *(const LAS f32x4*)(CW + (2 * 4 + kk) * 128 + cg8 * 8 + 4);
                    cw[kk][0] = (f32x2){c0[0], c0[1]}; cw[kk][1] = (f32x2){c0[2], c0[3]}; cw[kk][2] = (f32x2){c1[0], c1[1]}; cw[kk][3] = (f32x2){c1[2], c1[3]}; }
                f32x2 xf[5][4];
#pragma unroll
                for (int r = 0; r < 5; ++r) { const u32x4 w = (r < 3 && r < zb) ? (u32x4){0u, 0u, 0u, 0u} : xb[r]; xf[r][0] = (f32x2){bflo(w.x), bfhi(w.x)}; xf[r][1] = (f32x2){bflo(w.y), bfhi(w.y)}; xf[r][2] = (f32x2){bflo(w.z), bfhi(w.z)}; xf[r][3] = (f32x2){bflo(w.w), bfhi(w.w)}; }
                LAS bf16_t* dstb = VB + cg8 * 8;
#pragma unroll
                for (int tt = 0; tt < 2; ++tt) {
                    f32x2 y[4]; GDN_CONV_TOKEN(xf, tt, y);
                    u32x4 o; o.x = pk2(y[0].x, y[0].y); o.y = pk2(y[1].x, y[1].y); o.z = pk2(y[2].x, y[2].y); o.w = pk2(y[3].x, y[3].y);
                    *(LAS u32x4*)(dstb + (segB * 2 + tt) * 136) = o;
                }
            }
#undef GDN_CONV_TOKEN
        }
        if (tid >= 448) {
            const float beta = sigmoidf_(pbv); const float xx = pav + dtb_h;
            const float sp = fmaxf(xx, 0.f) + __logf(1.0f + __expf(-fabsf(xx)));
            float g = -ealog_h * sp;
#pragma unroll
            for (int o = 1; o < 64; o <<= 1) { const float v = __shfl_up(g, o); if (lane >= o) g += v; }
            GC[lane] = g; BETA[lane] = beta; { const float eg = __expf(g); EG[lane] = eg; BEG[lane] = beta * eg; }
        }
        { const int itn = it + (int)gridDim.x; if (itn < NITEM) GDN_LOADS(itn); }
        LBAR(); PSTAMP(20);
#pragma unroll
        for (int q4 = 0; q4 < 4; ++q4) {
            const int tt = wave * 4 + q4, sel = tt >> 4, mi = (tt & 15) >> 2, nj = tt & 3;
            f32x4 acc = (f32x4){0.f, 0.f, 0.f, 0.f};
            if (nj <= mi) acc = mm_tile<128>((sel ? QB : KB) + mi * 16 * 136, 136, KB + nj * 16 * 136, 136, acc, lane);
            const int jc = nj * 16 + (lane & 15); const float gj = GC[jc];
#pragma unroll
            for (int jj = 0; jj < 4; ++jj) { const int i = mi * 16 + (lane >> 4) * 4 + jj;
                if (sel == 0) { float val = 0.f; if (jc < i) val = BETA[i] * acc[jj] * __expf(GC[i] - gj); LM[i * 68 + jc] = val; LBh[i * 72 + jc] = (bf16_t)f2bf(nj < mi ? val : 0.f); }
                else { float val = 0.f; if (jc <= i) val = acc[jj] * __expf(GC[i] - gj); AQT[i * 72 + jc] = (bf16_t)f2bf(val); } }
        }
        LBAR(); PSTAMP(21);
#pragma unroll
        for (int i2 = 0; i2 < 2; ++i2) { const int idx = tid + NTHREADS * i2, i = idx >> 4, c8 = idx & 15; const float e = EG[i];
            const u32x4 w = *(const LAS u32x4*)(QB + i * 136 + c8 * 8); u32x4 o;
            o.x = pk2(bflo(w.x) * e, bfhi(w.x) * e); o.y = pk2(bflo(w.y) * e, bfhi(w.y) * e); o.z = pk2(bflo(w.z) * e, bfhi(w.z) * e); o.w = pk2(bflo(w.w) * e, bfhi(w.w) * e);
            *(u32x4*)((char*)P + ((unsigned)cidx * 131072u + (unsigned)((i * 1024 + h * 128 + c8 * 8) * 2))) = o; }
        { const int dk = tid >> 2, cb = (tid & 3) * 16; const float gl = GC[63];
#pragma unroll
          for (int v = 0; v < 2; ++v) { float t[8];
#pragma unroll
              for (int e = 0; e < 8; ++e) { const int c = cb + v * 8 + e; t[e] = bf2f(KB[c * 136 + dk]) * __expf(gl - GC[c]); }
              u32x4 o; o.x = pk2(t[0], t[1]); o.y = pk2(t[2], t[3]); o.z = pk2(t[4], t[5]); o.w = pk2(t[6], t[7]);
              *(u32x4*)((char*)P + ((unsigned)(PLANE * 2) + (unsigned)cidx * 131072u + (unsigned)((((dk >> 1)) * 1024 + h * 128 + ((dk & 1) << 6) + cb + v * 8) * 2))) = o; } }
        { const int r = tid >> 3, c8 = tid & 7; *(u32x4*)((char*)AQK + ((unsigned)it * 8192u + (unsigned)((r * 64 + c8 * 8) * 2))) = *(const LAS u32x4*)(AQT + r * 72 + c8 * 8); }
        if (tid < 128) DEC[(size_t)it * 128 + tid] = EG[63];
        const bool solver = tid < 256; const bool isu = tid < 128;
        unsigned a_lm = (unsigned)(size_t)LM, a_xu = (unsigned)(size_t)(XU + (tid & 255)), a_nat = (unsigned)(size_t)((isu ? QB : KB) + (tid & 127));
        unsigned a_src = (unsigned)(size_t)(isu ? (VB + (tid & 127)) : (KB + (tid & 127))), a_fac = (unsigned)(size_t)(isu ? BETA : BEG);
        asm volatile("" : "+v"(a_src), "+v"(a_fac), "+v"(a_lm), "+v"(a_xu), "+v"(a_nat));
        LBAR(); PSTAMP(22);
#define GDN_SOLVE_BLOCK(bi) do { float sol_[16]; \
            _Pragma("unroll") for (int r_ = 0; r_ < 16; ++r_) { const int i_ = (bi) * 16 + r_; \
                float v_ = bf2f(*(const LAS bf16_t*)(size_t)(a_src + i_ * 272)) * *(const LAS float*)(size_t)(a_fac + i_ * 4); \
                if ((bi) > 0) v_ -= *(const LAS float*)(size_t)(a_xu + r_ * 1040); \
                _Pragma("unroll") for (int j4_ = 0; j4_ * 4 < r_; ++j4_) { const f32x4 l_ = *(const LAS f32x4*)(size_t)(a_lm + (i_ * 68 + (bi) * 16 + j4_ * 4) * 4); \
                    v_ -= l_[0] * sol_[j4_ * 4]; if (j4_ * 4 + 1 < r_) v_ -= l_[1] * sol_[j4_ * 4 + 1]; if (j4_ * 4 + 2 < r_) v_ -= l_[2] * sol_[j4_ * 4 + 2]; if (j4_ * 4 + 3 < r_) v_ -= l_[3] * sol_[j4_ * 4 + 3]; } \
                sol_[r_] = v_; if ((r_ & 3) == 3) asm volatile("" ::: "memory"); } \
            u32x4 s0_, s1_; s0_.x = pk2(sol_[0], sol_[1]); s0_.y = pk2(sol_[2], sol_[3]); s0_.z = pk2(sol_[4], sol_[5]); s0_.w = pk2(sol_[6], sol_[7]); \
            s1_.x = pk2(sol_[8], sol_[9]); s1_.y = pk2(sol_[10], sol_[11]); s1_.z = pk2(sol_[12], sol_[13]); s1_.w = pk2(sol_[14], sol_[15]); \
            *(LAS u32x4*)(SOLT + tid * 72 + (bi) * 16) = s0_; *(LAS u32x4*)(SOLT + tid * 72 + (bi) * 16 + 8) = s1_; \
            const unsigned w_[8] = {s0_.x, s0_.y, s0_.z, s0_.w, s1_.x, s1_.y, s1_.z, s1_.w}; \
            _Pragma("unroll") for (int r_ = 0; r_ < 16; r_ += 2) { *(LAS bf16_t*)(size_t)(a_nat + ((bi) * 16 + r_) * 272) = (bf16_t)w_[r_ >> 1]; *(LAS bf16_t*)(size_t)(a_nat + ((bi) * 16 + r_ + 1) * 272) = (bf16_t)(w_[r_ >> 1] >> 16); } } while (0)
#define GDN_UPDATE_BLOCK(bi, KK) do { \
            _Pragma("unroll") for (int q2_ = 0; q2_ < 2; ++q2_) { const int nt_ = wave * 2 + q2_; \
                const f32x4 d_ = mm_tile<KK>(LBh + (bi) * 16 * 72, 72, SOLT + nt_ * 16 * 72, 72, (f32x4){0.f, 0.f, 0.f, 0.f}, lane); \
                _Pragma("unroll") for (int jj_ = 0; jj_ < 4; ++jj_) XU[((lane >> 4) * 4 + jj_) * 260 + nt_ * 16 + (lane & 15)] = d_[jj_]; } } while (0)
        if (solver) { GDN_SOLVE_BLOCK(0); }
        LBAR(); PSTAMP(23);
        GDN_UPDATE_BLOCK(1, 32); LBAR(); if (solver) { GDN_SOLVE_BLOCK(1); } LBAR();
        GDN_UPDATE_BLOCK(2, 32); LBAR(); if (solver) { GDN_SOLVE_BLOCK(2); } LBAR();
        GDN_UPDATE_BLOCK(3, 64); LBAR(); if (solver) { GDN_SOLVE_BLOCK(3); } LBAR(); PSTAMP(24);
#undef GDN_SOLVE_BLOCK
#undef GDN_UPDATE_BLOCK
#pragma unroll
        for (int i4 = 0; i4 < 4; ++i4) { const int idx = tid + NTHREADS * i4, arr = idx >> 10, r = (idx >> 4) & 63, c8 = idx & 15;
            const u32x4 w = *(const LAS u32x4*)((arr ? KB : QB) + r * 136 + c8 * 8);
            *(u32x4*)((char*)(arr ? Wpl : (P + 2 * PLANE)) + ((unsigned)cidx * 131072u + (unsigned)((r * 1024 + h * 128 + c8 * 8) * 2))) = w; }
        LBAR(); PSTAMP(25);
    }
#undef GDN_LOADS
}

__device__ __forceinline__ void hgrn_prep(LAS unsigned char* lds, int tid, bf16_t* P, bf16_t* AQK, float* DEC, const float* LBv) {
    asm volatile("" : "+v"(tid));
    const int lane = tid & 63, wave = __builtin_amdgcn_readfirstlane(tid >> 6);
    LAS bf16_t* QH = (LAS bf16_t*)lds; LAS bf16_t* KH = QH + 4 * 16 * 136; LAS float* TOT = (LAS float*)(lds + 14 * 16 * 136 * 2);
    LAS bf16_t* AQT = (LAS bf16_t*)(lds + 14 * 16 * 136 * 2 + 2048);
    const int d = tid & 127, s = tid >> 7;
    const int h = blockIdx.x & 7;
    const float lb = LBv[h * 128 + d];
    bf16_t pq[16], pf[16];
    const char* Pb = (const char*)P; const unsigned PLB = (unsigned)(PLANE * 2);
    const unsigned hq0 = (unsigned)(((s * 16) * 1024 + h * 128 + d) * 2);
#define HG_LOADS(itx) do { const unsigned o_ = hq0 + (unsigned)((itx) >> 3) * 131072u; \
        _Pragma("unroll") for (int r_ = 0; r_ < 16; ++r_) { pq[r_] = *(const bf16_t*)(Pb + (o_ + 2048u * r_)); pf[r_] = *(const bf16_t*)(Pb + (PLB + o_ + 2048u * r_)); } } while (0)
    if ((int)blockIdx.x < NITEM) HG_LOADS((int)blockIdx.x);
    int it_prev = -1;
    for (int it = blockIdx.x; it < NITEM; it += gridDim.x) {
        const int cidx = it >> 3; const size_t row0 = (size_t)cidx * 64;
        float qv[16], kv[16], gl[16]; float run = 0.f;
        const unsigned qo = hq0 + (unsigned)cidx * 131072u;
#pragma unroll
        for (int r = 0; r < 16; ++r) { const float qraw = bf2f(pq[r]), fraw = bf2f(pf[r]);
            const float ef = __expf(-fraw); const float sg = frcp_(1.0f + ef); const float ft = lb + (1.0f - lb) * sg; run += __logf(ft); gl[r] = run;
            kv[r] = (1.0f - lb) * ef * sg; qv[r] = siluf_(qraw) * 0.08838834764831845f; }
        { const int itn = it + (int)gridDim.x; if (itn < NITEM) HG_LOADS(itn); }
        if (it_prev >= 0) { const int r = tid >> 3, c8 = tid & 7;
            *(u32x4*)((char*)AQK + ((unsigned)it_prev * 8192u + (unsigned)((r * 64 + c8 * 8) * 2))) = *(const LAS u32x4*)(AQT + r * 72 + c8 * 8); }
        TOT[s * 128 + d] = run;
        LBAR();
        const float t0 = TOT[d], t1 = TOT[128 + d], t2 = TOT[256 + d], t3 = TOT[384 + d];
        const float gb = (s > 0 ? t0 : 0.f) + (s > 1 ? t1 : 0.f) + (s > 2 ? t2 : 0.f); const float glast = (t0 + t1) + (t2 + t3);
        const float egb = __expf(gb), ekd = __expf(glast - gb);
#pragma unroll
        for (int r = 0; r < 16; ++r) { const float ep = __expf(gl[r]); gl[r] = frcp_(ep); qv[r] *= ep; kv[r] *= gl[r]; }
#pragma unroll
        for (int r = 0; r < 16; r += 2) { const unsigned w = pk2(qv[r] * egb, qv[r + 1] * egb); *(bf16_t*)((char*)P + (qo + 2048u * r)) = (bf16_t)w; *(bf16_t*)((char*)P + (qo + 2048u * (r + 1))) = (bf16_t)(w >> 16); }
        { u32x4 o0, o1; o0.x = pk2(kv[0] * ekd, kv[1] * ekd); o0.y = pk2(kv[2] * ekd, kv[3] * ekd); o0.z = pk2(kv[4] * ekd, kv[5] * ekd); o0.w = pk2(kv[6] * ekd, kv[7] * ekd);
          o1.x = pk2(kv[8] * ekd, kv[9] * ekd); o1.y = pk2(kv[10] * ekd, kv[11] * ekd); o1.z = pk2(kv[12] * ekd, kv[13] * ekd); o1.w = pk2(kv[14] * ekd, kv[15] * ekd);
          bf16_t* kd = (bf16_t*)((char*)P + (PLB + (unsigned)cidx * 131072u + (unsigned)((((d >> 1)) * 1024 + h * 128 + ((d & 1) << 6) + s * 16) * 2)));
          *(u32x4*)kd = o0; *(u32x4*)(kd + 8) = o1; }
        if (s == 0) DEC[(size_t)it * 128 + d] = __expf(glast);
#pragma unroll
        for (int r = 0; r < 16; r += 2) { const unsigned w = pk2(qv[r], qv[r + 1]); QH[(s * 16 + r) * 136 + d] = (bf16_t)w; QH[(s * 16 + r + 1) * 136 + d] = (bf16_t)(w >> 16); }
#pragma unroll
        for (int st = 0; st < 4; ++st) {
            if (st >= s) {
                float off = 0.f;
                if (st > s) { if (s <= 0 && 0 < st) off += t0; if (s <= 1 && 1 < st) off += t1; if (s <= 2 && 2 < st) off += t2; }
                const float eo = __expf(off); const int pidx = st * (st + 1) / 2 + s;
#pragma unroll
                for (int r = 0; r < 16; r += 2) { const unsigned w = pk2(kv[r] * eo, kv[r + 1] * eo); KH[(pidx * 16 + r) * 136 + d] = (bf16_t)w; KH[(pidx * 16 + r + 1) * 136 + d] = (bf16_t)(w >> 16); }
            }
        }
        LBAR();
        for (int tile = wave; tile < 16; tile += 8) {
            const int st = tile >> 2, sj = tile & 3; f32x4 acc = (f32x4){0.f, 0.f, 0.f, 0.f};
            if (sj <= st) acc = mm_tile<128>(QH + st * 16 * 136, 136, KH + (st * (st + 1) / 2 + sj) * 16 * 136, 136, acc, lane);
            const int jc = sj * 16 + (lane & 15);
#pragma unroll
            for (int jj = 0; jj < 4; jj += 2) { const int i = st * 16 + (lane >> 4) * 4 + jj;
                const unsigned w = pk2((sj <= st && jc <= i) ? acc[jj] : 0.f, (sj <= st && jc <= i + 1) ? acc[jj + 1] : 0.f);
                AQT[i * 72 + jc] = (bf16_t)w; AQT[(i + 1) * 72 + jc] = (bf16_t)(w >> 16); }
        }
        LBAR();
        it_prev = it;
    }
    if (it_prev >= 0) { const int r = tid >> 3, c8 = tid & 7; *(u32x4*)((char*)AQK + ((unsigned)it_prev * 8192u + (unsigned)((r * 64 + c8 * 8) * 2))) = *(const LAS u32x4*)(AQT + r * 72 + c8 * 8); }
#undef HG_LOADS
}

__device__ __forceinline__ void scan_phase(LAS unsigned char* lds, int tid, bool gdn, bf16_t* P, const bf16_t* Wpl, const bf16_t* AQK, const float* DEC, const float* nw, float* ss_o
#ifdef PROBE_SEL
                                           , unsigned& tacc, unsigned& tprev
#endif
                                           ) {
    if (blockIdx.x >= 128) return;
    asm volatile("" : "+v"(tid));
    const int lane = tid & 63, wave = __builtin_amdgcn_readfirstlane(tid >> 6);
    const int b = blockIdx.x >> 3, h = blockIdx.x & 7;
    LAS bf16_t* ST = (LAS bf16_t*)lds; LAS bf16_t* VNT = (LAS bf16_t*)(lds + 34816); LAS bf16_t* WB = (LAS bf16_t*)(lds + 53248); LAS bf16_t* QD = (LAS bf16_t*)(lds + 70656);
    LAS bf16_t* AQ = (LAS bf16_t*)(lds + 88064); LAS bf16_t* KDT = (LAS bf16_t*)(lds + 97280); LAS float* DECV = (LAS float*)(lds + 115712); LAS float* SSQ = (LAS float*)(lds + 116224);
    const f32x4 Z4 = (f32x4){0.f, 0.f, 0.f, 0.f};
    f32x4 Sacc[8];
#pragma unroll
    for (int nt = 0; nt < 8; ++nt) Sacc[nt] = Z4;
    for (int i = tid; i < 128 * 136 / 2; i += NTHREADS) ((LAS unsigned*)ST)[i] = 0u;
    const int l15 = lane & 15, lq = lane >> 4, mrow = wave * 16 + lq * 4;
    const f32x4 nwv = *(const f32x4*)(nw + (gdn ? 0 : h * 128) + mrow);
    const LAS bf16_t* stf = ST + (wave * 16 + l15) * 136 + lq * 8; const LAS bf16_t* vnf = VNT + (wave * 16 + l15) * 72 + lq * 8;
    const LAS bf16_t* wbf = WB + l15 * 136 + lq * 8; const LAS bf16_t* qdf = QD + l15 * 136 + lq * 8; const LAS bf16_t* aqf = AQ + l15 * 72 + lq * 8; const LAS bf16_t* kdf = KDT + l15 * 72 + lq * 8;
    const int sr0 = tid >> 4, sc8 = tid & 15, ar = tid >> 3, ac8 = tid & 7;
    u32x4 pw[2], pq[2], pk[2], pa; u32x2 pu[4], cu[4], cgt[4]; float pdec = 0.f;
    pw[0] = pw[1] = (u32x4){0u, 0u, 0u, 0u};
    const char* Pb = (const char*)P; const char* Wb = (const char*)Wpl; const char* Ab = (const char*)AQK; const char* Db = (const char*)DEC;
    const unsigned PLB = (unsigned)(PLANE * 2);
    const unsigned go0 = (unsigned)(((b * 32 * 64 + sr0) * 1024 + h * 128 + sc8 * 8) * 2);
    const unsigned gu0 = (unsigned)(((b * 32 * 64 + l15) * 1024 + h * 128 + mrow) * 2);
    const unsigned ga0 = (unsigned)((((b * 32) * 8 + h) * 4096 + ar * 64 + ac8 * 8) * 2);
    const unsigned gd0 = (unsigned)((((b * 32) * 8 + h) * 128 + (tid & 127)) * 4);
#define SCAN_ISSUE(nn) do { const unsigned go_ = go0 + (unsigned)(nn) * 131072u, gu_ = gu0 + (unsigned)(nn) * 131072u; \
        _Pragma("unroll") for (int i_ = 0; i_ < 2; ++i_) { \
            if (gdn) pw[i_] = *(const u32x4*)(Wb + (go_ + 65536u * i_)); pq[i_] = *(const u32x4*)(Pb + (go_ + 65536u * i_)); pk[i_] = *(const u32x4*)(Pb + (PLB + go_ + 65536u * i_)); } \
        pa = *(const u32x4*)(Ab + (ga0 + (unsigned)(nn) * 65536u)); \
        _Pragma("unroll") for (int nt_ = 0; nt_ < 4; ++nt_) pu[nt_] = *(const u32x2*)(Pb + (2u * PLB + gu_ + 32768u * nt_)); \
        if (tid < 128) pdec = *(const float*)(Db + (gd0 + (unsigned)(nn) * 4096u)); } while (0)
#define SCAN_COMMIT() do { \
        _Pragma("unroll") for (int i_ = 0; i_ < 2; ++i_) { const int r_ = sr0 + 32 * i_; \
            if (gdn) *(LAS u32x4*)(WB + r_ * 136 + sc8 * 8) = pw[i_]; *(LAS u32x4*)(QD + r_ * 136 + sc8 * 8) = pq[i_]; \
            *(LAS u32x4*)(KDT + (r_ * 2 + (sc8 >> 3)) * 72 + (sc8 & 7) * 8) = pk[i_]; } \
        *(LAS u32x4*)(AQ + ar * 72 + ac8 * 8) = pa; if (tid < 128) DECV[tid] = pdec; \
        _Pragma("unroll") for (int nt_ = 0; nt_ < 4; ++nt_) { cu[nt_] = pu[nt_]; } } while (0)
    SCAN_ISSUE(0);
    SCAN_COMMIT();
    __syncthreads();
    for (int n = 0; n < 32; ++n) {
        const size_t row0 = (size_t)(b * 32 + n) * 64;
        if (n < 31) SCAN_ISSUE(n + 1);
#pragma unroll
        for (int nt = 0; nt < 4; ++nt) cgt[nt] = *(const u32x2*)(Pb + (3u * PLB + gu0 + (unsigned)n * 131072u + 32768u * nt));
        bf16x8 sf[4];
#pragma unroll
        for (int k = 0; k < 4; ++k) sf[k] = *(const LAS bf16x8*)(stf + k * 32);
#define SCAN_SB() __builtin_amdgcn_sched_barrier(0)
        __builtin_amdgcn_s_setprio(1);
        f32x4 vn[4];
#pragma unroll
        for (int nt = 0; nt < 4; ++nt) vn[nt] = (f32x4){bflo(cu[nt].x), bfhi(cu[nt].x), bflo(cu[nt].y), bfhi(cu[nt].y)};
        if (gdn) {
#pragma unroll
            for (int hh = 0; hh < 2; ++hh) {
                bf16x8 wf[2][4];
#pragma unroll
                for (int nt = 0; nt < 2; ++nt)
#pragma unroll
                    for (int k = 0; k < 4; ++k) wf[nt][k] = *(const LAS bf16x8*)(wbf + (hh * 2 + nt) * 16 * 136 + k * 32);
                f32x4 acc[2] = {Z4, Z4};
#pragma unroll
                for (int k = 0; k < 4; ++k)
#pragma unroll
                    for (int nt = 0; nt < 2; ++nt) acc[nt] = __builtin_amdgcn_mfma_f32_16x16x32_bf16(sf[k], wf[nt][k], acc[nt], 0, 0, 0);
#pragma unroll
                for (int nt = 0; nt < 2; ++nt) vn[hh * 2 + nt] = vn[hh * 2 + nt] - acc[nt];
                SCAN_SB();
            }
        }
        SCAN_SB();
        bf16x8 qf[2][4];
#pragma unroll
        for (int nt = 0; nt < 2; ++nt)
#pragma unroll
            for (int k = 0; k < 4; ++k) qf[nt][k] = *(const LAS bf16x8*)(qdf + nt * 16 * 136 + k * 32);
#pragma unroll
        for (int nt = 0; nt < 4; ++nt)
#pragma unroll
            for (int jj = 0; jj < 4; jj += 2) { const unsigned w = pk2(vn[nt][jj], vn[nt][jj + 1]); VNT[(mrow + jj) * 72 + nt * 16 + l15] = (bf16_t)w; VNT[(mrow + jj + 1) * 72 + nt * 16 + l15] = (bf16_t)(w >> 16); }
        f32x4 o[4] = {Z4, Z4, Z4, Z4};
#pragma unroll
        for (int k = 0; k < 4; ++k)
#pragma unroll
            for (int nt = 0; nt < 2; ++nt) o[nt] = __builtin_amdgcn_mfma_f32_16x16x32_bf16(sf[k], qf[nt][k], o[nt], 0, 0, 0);
        SCAN_SB();
#pragma unroll
        for (int nt = 0; nt < 2; ++nt)
#pragma unroll
            for (int k = 0; k < 4; ++k) qf[nt][k] = *(const LAS bf16x8*)(qdf + (nt + 2) * 16 * 136 + k * 32);
#pragma unroll
        for (int k = 0; k < 4; ++k)
#pragma unroll
            for (int nt = 0; nt < 2; ++nt) o[nt + 2] = __builtin_amdgcn_mfma_f32_16x16x32_bf16(sf[k], qf[nt][k], o[nt + 2], 0, 0, 0);
        SCAN_SB();
        bf16x8 af[4][2], kf0[4][2]; float dcy[8];
#pragma unroll
        for (int nt = 0; nt < 4; ++nt)
#pragma unroll
            for (int k = 0; k < 2; ++k) { af[nt][k] = *(const LAS bf16x8*)(aqf + nt * 16 * 72 + k * 32); kf0[nt][k] = *(const LAS bf16x8*)(kdf + nt * 16 * 72 + k * 32); }
        LDS_WAIT();
        bf16x8 vf[2];
#pragma unroll
        for (int k = 0; k < 2; ++k) vf[k] = *(const LAS bf16x8*)(vnf + k * 32);
#pragma unroll
        for (int nt = 0; nt < 8; ++nt) { dcy[nt] = DECV[nt * 16 + l15]; Sacc[nt] = Sacc[nt] * dcy[nt]; }
#pragma unroll
        for (int k = 0; k < 2; ++k)
#pragma unroll
            for (int nt = 0; nt < 4; ++nt) { if (k == 0 || nt >= 2) o[nt] = __builtin_amdgcn_mfma_f32_16x16x32_bf16(vf[k], af[nt][k], o[nt], 0, 0, 0);
                Sacc[nt] = __builtin_amdgcn_mfma_f32_16x16x32_bf16(vf[k], kf0[nt][k], Sacc[nt], 0, 0, 0); }
        SCAN_SB();
        {   bf16x8 kf1[4][2];
#pragma unroll
            for (int nt = 0; nt < 4; ++nt)
#pragma unroll
                for (int k = 0; k < 2; ++k) kf1[nt][k] = *(const LAS bf16x8*)(kdf + (nt + 4) * 16 * 72 + k * 32);
#pragma unroll
            for (int k = 0; k < 2; ++k)
#pragma unroll
                for (int nt = 0; nt < 4; ++nt) Sacc[nt + 4] = __builtin_amdgcn_mfma_f32_16x16x32_bf16(vf[k], kf1[nt][k], Sacc[nt + 4], 0, 0, 0); }
#undef SCAN_SB
        __builtin_amdgcn_s_setprio(0);
#pragma unroll
        for (int nt = 0; nt < 4; ++nt) { float q = (o[nt][0] * o[nt][0] + o[nt][1] * o[nt][1]) + (o[nt][2] * o[nt][2] + o[nt][3] * o[nt][3]);
            { const auto r16 = __builtin_amdgcn_permlane16_swap(__float_as_uint(q), __float_as_uint(q), false, false); q = __uint_as_float(r16[0]) + __uint_as_float(r16[1]); }
            { const auto r32 = __builtin_amdgcn_permlane32_swap(__float_as_uint(q), __float_as_uint(q), false, false); q = __uint_as_float(r32[0]) + __uint_as_float(r32[1]); }
            if (lq == 0) SSQ[(nt * 16 + l15) * 8 + wave] = q; }
        LBAR(); PSTAMP(30);
#pragma unroll
        for (int nt = 0; nt < 8; ++nt)
#pragma unroll
            for (int jj = 0; jj < 4; jj += 2) { const unsigned w = pk2(Sacc[nt][jj], Sacc[nt][jj + 1]); ST[(mrow + jj) * 136 + nt * 16 + l15] = (bf16_t)w; ST[(mrow + jj + 1) * 136 + nt * 16 + l15] = (bf16_t)(w >> 16); }
        if (n < 31) SCAN_COMMIT();
#pragma unroll
        for (int nt = 0; nt < 4; ++nt) { const int tok = nt * 16 + l15; float tot = 0.f;
#pragma unroll
            for (int w4 = 0; w4 < 2; ++w4) { const f32x4 pz = *(const LAS f32x4*)(SSQ + tok * 8 + w4 * 4); tot += (pz[0] + pz[1]) + (pz[2] + pz[3]); }
            const float rs = gdn ? rsqrtf(tot * (1.0f / 128.0f) + EPS) : 1.0f;
            const float g0 = bflo(cgt[nt].x), g1 = bfhi(cgt[nt].x), g2 = bflo(cgt[nt].y), g3 = bfhi(cgt[nt].y);
            u32x2 ow; ow.x = pk2(o[nt][0] * rs * nwv[0] * g0, o[nt][1] * rs * nwv[1] * g1); ow.y = pk2(o[nt][2] * rs * nwv[2] * g2, o[nt][3] * rs * nwv[3] * g3);
            *(u32x2*)((char*)P + (3u * PLB + gu0 + (unsigned)n * 131072u + 32768u * nt)) = ow;
            if (!gdn && wave == 0 && lq == 0) ss_o[(row0 + tok) * 8 + h] = tot; }
        LBAR(); PSTAMP(31);
    }
#undef SCAN_ISSUE
#undef SCAN_COMMIT
}

__device__ __forceinline__ void scan_hgrn_split(LAS unsigned char* lds, int tid, bf16_t* P, const bf16_t* AQK, const float* DEC, const float* nw, float* ss_o) {
    asm volatile("" : "+v"(tid));
    const int lane = tid & 63, wave = __builtin_amdgcn_readfirstlane(tid >> 6);
    const int xcd_ = blockIdx.x & 7, kk_ = blockIdx.x >> 3;
    const int chain = (kk_ >> 1) * 8 + xcd_, half = kk_ & 1, b = chain >> 3, h = chain & 7, dv0 = half * 64;
    const int dt = wave & 3, ch = wave >> 2;
    LAS bf16_t* ST = (LAS bf16_t*)lds; LAS bf16_t* VNT = (LAS bf16_t*)(lds + 17408); LAS bf16_t* QD = (LAS bf16_t*)(lds + 35840);
    LAS bf16_t* AQ = (LAS bf16_t*)(lds + 53248); LAS bf16_t* KDT = (LAS bf16_t*)(lds + 62464); LAS float* DECV = (LAS float*)(lds + 80896); LAS float* SSQ = (LAS float*)(lds + 81408);
    LAS float* NWL = (LAS float*)(lds + 82432);
    const f32x4 Z4 = (f32x4){0.f, 0.f, 0.f, 0.f};
    f32x4 Sacc[4];
#pragma unroll
    for (int n4 = 0; n4 < 4; ++n4) Sacc[n4] = Z4;
    for (int i = tid; i < 64 * 136 / 2; i += NTHREADS) ((LAS unsigned*)ST)[i] = 0u;
    if (tid < 64) NWL[tid] = nw[h * 128 + dv0 + tid];
    const int l15 = lane & 15, lq = lane >> 4, mrow = dt * 16 + lq * 4;
    const LAS bf16_t* stf = ST + (dt * 16 + l15) * 136 + lq * 8; const LAS bf16_t* vnf = VNT + (wave * 16 + l15) * 72 + lq * 8;
    const LAS bf16_t* qdf = QD + l15 * 136 + lq * 8; const LAS bf16_t* aqf = AQ + l15 * 72 + lq * 8; const LAS bf16_t* kdf = KDT + l15 * 72 + lq * 8;
    const int sr0 = tid >> 4, sc8 = tid & 15, ar = tid >> 3, ac8 = tid & 7;
    u32x4 pq[2], pk[2], pa; u32x2 pu[4], cu[4], cgt[2]; float pdec = 0.f;
    const char* Pb = (const char*)P; const char* Ab = (const char*)AQK; const char* Db = (const char*)DEC;
    const unsigned PLB = (unsigned)(PLANE * 2);
    const unsigned go0 = (unsigned)(((b * 32 * 64 + sr0) * 1024 + h * 128 + sc8 * 8) * 2);
    const unsigned gu0 = (unsigned)(((b * 32 * 64 + l15) * 1024 + h * 128 + dv0 + mrow) * 2);
    const unsigned ga0 = (unsigned)((((b * 32) * 8 + h) * 4096 + ar * 64 + ac8 * 8) * 2);
    const unsigned gd0 = (unsigned)((((b * 32) * 8 + h) * 128 + (tid & 127)) * 4);
#define HS_ISSUE(nn) do { const unsigned go_ = go0 + (unsigned)(nn) * 131072u, gu_ = gu0 + (unsigned)(nn) * 131072u; \
        _Pragma("unroll") for (int i_ = 0; i_ < 2; ++i_) { pq[i_] = *(const u32x4*)(Pb + (go_ + 65536u * i_)); pk[i_] = *(const u32x4*)(Pb + (PLB + go_ + 65536u * i_)); } \
        pa = *(const u32x4*)(Ab + (ga0 + (unsigned)(nn) * 65536u)); \
        _Pragma("unroll") for (int nt_ = 0; nt_ < 4; ++nt_) pu[nt_] = *(const u32x2*)(Pb + (2u * PLB + gu_ + 32768u * nt_)); \
        if (tid < 128) pdec = *(const float*)(Db + (gd0 + (unsigned)(nn) * 4096u)); } while (0)
#define HS_COMMIT() do { \
        _Pragma("unroll") for (int i_ = 0; i_ < 2; ++i_) { const int r_ = sr0 + 32 * i_; \
            *(LAS u32x4*)(QD + r_ * 136 + sc8 * 8) = pq[i_]; *(LAS u32x4*)(KDT + (r_ * 2 + (sc8 >> 3)) * 72 + (sc8 & 7) * 8) = pk[i_]; } \
        *(LAS u32x4*)(AQ + ar * 72 + ac8 * 8) = pa; if (tid < 128) DECV[tid] = pdec; \
        _Pragma("unroll") for (int nt_ = 0; nt_ < 4; ++nt_) { cu[nt_] = pu[nt_]; } } while (0)
    HS_ISSUE(0);
    HS_COMMIT();
    __syncthreads();
    for (int n = 0; n < 32; ++n) {
        if (n < 31) HS_ISSUE(n + 1);
#pragma unroll
        for (int t2 = 0; t2 < 2; ++t2) cgt[t2] = *(const u32x2*)(Pb + (3u * PLB + gu0 + (unsigned)n * 131072u + 32768u * (ch * 2 + t2)));
        bf16x8 sf[4];
#pragma unroll
        for (int k = 0; k < 4; ++k) sf[k] = *(const LAS bf16x8*)(stf + k * 32);
#pragma unroll
        for (int nt = 0; nt < 4; ++nt) { VNT[(wave * 16 + lq * 4 + 0) * 72 + nt * 16 + l15] = (bf16_t)cu[nt].x; VNT[(wave * 16 + lq * 4 + 1) * 72 + nt * 16 + l15] = (bf16_t)(cu[nt].x >> 16);
            VNT[(wave * 16 + lq * 4 + 2) * 72 + nt * 16 + l15] = (bf16_t)cu[nt].y; VNT[(wave * 16 + lq * 4 + 3) * 72 + nt * 16 + l15] = (bf16_t)(cu[nt].y >> 16); }
        __builtin_amdgcn_s_setprio(1);
        bf16x8 qf[2][4];
#pragma unroll
        for (int t2 = 0; t2 < 2; ++t2)
#pragma unroll
            for (int k = 0; k < 4; ++k) qf[t2][k] = *(const LAS bf16x8*)(qdf + (ch * 2 + t2) * 16 * 136 + k * 32);
        f32x4 o[2] = {Z4, Z4};
#pragma unroll
        for (int k = 0; k < 4; ++k)
#pragma unroll
            for (int t2 = 0; t2 < 2; ++t2) o[t2] = __builtin_amdgcn_mfma_f32_16x16x32_bf16(sf[k], qf[t2][k], o[t2], 0, 0, 0);
        bf16x8 af[2][2], kf[4][2];
#pragma unroll
        for (int k = 0; k < 2; ++k) {
#pragma unroll
            for (int t2 = 0; t2 < 2; ++t2) af[t2][k] = *(const LAS bf16x8*)(aqf + (ch * 2 + t2) * 16 * 72 + k * 32);
#pragma unroll
            for (int n4 = 0; n4 < 4; ++n4) kf[n4][k] = *(const LAS bf16x8*)(kdf + (ch * 4 + n4) * 16 * 72 + k * 32); }
        LDS_WAIT();
        bf16x8 vf[2];
#pragma unroll
        for (int k = 0; k < 2; ++k) vf[k] = *(const LAS bf16x8*)(vnf + k * 32);
#pragma unroll
        for (int n4 = 0; n4 < 4; ++n4) Sacc[n4] = Sacc[n4] * DECV[(ch * 4 + n4) * 16 + l15];
#pragma unroll
        for (int k = 0; k < 2; ++k) {
#pragma unroll
            for (int t2 = 0; t2 < 2; ++t2) { if (k == 0 || ch == 1) o[t2] = __builtin_amdgcn_mfma_f32_16x16x32_bf16(vf[k], af[t2][k], o[t2], 0, 0, 0); }
#pragma unroll
            for (int n4 = 0; n4 < 4; ++n4) Sacc[n4] = __builtin_amdgcn_mfma_f32_16x16x32_bf16(vf[k], kf[n4][k], Sacc[n4], 0, 0, 0); }
        __builtin_amdgcn_s_setprio(0);
#pragma unroll
        for (int t2 = 0; t2 < 2; ++t2) { float q = (o[t2][0] * o[t2][0] + o[t2][1] * o[t2][1]) + (o[t2][2] * o[t2][2] + o[t2][3] * o[t2][3]);
            { const auto r16 = __builtin_amdgcn_permlane16_swap(__float_as_uint(q), __float_as_uint(q), false, false); q = __uint_as_float(r16[0]) + __uint_as_float(r16[1]); }
            { const auto r32 = __builtin_amdgcn_permlane32_swap(__float_as_uint(q), __float_as_uint(q), false, false); q = __uint_as_float(r32[0]) + __uint_as_float(r32[1]); }
            if (lq == 0) SSQ[((ch * 2 + t2) * 16 + l15) * 4 + dt] = q; }
        LBAR();
#pragma unroll
        for (int n4 = 0; n4 < 4; ++n4)
#pragma unroll
            for (int jj = 0; jj < 4; jj += 2) { const unsigned w = pk2(Sacc[n4][jj], Sacc[n4][jj + 1]); ST[(mrow + jj) * 136 + (ch * 4 + n4) * 16 + l15] = (bf16_t)w; ST[(mrow + jj + 1) * 136 + (ch * 4 + n4) * 16 + l15] = (bf16_t)(w >> 16); }
        if (n < 31) HS_COMMIT();
        const f32x4 nwv = *(const LAS f32x4*)(NWL + mrow);
#pragma unroll
        for (int t2 = 0; t2 < 2; ++t2) { const int tok = (ch * 2 + t2) * 16 + l15;
            const float g0 = bflo(cgt[t2].x), g1 = bfhi(cgt[t2].x), g2 = bflo(cgt[t2].y), g3 = bfhi(cgt[t2].y);
            u32x2 ow; ow.x = pk2(o[t2][0] * nwv[0] * g0, o[t2][1] * nwv[1] * g1); ow.y = pk2(o[t2][2] * nwv[2] * g2, o[t2][3] * nwv[3] * g3);
            *(u32x2*)((char*)P + (3u * PLB + gu0 + (unsigned)n * 131072u + 32768u * (ch * 2 + t2))) = ow;
            if (dt == 0 && lq == 0) { const f32x4 pz = *(const LAS f32x4*)(SSQ + tok * 4); ss_o[((size_t)(b * 32 + n) * 64 + tok) * 16 + h * 2 + half] = (pz[0] + pz[1]) + (pz[2] + pz[3]); } }
        LBAR();
    }
#undef HS_ISSUE
#undef HS_COMMIT
}

#define BUILD_RSTD_TABLE(S_, ssp_, pm_a_, pm_b_) do { \
        pm_a_ = -1; pm_b_ = -1; \
        for (int i_ = 0; i_ < 64; ++i_) { pg8::Unit u_; if (!(S_).next(i_, u_)) break; if (pm_a_ < 0) pm_a_ = u_.pm; else if (u_.pm != pm_a_ && pm_b_ < 0) pm_b_ = u_.pm; } \
        int t_ = tid; asm volatile("" : "+v"(t_)); \
        { const int k_ = t_ >> 8, r_ = t_ & 255; const int pm_ = k_ ? pm_b_ : pm_a_; ((LAS float*)(lds + 131072))[t_] = (pm_ >= 0) ? pg8::row_rstd16(ssp_, pm_ * 256 + r_) : 0.f; } \
        __syncthreads(); } while (0)
#define BUILD_RSTD8_TABLE(S_, ssp_, pm_a_, pm_b_) do { \
        pm_a_ = -1; pm_b_ = -1; \
        for (int i_ = 0; i_ < 64; ++i_) { pg8::Unit u_; if (!(S_).next(i_, u_)) break; if (pm_a_ < 0) pm_a_ = u_.pm; else if (u_.pm != pm_a_ && pm_b_ < 0) pm_b_ = u_.pm; } \
        int t_ = tid; asm volatile("" : "+v"(t_)); \
        { const int k_ = t_ >> 8, r_ = t_ & 255; const int pm_ = k_ ? pm_b_ : pm_a_; ((LAS float*)(lds + 131072))[t_] = (pm_ >= 0) ? pg8::row_rstd16(ssp_, pm_ * 256 + r_) : 0.f; } \
        __syncthreads(); } while (0)

__global__ void __launch_bounds__(NTHREADS, 2) mega_fwd(Args a) {
    extern __shared__ __attribute__((aligned(16))) unsigned char lds_raw[];
    LAS unsigned char* lds = (LAS unsigned char*)lds_raw;
    cg::grid_group grid = cg::this_grid();
    const int tid = threadIdx.x;
    unsigned char* ws = a.ws;
    float* SSA = (float*)(ws + WS_SSA); float* SSB = (float*)(ws + WS_SSB); float* SSO = (float*)(ws + WS_SSO); bf16_t* P = (bf16_t*)(ws + WS_PROJ); bf16_t* HB = (bf16_t*)(ws + WS_HB); bf16_t* AQK = (bf16_t*)(ws + WS_AQK);
    bf16_t* HALO = (bf16_t*)(ws + WS_HALO); float* AB = (float*)(ws + WS_AB); float* DEC = (float*)(ws + WS_DEC);
    const float* x = a.in[0]; float* out = a.out;
    const int G = gridDim.x;

    volatile LAS unsigned* misc = (volatile LAS unsigned*)(lds + LDS_BYTES - 16);
    if (tid < 4) misc[tid] = 0u;
    __syncthreads();
    const XcdBarrier bar = xcd_barrier_post((unsigned*)ws, misc);
#define GRID_BAR() do { XcdBarrier b2_ = bar; asm volatile("" : "+s"(b2_.x), "+s"(b2_.bar)); xcd_barrier(b2_); } while (0)
#ifdef PROBE_SEL
    unsigned tacc = 0u, tprev = (unsigned)__builtin_amdgcn_s_memrealtime();
#define STAMP(k) do { const unsigned t_ = (unsigned)__builtin_amdgcn_s_memrealtime(); if ((k) == PROBE_SEL) tacc += t_ - tprev; tprev = t_; } while (0)
#else
#define STAMP(k) do {} while (0)
#endif

    prologue(a, lds, tid);
    if (a.out == nullptr) grid.sync();
    GRID_BAR(); STAMP(0);

    for (int i = 0; i < 4; ++i) {
        const int j = i >> 1; const bool gdn = (i & 1) == 0;
        {
            const bf16_t* Bt = gdn ? (const bf16_t*)(ws + WS_WGI) + (size_t)j * GDN_NPAD * 1024 : (const bf16_t*)(ws + WS_WHI) + (size_t)j * 4096 * 1024;
            pg8::Gemm g{HB, Bt, M_TOK, 4096, 1024}; pg8::StaticOrder S; S.init(M_TOK, 4096, G, (int)blockIdx.x);
            int pm_a, pm_b; BUILD_RSTD_TABLE(S, SSB, pm_a, pm_b);
            pg8::EpiProj E{P, PLANE, SSB, gdn ? AB : nullptr, gdn ? HALO : nullptr, (const LAS float*)(lds + 131072), pm_a, pm_b};
            pg8::gemm_phase<pg8::EpiProj, pg8::StaticOrder, true, true>(lds, g, S, E);
            if (gdn) {
                int t2 = tid; asm volatile("" : "+v"(t2));
                const int lane = t2 & 63, l15 = lane & 15, lq = lane >> 4;
                for (int rt = (int)blockIdx.x * NWAVES + (t2 >> 6); rt < M_TOK / 16; rt += G * NWAVES) {
                    const bf16_t* ap = HB + (size_t)(rt * 16 + l15) * 1024 + lq * 8; const bf16_t* bp = Bt + (size_t)(4096 + l15) * 1024 + lq * 8;
                    f32x4 acc = (f32x4){0.f, 0.f, 0.f, 0.f};
#pragma unroll 8
                    for (int k0 = 0; k0 < 1024; k0 += 32) acc = __builtin_amdgcn_mfma_f32_16x16x32_bf16(*(const bf16x8*)(ap + k0), *(const bf16x8*)(bp + k0), acc, 0, 0, 0);
#pragma unroll
                    for (int jj = 0; jj < 4; ++jj) { const int row = rt * 16 + lq * 4 + jj; AB[(size_t)row * 16 + l15] = acc[jj] * pg8::row_rstd16(SSB, row); }
                }
            }
        }
        GRID_BAR(); STAMP(1);
        if (gdn) gdn_prep(lds, tid, P, (bf16_t*)out, AQK, HALO, AB, DEC, a.in[2] + (size_t)j * 4 * 3072, a.in[3] + j * 8, a.in[4] + j * 8
#ifdef PROBE_SEL
                          , tacc, tprev
#endif
                          );
        else hgrn_prep(lds, tid, P, AQK, DEC, (const float*)(ws + WS_LB) + j * 1024);
        GRID_BAR(); if (gdn) STAMP(2); else STAMP(3);
        if (!gdn) scan_hgrn_split(lds, tid, P, AQK, DEC, a.in[9] + j * 1024, SSO);
        else {
        if (blockIdx.x >= 128) { for (int ii = i; ii < i + 2; ++ii) convert_layer_weights(a, lds, tid, ii, (G - 128) * NWAVES); }
        scan_phase(lds, tid, gdn, P, (const bf16_t*)out, AQK, DEC, gdn ? a.in[5] + j * 128 : a.in[9] + j * 1024, SSO
#ifdef PROBE_SEL
                   , tacc, tprev
#endif
                   );
        }
        GRID_BAR(); if (gdn) STAMP(4); else STAMP(5);
        {
            const bf16_t* Bt = gdn ? (const bf16_t*)(ws + WS_WGO) + (size_t)j * 1024 * 1024 : (const bf16_t*)(ws + WS_WHO) + (size_t)j * 1024 * 1024;
            pg8::Gemm g{P + 3 * PLANE, Bt, M_TOK, 1024, 1024}; pg8::StaticOrder S; S.init(M_TOK, 1024, G, (int)blockIdx.x);
            int pm_a = -1, pm_b = -1; if (!gdn) BUILD_RSTD8_TABLE(S, SSO, pm_a, pm_b);
            pg8::EpiRes E{HB, SSA, gdn ? nullptr : SSO, (const LAS float*)(lds + 131072), pm_a, pm_b};
            pg8::gemm_phase<pg8::EpiRes, pg8::StaticOrder, true, true>(lds, g, S, E);
        }
        GRID_BAR(); STAMP(6);
        {
            pg8::Gemm g{HB, (const bf16_t*)(ws + WS_WUP) + (size_t)i * 4096 * 1024, M_TOK, 4096, 1024}; pg8::StaticOrder S; S.init(M_TOK, 4096, G, (int)blockIdx.x);
            int pm_a, pm_b; BUILD_RSTD_TABLE(S, SSA, pm_a, pm_b);
            pg8::EpiUp E{P, SSA, (const LAS float*)(lds + 131072), pm_a, pm_b};
            pg8::gemm_phase<pg8::EpiUp, pg8::StaticOrder, true, true>(lds, g, S, E);
        }
        GRID_BAR(); STAMP(7);
        {
            pg8::Gemm g{P, (const bf16_t*)(ws + WS_WDN) + (size_t)i * 1024 * 4096, M_TOK, 1024, 4096}; pg8::StaticOrder S; S.init(M_TOK, 1024, G, (int)blockIdx.x);
            pg8::EpiRes E{HB, SSB, nullptr, (const LAS float*)(lds + 131072), -1, -1};
            pg8::gemm_phase<pg8::EpiRes, pg8::StaticOrder, true, true>(lds, g, S, E);
        }
        GRID_BAR(); STAMP(8);
    }
    {
        int t3 = tid; asm volatile("" : "+v"(t3));
        const int lane = t3 & 63, wave = t3 >> 6; const int gw = blockIdx.x * NWAVES + wave, NGW = G * NWAVES;
        const f32x4* nf = (const f32x4*)a.in[15] + 2 * lane;
        f32x4 wv[4];
#pragma unroll
        for (int jx = 0; jx < 2; ++jx) { wv[2 * jx] = nf[128 * jx]; wv[2 * jx + 1] = nf[128 * jx + 1]; }
        for (int m = gw; m < M_TOK; m += NGW) {
            const float rs = pg8::row_rstd16(SSB, m); const u32x4* hr = (const u32x4*)(HB + (size_t)m * DMODEL) + lane; f32x4* o = (f32x4*)(out + (size_t)m * DMODEL) + 2 * lane;
#pragma unroll
            for (int jx = 0; jx < 2; ++jx) { const u32x4 hw = hr[64 * jx];
                const f32x4 h0 = (f32x4){bflo(hw.x), bfhi(hw.x), bflo(hw.y), bfhi(hw.y)}, h1 = (f32x4){bflo(hw.z), bfhi(hw.z), bflo(hw.w), bfhi(hw.w)};
                o[128 * jx] = h0 * rs * wv[2 * jx]; o[128 * jx + 1] = h1 * rs * wv[2 * jx + 1]; }
        }
    }
#ifdef PROBE_SEL
    STAMP(9);
    __syncthreads();
    if (blockIdx.x == 0 && tid == 0) { __builtin_amdgcn_s_waitcnt(0); out[0] += 0.02f * rintf((float)tacc * 0.001f); }
#endif
}

extern "C" void kernel_launch(void* const* d_in, const int* in_sizes, int n_in, void* d_out, int out_size, void* d_ws, size_t ws_size, hipStream_t stream) {
    static int grid = 0;
    if (grid == 0) {
        if (n_in != 16 || out_size != M_TOK * DMODEL || ws_size < WS_END) { fprintf(stderr, "kernel_launch: unexpected shapes (n_in %d, out %d, ws %zu; need ws >= %zu)\n", n_in, out_size, ws_size, (size_t)WS_END); grid = -1; return; }
        int dev = 0, cus = 0, per_cu = 0;
        (void)hipGetDevice(&dev); (void)hipDeviceGetAttribute(&cus, hipDeviceAttributeMultiprocessorCount, dev);
        (void)hipFuncSetAttribute((const void*)mega_fwd, hipFuncAttributeMaxDynamicSharedMemorySize, LDS_BYTES);
        if (hipOccupancyMaxActiveBlocksPerMultiprocessor(&per_cu, (const void*)mega_fwd, NTHREADS, LDS_BYTES) != hipSuccess || per_cu < 1) per_cu = 1;
        (void)hipGetLastError();
        grid = cus * (per_cu > 1 ? 1 : per_cu);
        if (grid <= 0) grid = 256;
    }
    if (grid < 0) return;
    Args a{};
    for (int i = 0; i < 16; ++i) a.in[i] = (const float*)d_in[i];
    a.out = (float*)d_out; a.ws = (unsigned char*)d_ws;
    (void)hipMemsetAsync(d_ws, 0, 16384, stream);
    void* args[] = {&a};
    hipError_t e = hipLaunchCooperativeKernel((const void*)mega_fwd, dim3(grid), dim3(NTHREADS), args, LDS_BYTES, stream);
    if (e != hipSuccess) fprintf(stderr, "cooperative launch failed: %s (grid %d)\n", hipGetErrorString(e), grid);
}
```
